# Optimizing an MI355X kernel written in HIP

```python
import math
import jax, jax.numpy as jnp
from jax import lax
import numpy as np


D_MODEL = 1024
BATCH = 16
SEQ = 2048
DEPTH = 1
DEC_BATCH = 4
DEC_SEQ = 4096
PAST_LEN = 128

ATT_HEAD_DIM = 64
ATT_HEADS_PER_GROUP = 8
DILATED_GROUPS = ((128, 1), (512, 4), (2048, 16))
ATT_HEADS = ATT_HEADS_PER_GROUP * len(DILATED_GROUPS)
ATT_WIDTH = ATT_HEADS * ATT_HEAD_DIM
ATT_OUT_WIDTH = ATT_HEADS_PER_GROUP * ATT_HEAD_DIM
ROPE_DIM = ATT_HEAD_DIM // 4
ROPE_THETA = 500000.0
DN_HEADS = 8
DN_HEAD_DIM = 128
DN_WIDTH = DN_HEADS * DN_HEAD_DIM
SHORT_CONV = 5
DN_CHUNK = 64
D_FF = 2816
FFN_CONV = 3
EPS = 1e-6
COL_ATT = 3 * ATT_WIDTH
COL_DN_QKV = 3 * DN_WIDTH
COL_DN_Z = DN_WIDTH
COL_DN_SMALL = 4 * DN_HEADS
COL_GATES = 2 * D_MODEL
IN_COLS = COL_ATT + COL_DN_QKV + COL_DN_Z + COL_DN_SMALL + COL_GATES

kernel_name = "hybrid_dilated_attn_gdn_encoder"


def rms_norm(x, g):
    xf = x.astype(jnp.float32)
    y = xf * lax.rsqrt(jnp.mean(xf * xf, axis=-1, keepdims=True) + EPS)
    return (y * g.astype(jnp.float32)).astype(x.dtype)


def l2_normalize(t):
    tf = t.astype(jnp.float32)
    return tf * lax.rsqrt(jnp.sum(tf * tf, axis=-1, keepdims=True) + EPS)


def centred_depthwise_conv(t, w):
    K = w.shape[0]
    r = K // 2
    S = t.shape[1]
    tp = jnp.pad(t, ((0, 0), (r, r), (0, 0)))
    out = tp[:, 0:S] * w[0]
    for i in range(1, K):
        out = out + tp[:, i:i + S] * w[i]
    return out


def partial_rope(t, pos):
    half = ROPE_DIM // 2
    inv = ROPE_THETA ** (-jnp.arange(half, dtype=jnp.float32) / half)
    ang = pos[:, None] * inv[None, :]
    cos = jnp.cos(ang)[None, :, None, :]
    sin = jnp.sin(ang)[None, :, None, :]
    tr = t[..., :ROPE_DIM].astype(jnp.float32)
    t1, t2 = tr[..., :half], tr[..., half:]
    rot = jnp.concatenate([t1 * cos - t2 * sin, t2 * cos + t1 * sin], axis=-1).astype(t.dtype)
    return jnp.concatenate([rot, t[..., ROPE_DIM:]], axis=-1)


def dilated_window_attention(q, k, v, window, dil):
    B, S, H, Dh = q.shape
    half = window // (2 * dil)
    blk = half
    L = S // dil
    nb = -(-L // blk)
    Lp = nb * blk

    def residue_major(t):
        t = t.reshape(B, L, dil, H, Dh).transpose(0, 2, 1, 3, 4)
        return jnp.pad(t, ((0, 0), (0, 0), (0, Lp - L), (0, 0), (0, 0)))

    def key_windows(t):
        t = jnp.pad(residue_major(t), ((0, 0), (0, 0), (blk, blk), (0, 0), (0, 0)))
        t = t.reshape(B, dil, nb + 2, blk, H, Dh)
        return jnp.concatenate([t[:, :, :-2], t[:, :, 1:-1], t[:, :, 2:]], axis=3)

    qs = residue_major(q).reshape(B, dil, nb, blk, H, Dh).astype(jnp.float32)
    ks = key_windows(k).astype(jnp.float32)
    vs = key_windows(v).astype(jnp.float32)
    qpos = jnp.arange(nb)[:, None] * blk + jnp.arange(blk)[None, :]
    kpos = (jnp.arange(nb)[:, None] - 1) * blk + jnp.arange(3 * blk)[None, :]
    diff = kpos[:, None, :] - qpos[:, :, None]
    valid = (jnp.abs(diff) <= half) & (kpos[:, None, :] >= 0) & (kpos[:, None, :] < L)
    s = jnp.einsum('bdnqhe,bdnkhe->bdnhqk', qs, ks) * (Dh ** -0.5)
    s = jnp.where(valid[None, None, :, None], s, -1e30)
    m = jnp.max(s, axis=-1, keepdims=True)
    p = jnp.exp(s - m)
    den = jnp.sum(p, axis=-1, keepdims=True)
    o = jnp.einsum('bdnhqk,bdnkhe->bdnqhe', p / den, vs)
    lse = (m + jnp.log(den))[..., 0]
    o = o.reshape(B, dil, Lp, H, Dh)[:, :, :L].transpose(0, 2, 1, 3, 4).reshape(B, S, H, Dh)
    lse = lse.transpose(0, 1, 2, 4, 3).reshape(B, dil, Lp, H)[:, :, :L].transpose(0, 2, 1, 3).reshape(B, S, H)
    return o, lse


def dilated_attention_branch(qkv, pos):
    B, S, _ = qkv.shape
    q, k, v = jnp.split(qkv, 3, axis=-1)
    q = partial_rope(q.reshape(B, S, ATT_HEADS, ATT_HEAD_DIM), pos)
    k = partial_rope(k.reshape(B, S, ATT_HEADS, ATT_HEAD_DIM), pos)
    v = v.reshape(B, S, ATT_HEADS, ATT_HEAD_DIM)
    outs, lses = [], []
    for gi, (window, dil) in enumerate(DILATED_GROUPS):
        sl = slice(gi * ATT_HEADS_PER_GROUP, (gi + 1) * ATT_HEADS_PER_GROUP)
        o, l = dilated_window_attention(q[:, :, sl], k[:, :, sl], v[:, :, sl], window, dil)
        outs.append(o)
        lses.append(l)
    wts = jax.nn.softmax(jnp.stack(lses, axis=0), axis=0)
    o = jnp.sum(wts[..., None] * jnp.stack(outs, axis=0), axis=0)
    return o.reshape(B, S, ATT_OUT_WIDTH).astype(qkv.dtype)


def gated_delta_rule(q, k, v, g, beta):
    B, S, H, Dk = q.shape
    Dv = v.shape[-1]
    C = DN_CHUNK
    N = S // C

    def chunks(t):
        t = t.reshape((B, N, C, H) + t.shape[3:])
        return jnp.moveaxis(t, 3, 1)

    qc, kc, vc = chunks(q), chunks(k), chunks(v)
    gc = jnp.cumsum(chunks(g), axis=-1)
    bc = chunks(beta)
    tril = jnp.tril(jnp.ones((C, C), dtype=bool))
    strict = jnp.tril(jnp.ones((C, C), dtype=bool), -1)
    gdiff = gc[..., :, None] - gc[..., None, :]
    dmask = jnp.where(tril, jnp.exp(jnp.where(tril, gdiff, 0.0)), 0.0)
    kb = kc * bc[..., None]
    vb = vc * bc[..., None]
    m_low = jnp.where(strict, jnp.einsum('bhnid,bhnjd->bhnij', kb, kc) * dmask, 0.0)
    eye = jnp.eye(C, dtype=jnp.float32)
    rhs = jnp.concatenate([vb, kb * jnp.exp(gc)[..., None]], axis=-1)
    sol = lax.linalg.triangular_solve(m_low + eye, rhs, left_side=True, lower=True, unit_diagonal=True)
    u, w = sol[..., :Dv], sol[..., Dv:]
    intra = jnp.where(tril, jnp.einsum('bhnid,bhnjd->bhnij', qc, kc) * dmask, 0.0)

    def step(state, xs):
        qi, ki, ui, wi, gi, ai = xs
        v_new = ui - jnp.einsum('bhck,bhkv->bhcv', wi, state)
        o = (jnp.einsum('bhck,bhkv->bhcv', qi * jnp.exp(gi)[..., None], state)
             + jnp.einsum('bhij,bhjv->bhiv', ai, v_new))
        glast = gi[..., -1]
        state = (state * jnp.exp(glast)[..., None, None]
                 + jnp.einsum('bhck,bhcv->bhkv', ki * jnp.exp(glast[..., None] - gi)[..., None], v_new))
        return state, o

    xs = tuple(jnp.moveaxis(t, 2, 0) for t in (qc, kc, u, w, gc, intra))
    state0 = jnp.zeros((B, H, Dk, Dv), dtype=jnp.float32)
    _, o = lax.scan(step, state0, xs)
    return o.transpose(1, 0, 3, 2, 4).reshape(B, S, H, Dv)


def deltanet_branch(qkv_raw, z, small, conv_qkv_w, a_log_f, a_log_b, dt_bias_f, dt_bias_b, out_norm_g):
    B, S, _ = qkv_raw.shape
    qkv = jax.nn.silu(centred_depthwise_conv(qkv_raw, conv_qkv_w))
    q, k, v = jnp.split(qkv, 3, axis=-1)
    q = l2_normalize(q.reshape(B, S, DN_HEADS, DN_HEAD_DIM)) * (DN_HEAD_DIM ** -0.5)
    k = l2_normalize(k.reshape(B, S, DN_HEADS, DN_HEAD_DIM))
    v = v.reshape(B, S, DN_HEADS, DN_HEAD_DIM).astype(jnp.float32)
    small = small.astype(jnp.float32)
    beta_f = jax.nn.sigmoid(small[..., 0:DN_HEADS])
    beta_b = jax.nn.sigmoid(small[..., DN_HEADS:2 * DN_HEADS])
    g_f = -jnp.exp(a_log_f.astype(jnp.float32)) * jax.nn.softplus(small[..., 2 * DN_HEADS:3 * DN_HEADS] + dt_bias_f.astype(jnp.float32))
    g_b = -jnp.exp(a_log_b.astype(jnp.float32)) * jax.nn.softplus(small[..., 3 * DN_HEADS:4 * DN_HEADS] + dt_bias_b.astype(jnp.float32))
    o_f = gated_delta_rule(q, k, v, g_f, beta_f)
    flip = lambda t: jnp.flip(t, axis=1)
    o_b = flip(gated_delta_rule(flip(q), flip(k), flip(v), flip(g_b), flip(beta_b)))
    o = rms_norm(o_f + o_b, out_norm_g)
    o = o * jax.nn.silu(z.reshape(B, S, DN_HEADS, DN_HEAD_DIM).astype(jnp.float32))
    return o.reshape(B, S, DN_WIDTH).astype(qkv_raw.dtype)


def trunk(x, norm_mix_g, w_in, conv_qkv_w, a_log_f, a_log_b, dt_bias_f, dt_bias_b, out_norm_g,
          w_branch_a, w_branch_b, w_out, norm_ffn_g, w_up, ffn_conv_w, ffn_conv_b, w_down, norm_final_g):
    B, S, _ = x.shape
    pos = jnp.arange(S, dtype=jnp.float32)
    for _layer in range(DEPTH):
        h = rms_norm(x, norm_mix_g)
        proj = h @ w_in
        o0 = COL_ATT
        o1 = o0 + COL_DN_QKV
        o2 = o1 + COL_DN_Z
        o3 = o2 + COL_DN_SMALL
        att_qkv = proj[..., :o0]
        dn_qkv = proj[..., o0:o1]
        dn_z = proj[..., o1:o2]
        dn_small = proj[..., o2:o3]
        gate_a = jax.nn.sigmoid(proj[..., o3:o3 + D_MODEL])
        gate_b = jax.nn.sigmoid(proj[..., o3 + D_MODEL:])
        y_a = dilated_attention_branch(att_qkv, pos) @ w_branch_a
        y_b = deltanet_branch(dn_qkv, dn_z, dn_small, conv_qkv_w, a_log_f, a_log_b, dt_bias_f, dt_bias_b, out_norm_g) @ w_branch_b
        x = x + (gate_a * y_a + gate_b * y_b) @ w_out
        h2 = rms_norm(x, norm_ffn_g)
        up = h2 @ w_up
        gate, val = jnp.split(up, 2, axis=-1)
        gate = centred_depthwise_conv(gate, ffn_conv_w) + ffn_conv_b
        x = x + (jax.nn.gelu(gate, approximate=False) * val) @ w_down
    return rms_norm(x, norm_final_g)


def setup_inputs(seed: int = 0) -> dict:
    key = jax.random.key(seed)
    ks = jax.random.split(key, 24)
    f32 = jnp.float32
    nrm = lambda k, shape, fan_in: jax.random.normal(k, shape, f32) * (fan_in ** -0.5)
    gain = lambda k, n: 1.0 + 0.02 * jax.random.normal(k, (n,), f32)

    def dt_bias(k):
        dt = jnp.exp(jax.random.uniform(k, (DN_HEADS,), f32, math.log(1e-3), math.log(1e-1)))
        return dt + jnp.log(-jnp.expm1(-dt))

    return {
        'x_prompt': jax.random.normal(ks[0], (BATCH, SEQ, D_MODEL), f32),
        'x_sample': jax.random.normal(ks[1], (DEC_BATCH, DEC_SEQ, D_MODEL), f32),
        'norm_mix_g': gain(ks[2], D_MODEL),
        'w_in': nrm(ks[3], (D_MODEL, IN_COLS), D_MODEL),
        'conv_qkv_w': nrm(ks[4], (SHORT_CONV, COL_DN_QKV), SHORT_CONV),
        'a_log_f': jnp.log(jax.random.uniform(ks[5], (DN_HEADS,), f32, 1.0, 16.0)),
        'a_log_b': jnp.log(jax.random.uniform(ks[6], (DN_HEADS,), f32, 1.0, 16.0)),
        'dt_bias_f': dt_bias(ks[7]),
        'dt_bias_b': dt_bias(ks[8]),
        'out_norm_g': gain(ks[9], DN_HEAD_DIM),
        'w_branch_a': nrm(ks[10], (ATT_OUT_WIDTH, D_MODEL), ATT_OUT_WIDTH),
        'w_branch_b': nrm(ks[11], (DN_WIDTH, D_MODEL), DN_WIDTH),
        'w_out': nrm(ks[12], (D_MODEL, D_MODEL), D_MODEL),
        'norm_ffn_g': gain(ks[13], D_MODEL),
        'w_up': nrm(ks[14], (D_MODEL, 2 * D_FF), D_MODEL),
        'ffn_conv_w': nrm(ks[15], (FFN_CONV, D_FF), FFN_CONV),
        'ffn_conv_b': 0.02 * jax.random.normal(ks[16], (D_FF,), f32),
        'w_down': nrm(ks[17], (D_FF, D_MODEL), D_FF),
        'norm_final_g': gain(ks[18], D_MODEL),
    }


def reference(x_prompt, x_sample, norm_mix_g, w_in, conv_qkv_w, a_log_f, a_log_b, dt_bias_f, dt_bias_b,
              out_norm_g, w_branch_a, w_branch_b, w_out, norm_ffn_g, w_up, ffn_conv_w, ffn_conv_b, w_down,
              norm_final_g):
    y_prompt = trunk(x_prompt, norm_mix_g, w_in, conv_qkv_w, a_log_f, a_log_b, dt_bias_f, dt_bias_b, out_norm_g,
                     w_branch_a, w_branch_b, w_out, norm_ffn_g, w_up, ffn_conv_w, ffn_conv_b, w_down, norm_final_g)
    y_sample = trunk(x_sample, norm_mix_g, w_in, conv_qkv_w, a_log_f, a_log_b, dt_bias_f, dt_bias_b, out_norm_g,
                     w_branch_a, w_branch_b, w_out, norm_ffn_g, w_up, ffn_conv_w, ffn_conv_b, w_down, norm_final_g)
    return (y_prompt, y_sample)
```

```cpp
#include <hip/hip_runtime.h>
#include <hip/hip_cooperative_groups.h>
#include <cstdio>
#include <cstdint>
namespace cg = cooperative_groups;
namespace pg8 {
#define PG8_LAS __attribute__((address_space(3)))
typedef unsigned short bf16_t;
typedef short bf16x8 __attribute__((ext_vector_type(8)));
typedef float f32x4 __attribute__((ext_vector_type(4)));
typedef unsigned u32x4 __attribute__((ext_vector_type(4)));
constexpr int BM = 256, BK = 64, HALF = 128, HTB = HALF * BK * 2  , STAGE_BYTES = 8 * HTB, NXCD = 8, WGM = 8;

__host__ __device__ __forceinline__ int lds_byte(int r, int c) { const int st = (r >> 4) * 2 + (c >> 5), rr = r & 15, cc = c & 31, ob = rr * 64 + cc * 2; return st * 1024 + (ob ^ (((ob >> 9) & 1) << 5)); }
__host__ __device__ __forceinline__ void stage_rc(int b, int& R, int& C) { const int st = b / 1024, sb = b % 1024, swz = sb ^ (((sb >> 9) & 1) << 5); R = (st >> 1) * 16 + swz / 64; C = (st & 1) * 32 + (swz % 64) / 2; }
__host__ __device__ __forceinline__ int perm32(int rho) { const int n = rho >> 4, i = rho & 15; return 8 * (i >> 2) + 4 * n + (i & 3); }

struct Unit { int pm, pn; };
struct Gemm { const bf16_t* A; const bf16_t* Bt; int M, N, K; };

struct StaticOrder {
    int nM, nN, nwg, G, c;
    __host__ __device__ void init(int M, int N, int G_, int c_) { nM = M / BM; nN = N / BM; nwg = nM * nN; G = G_; c = c_; }
    __host__ __device__ bool next(int i, Unit& u) const {
        const long L = (long)i * G + c; if (L >= nwg) return false;
        int wgid = (int)L; { const int q = nwg / NXCD, r = nwg % NXCD, xcd = wgid % NXCD, off = wgid / NXCD; wgid = (xcd < r ? xcd * (q + 1) : r * (q + 1) + (xcd - r) * q) + off; }
        const int nig = WGM * nN, gid = wgid / nig, fm = gid * WGM, gsz = (nM - fm) < WGM ? (nM - fm) : WGM;
        u.pm = fm + ((wgid % nig) % gsz); u.pn = (wgid % nig) / gsz; return true;
    }
    __device__ __forceinline__ void a_ready(const Unit&) const {}
    __device__ __forceinline__ void done(const Unit&) const {}
};

__device__ __forceinline__ unsigned cvt_pk_bf16(float lo, float hi) { unsigned r; asm volatile("v_cvt_pk_bf16_f32 %0, %1, %2" : "=v"(r) : "v"(lo), "v"(hi)); return r; }
typedef float f32x2 __attribute__((ext_vector_type(2)));
typedef unsigned u32x2 __attribute__((ext_vector_type(2)));
__device__ __forceinline__ float bflo(unsigned w) { return __uint_as_float(w << 16); }
__device__ __forceinline__ float bfhi(unsigned w) { return __uint_as_float(w & 0xffff0000u); }
__device__ __forceinline__ float sigmoidf_(float x) { return 1.0f / (1.0f + __expf(-x)); }
constexpr float RMS_EPS = 1e-6f;

struct EpiProjA {
    static constexpr bool PERM = true, AFTER_DRAIN = false;
    bf16_t* ATT; bf16_t* DNQ; bf16_t* Z; float* SMALL; const float* rstd;
    __device__ __forceinline__ void operator()(const f32x4 (&acc)[2][2][4][2], const Unit& u, int wr, int wc, int fr, int fq) const {
        const int row0 = u.pm * BM + wr * 64 + fr; const int pn = u.pn;
        bf16_t* base; int ldc, colt;
        if (pn < 18) { base = ATT; ldc = 4608; colt = pn * 256; } else if (pn < 30) { base = DNQ; ldc = 3072; colt = (pn - 18) * 256; } else { base = Z; ldc = 1024; colt = (pn - 30) * 256; }
        const int col0 = colt + wc * 32 + 8 * fq;
#pragma unroll
        for (int ai = 0; ai < 2; ++ai)
#pragma unroll
            for (int m = 0; m < 4; ++m) { const int r = row0 + ai * HALF + m * 16; const float rs = rstd[r];
#pragma unroll
                for (int bj = 0; bj < 2; ++bj) { const f32x4 v0 = acc[ai][bj][m][0] * rs, v1 = acc[ai][bj][m][1] * rs;
                    if (pn < 34) { u32x4 w; w.x = cvt_pk_bf16(v0[0], v0[1]); w.y = cvt_pk_bf16(v0[2], v0[3]); w.z = cvt_pk_bf16(v1[0], v1[1]); w.w = cvt_pk_bf16(v1[2], v1[3]);
                        *(u32x4*)(base + (size_t)r * ldc + col0 + bj * HALF) = w; }
                    else if (bj == 0 && wc == 0) { float* sp = SMALL + (size_t)r * 32 + 8 * fq; *(f32x4*)sp = v0; *(f32x4*)(sp + 4) = v1; } } }
    }
};
struct EpiGates {
    static constexpr bool PERM = true, AFTER_DRAIN = false;
    bf16_t* G; const float* rstd;
    __device__ __forceinline__ void operator()(const f32x4 (&acc)[2][2][4][2], const Unit& u, int wr, int wc, int fr, int fq) const {
        const int row0 = u.pm * BM + wr * 64 + fr; const int col0 = u.pn * BM + wc * 32 + 8 * fq;
#pragma unroll
        for (int ai = 0; ai < 2; ++ai)
#pragma unroll
            for (int m = 0; m < 4; ++m) { const int r = row0 + ai * HALF + m * 16; const float rs = rstd[r];
#pragma unroll
                for (int bj = 0; bj < 2; ++bj) { const f32x4 v0 = acc[ai][bj][m][0] * rs, v1 = acc[ai][bj][m][1] * rs;
                    u32x4 w; w.x = cvt_pk_bf16(sigmoidf_(v0[0]), sigmoidf_(v0[1])); w.y = cvt_pk_bf16(sigmoidf_(v0[2]), sigmoidf_(v0[3])); w.z = cvt_pk_bf16(sigmoidf_(v1[0]), sigmoidf_(v1[1])); w.w = cvt_pk_bf16(sigmoidf_(v1[2]), sigmoidf_(v1[3]));
                    *(u32x4*)(G + (size_t)r * 2048 + col0 + bj * HALF) = w; } }
    }
};
struct EpiF32 {
    static constexpr bool PERM = false, AFTER_DRAIN = false;
    float* C; int ldc;
    __device__ __forceinline__ void operator()(const f32x4 (&acc)[2][2][4][2], const Unit& u, int wr, int wc, int fr, int fq) const {
        const int row0 = u.pm * BM + wr * 64 + fr, col0 = u.pn * BM + wc * 32 + 4 * fq;
#pragma unroll
        for (int ai = 0; ai < 2; ++ai)
#pragma unroll
            for (int m = 0; m < 4; ++m) { float* rowp = C + (size_t)(row0 + ai * HALF + m * 16) * ldc + col0;
#pragma unroll
                for (int bj = 0; bj < 2; ++bj)
#pragma unroll
                    for (int n = 0; n < 2; ++n) *(f32x4*)(rowp + bj * HALF + n * 16) = acc[ai][bj][m][n]; }
    }
};
struct EpiMix {
    static constexpr bool PERM = true, AFTER_DRAIN = false;
    const bf16_t* G; const float* YA; bf16_t* MIX;
    __device__ __forceinline__ void operator()(const f32x4 (&acc)[2][2][4][2], const Unit& u, int wr, int wc, int fr, int fq) const {
        const int row0 = u.pm * BM + wr * 64 + fr; const int col0 = u.pn * BM + wc * 32 + 8 * fq;
#pragma unroll
        for (int ai = 0; ai < 2; ++ai)
#pragma unroll
            for (int m = 0; m < 4; ++m) { const int r = row0 + ai * HALF + m * 16;
#pragma unroll
                for (int bj = 0; bj < 2; ++bj) { const int c = col0 + bj * HALF;
                    const u32x4 ga = *(const u32x4*)(G + (size_t)r * 2048 + c), gb = *(const u32x4*)(G + (size_t)r * 2048 + 1024 + c);
                    const f32x4 y0 = *(const f32x4*)(YA + (size_t)r * 1024 + c), y1 = *(const f32x4*)(YA + (size_t)r * 1024 + c + 4);
                    const f32x4 a0 = acc[ai][bj][m][0], a1 = acc[ai][bj][m][1];
                    u32x4 w;
                    w.x = cvt_pk_bf16(bflo(ga.x) * y0[0] + bflo(gb.x) * a0[0], bfhi(ga.x) * y0[1] + bfhi(gb.x) * a0[1]);
                    w.y = cvt_pk_bf16(bflo(ga.y) * y0[2] + bflo(gb.y) * a0[2], bfhi(ga.y) * y0[3] + bfhi(gb.y) * a0[3]);
                    w.z = cvt_pk_bf16(bflo(ga.z) * y1[0] + bflo(gb.z) * a1[0], bfhi(ga.z) * y1[1] + bfhi(gb.z) * a1[1]);
                    w.w = cvt_pk_bf16(bflo(ga.w) * y1[2] + bflo(gb.w) * a1[2], bfhi(ga.w) * y1[3] + bfhi(gb.w) * a1[3]);
                    *(u32x4*)(MIX + (size_t)r * 1024 + c) = w; } }
    }
};
struct EpiRes {
    static constexpr bool PERM = false, AFTER_DRAIN = false;
    const float* RES; float* OUT; bf16_t* XB; float* ssq;
    __device__ __forceinline__ void operator()(const f32x4 (&acc)[2][2][4][2], const Unit& u, int wr, int wc, int fr, int fq) const {
        const int row0 = u.pm * BM + wr * 64 + fr, col0 = u.pn * BM + wc * 32 + 4 * fq;
#pragma unroll
        for (int ai = 0; ai < 2; ++ai)
#pragma unroll
            for (int m = 0; m < 4; ++m) { const int r = row0 + ai * HALF + m * 16; const size_t off = (size_t)r * 1024 + col0; float s = 0.f;
#pragma unroll
                for (int bj = 0; bj < 2; ++bj)
#pragma unroll
                    for (int n = 0; n < 2; ++n) { const size_t o2 = off + bj * HALF + n * 16; const f32x4 v = *(const f32x4*)(RES + o2) + acc[ai][bj][m][n];
                        *(f32x4*)(OUT + o2) = v; s += (v[0] * v[0] + v[1] * v[1]) + (v[2] * v[2] + v[3] * v[3]);
                        if (XB) { u32x2 w; w.x = cvt_pk_bf16(v[0], v[1]); w.y = cvt_pk_bf16(v[2], v[3]); *(u32x2*)(XB + o2) = w; } }
                s += __shfl_xor(s, 16); s += __shfl_xor(s, 32);
                if (fq == 0) atomicAdd(ssq + r, s); }
    }
};
struct EpiUp {
    static constexpr bool PERM = true, AFTER_DRAIN = false;
    bf16_t* UP; const float* ssq;
    __device__ __forceinline__ void operator()(const f32x4 (&acc)[2][2][4][2], const Unit& u, int wr, int wc, int fr, int fq) const {
        const int row0 = u.pm * BM + wr * 64 + fr; const int col0 = u.pn * BM + wc * 32 + 8 * fq;
#pragma unroll
        for (int ai = 0; ai < 2; ++ai)
#pragma unroll
            for (int m = 0; m < 4; ++m) { const int r = row0 + ai * HALF + m * 16; const float rs = rsqrtf(ssq[r] * (1.0f / 1024.0f) + RMS_EPS);
#pragma unroll
                for (int bj = 0; bj < 2; ++bj) { const f32x4 v0 = acc[ai][bj][m][0] * rs, v1 = acc[ai][bj][m][1] * rs;
                    u32x4 w; w.x = cvt_pk_bf16(v0[0], v0[1]); w.y = cvt_pk_bf16(v0[2], v0[3]); w.z = cvt_pk_bf16(v1[0], v1[1]); w.w = cvt_pk_bf16(v1[2], v1[3]);
                    *(u32x4*)(UP + (size_t)r * 5632 + col0 + bj * HALF) = w; } }
    }
};
template <class Epi, class Sched, bool ALIGN_EPI = false, bool SP2 = false>
__device__ __forceinline__ void gemm_phase(PG8_LAS unsigned char* lds, const Gemm g, const Sched& S, const Epi& E) {
    const int tid = threadIdx.x, wid = __builtin_amdgcn_readfirstlane(tid >> 6), lane = tid & 63, wr = wid >> 2, wc = wid & 3, fr = lane & 15, fq = lane >> 4;
    const int K = g.K, nt = K / BK;
    unsigned voffA[2], voffB[2];
#pragma unroll
    for (int i = 0; i < 2; ++i) { int R, C; stage_rc(tid * 16 + i * 8192, R, C); const int Rb = Epi::PERM ? ((R & ~31) + perm32(R & 31)) : R;
        voffA[i] = (unsigned)(R * K + C) * 2u; voffB[i] = (unsigned)(Rb * K + C) * 2u; }
    const size_t kstep = (size_t)(BK * 2);
    const size_t hstep = (size_t)HALF * K * 2;
    const size_t tstep = 2 * hstep;
    const unsigned ldsw = (unsigned)wid * 1024u;
    const int aoff = lds_byte(wr * 64 + fr, fq * 8), boff = lds_byte(wc * 32 + fr, fq * 8);
#define PG8_SA(b, h) (((b) * 2 + (h)) * HTB)
#define PG8_SB(b, h) ((4 + (b) * 2 + (h)) * HTB)
#define PG8_STAGE(bufoff, gbase, voff) do { _Pragma("unroll") for (int _i = 0; _i < 2; ++_i) \
        __builtin_amdgcn_global_load_lds((const unsigned*)((const char*)(gbase) + (voff)[_i]), (PG8_LAS unsigned*)(lds + (bufoff) + ldsw + _i * 8192), 16, 0, 0); } while (0)
#define PG8_LDA(dst, b, h) do { _Pragma("unroll") for (int m = 0; m < 4; ++m) _Pragma("unroll") for (int k = 0; k < 2; ++k) dst[m][k] = *(const PG8_LAS bf16x8*)(lds + PG8_SA(b, h) + aoff + m * 2048 + k * 1024); } while (0)
#define PG8_LDB(dst, b, h) do { _Pragma("unroll") for (int n = 0; n < 2; ++n) _Pragma("unroll") for (int k = 0; k < 2; ++k) dst[n][k] = *(const PG8_LAS bf16x8*)(lds + PG8_SB(b, h) + boff + n * 2048 + k * 1024); } while (0)
#define PG8_MMA(ai, bj, At, Bt) do { __builtin_amdgcn_s_setprio(1); _Pragma("unroll") for (int m = 0; m < 4; ++m) _Pragma("unroll") for (int n = 0; n < 2; ++n) _Pragma("unroll") for (int k = 0; k < 2; ++k) \
        acc[ai][bj][m][n] = __builtin_amdgcn_mfma_f32_16x16x32_bf16(Bt[n][k], At[m][k], acc[ai][bj][m][n], 0, 0, 0); __builtin_amdgcn_s_setprio(0); } while (0)
#define PG8_WAIT_V(n) asm volatile("s_waitcnt vmcnt(" #n ")" ::: "memory")
#define PG8_WAIT_L(n) asm volatile("s_waitcnt lgkmcnt(" #n ")" ::: "memory")
#define PG8_BAR __builtin_amdgcn_s_barrier()
#define PG8_SCHED __builtin_amdgcn_sched_barrier(0)
    Unit cur, nxt; int ui = 0;
    if (!S.next(0, cur)) return;
    f32x4 acc[2][2][4][2];
#pragma unroll
    for (int a = 0; a < 2; ++a)
#pragma unroll
        for (int b = 0; b < 2; ++b)
#pragma unroll
            for (int m = 0; m < 4; ++m)
#pragma unroll
                for (int n = 0; n < 2; ++n) acc[a][b][m][n] = (f32x4){0.f, 0.f, 0.f, 0.f};
    bf16x8 At[4][2], B0[2][2], B1[2][2];
    const char* cA = (const char*)g.A + (size_t)cur.pm * tstep; const char* cB = (const char*)g.Bt + (size_t)cur.pn * tstep;
    S.a_ready(cur);
    if constexpr (SP2) {
        PG8_STAGE(PG8_SB(0, 0), cB, voffB); PG8_STAGE(PG8_SB(0, 1), cB + hstep, voffB); PG8_STAGE(PG8_SA(0, 0), cA, voffA); PG8_STAGE(PG8_SA(0, 1), cA + hstep, voffA);
        if (wr == 1) PG8_BAR;
        PG8_WAIT_V(2); PG8_BAR;
        PG8_STAGE(PG8_SB(1, 0), cB + kstep, voffB); PG8_STAGE(PG8_SA(1, 0), cA + kstep, voffA); PG8_STAGE(PG8_SB(1, 1), cB + hstep + kstep, voffB);
        PG8_WAIT_V(6); PG8_BAR;
    } else {
        PG8_STAGE(PG8_SB(0, 0), cB, voffB); PG8_STAGE(PG8_SA(0, 0), cA, voffA); PG8_STAGE(PG8_SB(0, 1), cB + hstep, voffB); PG8_STAGE(PG8_SA(0, 1), cA + hstep, voffA);
        if (wr == 1) PG8_BAR;
        PG8_WAIT_V(4); PG8_BAR;
        PG8_STAGE(PG8_SB(1, 0), cB + kstep, voffB); PG8_STAGE(PG8_SA(1, 0), cA + kstep, voffA); PG8_STAGE(PG8_SB(1, 1), cB + hstep + kstep, voffB);
        PG8_WAIT_V(6); PG8_BAR;
    }
    for (;;) {
        const bool has_next = S.next(ui + 1, nxt);
        const char* nA = has_next ? (const char*)g.A + (size_t)nxt.pm * tstep : cA; const char* nB = has_next ? (const char*)g.Bt + (size_t)nxt.pn * tstep : cB;
        for (int t = 0; t < nt; t += 2) {
            const bool last = (t == nt - 2);
            const char* a1 = cA + (size_t)(t + 1) * kstep;
            const char* a2 = last ? nA : cA + (size_t)(t + 2) * kstep; const char* b2 = last ? nB : cB + (size_t)(t + 2) * kstep;
            const char* a3 = a2 + kstep; const char* b3 = b2 + kstep;
            if (last && has_next) S.a_ready(nxt);
            if constexpr (SP2) {
            PG8_LDB(B0, 0, 0); PG8_LDB(B1, 0, 1); PG8_SCHED; PG8_LDA(At, 0, 0); PG8_STAGE(PG8_SA(1, 1), a1 + hstep, voffA);
            PG8_WAIT_V(8); PG8_WAIT_L(0); PG8_BAR; PG8_MMA(0, 0, At, B0); PG8_MMA(0, 1, At, B1); PG8_BAR; PG8_SCHED;
            PG8_LDA(At, 0, 1); PG8_STAGE(PG8_SB(0, 0), b2, voffB); PG8_STAGE(PG8_SB(0, 1), b2 + hstep, voffB); PG8_STAGE(PG8_SA(0, 0), a2, voffA);
            PG8_WAIT_V(8); PG8_WAIT_L(0); PG8_BAR; PG8_MMA(1, 0, At, B0); PG8_MMA(1, 1, At, B1); PG8_BAR; PG8_SCHED;
            PG8_LDB(B0, 1, 0); PG8_LDB(B1, 1, 1); PG8_SCHED; PG8_LDA(At, 1, 0); PG8_STAGE(PG8_SA(0, 1), a2 + hstep, voffA);
            PG8_WAIT_V(8); PG8_WAIT_L(0); PG8_BAR; PG8_MMA(0, 0, At, B0); PG8_MMA(0, 1, At, B1); PG8_BAR; PG8_SCHED;
            PG8_LDA(At, 1, 1); PG8_STAGE(PG8_SB(1, 0), b3, voffB); PG8_STAGE(PG8_SB(1, 1), b3 + hstep, voffB); PG8_STAGE(PG8_SA(1, 0), a3, voffA);
            PG8_WAIT_V(8); PG8_WAIT_L(0); PG8_BAR; PG8_MMA(1, 0, At, B0); PG8_MMA(1, 1, At, B1); PG8_BAR; PG8_SCHED;
            } else {
            PG8_LDB(B0, 0, 0); PG8_SCHED; PG8_LDA(At, 0, 0); PG8_STAGE(PG8_SA(1, 1), a1 + hstep, voffA);
            PG8_WAIT_L(8); PG8_BAR; PG8_WAIT_L(0); PG8_MMA(0, 0, At, B0); PG8_BAR; PG8_SCHED;
            PG8_LDB(B1, 0, 1); PG8_STAGE(PG8_SB(0, 0), b2, voffB);
            PG8_BAR; PG8_WAIT_L(0); PG8_MMA(0, 1, At, B1); PG8_BAR;
            PG8_LDA(At, 0, 1); PG8_STAGE(PG8_SA(0, 0), a2, voffA);
            PG8_BAR; PG8_WAIT_L(0); PG8_MMA(1, 0, At, B0); PG8_BAR; PG8_SCHED;
            PG8_STAGE(PG8_SB(0, 1), b2 + hstep, voffB);
            PG8_WAIT_V(6); PG8_BAR; PG8_MMA(1, 1, At, B1); PG8_BAR;
            PG8_LDB(B0, 1, 0); PG8_SCHED; PG8_LDA(At, 1, 0); PG8_STAGE(PG8_SA(0, 1), a2 + hstep, voffA);
            PG8_WAIT_L(8); PG8_BAR; PG8_WAIT_L(0); PG8_MMA(0, 0, At, B0); PG8_BAR; PG8_SCHED;
            PG8_LDB(B1, 1, 1); PG8_STAGE(PG8_SB(1, 0), b3, voffB);
            PG8_BAR; PG8_WAIT_L(0); PG8_MMA(0, 1, At, B1); PG8_BAR;
            PG8_LDA(At, 1, 1); PG8_STAGE(PG8_SA(1, 0), a3, voffA);
            PG8_BAR; PG8_WAIT_L(0); PG8_MMA(1, 0, At, B0); PG8_BAR; PG8_SCHED;
            PG8_STAGE(PG8_SB(1, 1), b3 + hstep, voffB);
            PG8_WAIT_V(6); PG8_BAR; PG8_MMA(1, 1, At, B1); PG8_BAR;
            }
        }
        if constexpr (ALIGN_EPI) { if (wr == 0) PG8_BAR; }
        if constexpr (!Epi::AFTER_DRAIN) { E(acc, cur, wr, wc, fr, fq); S.done(cur); }
        if (!has_next) break;
#pragma unroll
        for (int a = 0; a < 2; ++a)
#pragma unroll
            for (int b = 0; b < 2; ++b)
#pragma unroll
                for (int m = 0; m < 4; ++m)
#pragma unroll
                    for (int n = 0; n < 2; ++n) acc[a][b][m][n] = (f32x4){0.f, 0.f, 0.f, 0.f};
        cur = nxt; cA = nA; cB = nB; ++ui;
        if constexpr (ALIGN_EPI) { if (wr == 1) PG8_BAR; }
    }
    PG8_WAIT_V(0);
    if constexpr (!ALIGN_EPI) { if (wr == 0) PG8_BAR; }
    PG8_BAR;
    if constexpr (Epi::AFTER_DRAIN) { E.fused(acc, cur, wr, wc, fr, fq, lds, wid, lane); S.done(cur); }
#undef PG8_SA
#undef PG8_SB
#undef PG8_STAGE
#undef PG8_LDA
#undef PG8_LDB
#undef PG8_MMA
#undef PG8_WAIT_V
#undef PG8_WAIT_L
#undef PG8_BAR
#undef PG8_SCHED
}
}

#define LAS __attribute__((address_space(3)))
typedef unsigned short bf16;
typedef float f32x4 __attribute__((ext_vector_type(4)));
typedef unsigned v4u __attribute__((ext_vector_type(4)));
typedef unsigned v2u __attribute__((ext_vector_type(2)));
using pg8::cvt_pk_bf16; using pg8::bflo; using pg8::bfhi;

constexpr int NWAVES = 8, NTHREADS = 512;
constexpr int D = 1024, NTOK = 49152, TG = 16384, NGROUPS = 3;
constexpr int ATTW = 4608, DNW = 3072, NPA = 8960  , NIN_T = 11008, DFF = 2816, NUP = 5632;
constexpr float EPS = 1e-6f;

constexpr size_t MiB = 1u << 20;
constexpr size_t WS_CTL = 0, CTL_BYTES = 1 * MiB;
constexpr size_t CTL_SSQ2 = 256 * 1024, CTL_SSQ3 = 512 * 1024;
constexpr size_t WS_WIN = 1 * MiB, WS_WUP = 23 * MiB, WS_WDOWN = 34 * MiB, WS_WOUT = 40 * MiB, WS_WA = 42 * MiB, WS_WB = 43 * MiB;
constexpr size_t WS_ROPE = 45 * MiB, WS_RSTD1 = 46 * MiB, WS_XB = 48 * MiB, WS_ARENA = 144 * MiB, WS_END = 512 * MiB;
constexpr size_t AR_ATT = 0, AR_DNQ = 144 * MiB, AR_Z = 240 * MiB, AR_SMALL = 272 * MiB, AR_GATE = 274 * MiB, AR_AO = 276 * MiB, AR_MIX = 292 * MiB;
constexpr size_t AR_CONV = 0;
constexpr size_t AR_OF = 144 * MiB, AR_OB = 176 * MiB, AR_DNOUT = 208 * MiB;
constexpr size_t AR_G = 0, AR_YA = 64 * MiB;
constexpr size_t AR_UP = 0, AR_ACT = 176 * MiB;
static_assert(WS_ARENA + AR_MIX + 32 * MiB <= WS_END, "ws map");

struct Args { const float* in[19]; float* out; unsigned char* ws; int lo, hi; };

__device__ __forceinline__ float wave_sum(float v) {
#pragma unroll
    for (int o = 1; o < 64; o <<= 1) v += __shfl_xor(v, o);
    return v;
}
__device__ __forceinline__ float bf2f(bf16 u) { return __uint_as_float((unsigned)u << 16); }
__device__ __forceinline__ float siluf_(float x) { return x / (1.0f + __expf(-x)); }

__device__ __forceinline__ void p0_transpose_item(const float* W, int ldw, int col_off, int K, int ncols, const float* gain, bf16* WT, int row_off, LAS float* scr, int item, int lane) {
    const int nblk = ncols / 32, kb = item / nblk, nb = item % nblk, k0 = 64 * kb, n0 = 32 * nb;
#pragma unroll 8
    for (int i = 0; i < 32; ++i) { const int kk = 2 * i + (lane >> 5); float w = W[(size_t)(k0 + kk) * ldw + col_off + n0 + (lane & 31)]; if (gain) w *= gain[k0 + kk]; scr[kk * 33 + (lane & 31)] = w; }
    asm volatile("s_waitcnt lgkmcnt(0)" ::: "memory");
    const int c = lane & 7;
#pragma unroll
    for (int j = 0; j < 4; ++j) { const int n = (lane >> 3) + 8 * j; const LAS float* s = scr + (8 * c) * 33 + n;
        v4u o; o.x = cvt_pk_bf16(s[0 * 33], s[1 * 33]); o.y = cvt_pk_bf16(s[2 * 33], s[3 * 33]); o.z = cvt_pk_bf16(s[4 * 33], s[5 * 33]); o.w = cvt_pk_bf16(s[6 * 33], s[7 * 33]);
        *(v4u*)(WT + (size_t)(row_off + n0 + n) * K + k0 + 8 * c) = o; }
    asm volatile("s_waitcnt lgkmcnt(0)" ::: "memory");
}

struct Ptrs {
    const float *x_p, *x_s, *norm_mix_g, *w_in, *conv_w, *a_log_f, *a_log_b, *dt_f, *dt_b, *out_norm_g, *w_a, *w_b, *w_out, *norm_ffn_g, *w_up, *ffn_conv_w, *ffn_conv_b, *w_down, *norm_final_g;
    float* out; unsigned char* ws;
};
__device__ __forceinline__ const float* x_row(const Ptrs& P, int tok) { return tok < 32768 ? P.x_p + (size_t)tok * D : P.x_s + (size_t)(tok - 32768) * D; }

__device__ __forceinline__ void phase_prologue(const Ptrs& P, unsigned char* lds, int bid, int G) {
    const int tid = threadIdx.x, lane = tid & 63, wave = tid >> 6;
    LAS float* scr = (LAS float*)((LAS unsigned char*)lds + wave * 16384);
    const int gw = bid * NWAVES + wave, NGW = G * NWAVES;
    bf16* Win = (bf16*)(P.ws + WS_WIN); bf16* Wup = (bf16*)(P.ws + WS_WUP); bf16* Wdn = (bf16*)(P.ws + WS_WDOWN); bf16* Wout = (bf16*)(P.ws + WS_WOUT); bf16* Wa = (bf16*)(P.ws + WS_WA); bf16* Wb = (bf16*)(P.ws + WS_WB);
    constexpr int I1 = 16 * 273, I2 = 16 * 64, I3 = 8 * 32, I4 = 16 * 32, I5 = 16 * 32, I6 = 16 * 176, I7 = 44 * 32;
    constexpr int NIT = I1 + I2 + I3 + I4 + I5 + I6 + I7;
    for (int it = gw; it < NIT; it += NGW) {
        int r = it;
        if (r < I1) { p0_transpose_item(P.w_in, 10784, 0, 1024, 8736, P.norm_mix_g, Win, 0, scr, r, lane); continue; } r -= I1;
        if (r < I2) { p0_transpose_item(P.w_in, 10784, 8736, 1024, 2048, P.norm_mix_g, Win, 8960, scr, r, lane); continue; } r -= I2;
        if (r < I3) { p0_transpose_item(P.w_a, 1024, 0, 512, 1024, nullptr, Wa, 0, scr, r, lane); continue; } r -= I3;
        if (r < I4) { p0_transpose_item(P.w_b, 1024, 0, 1024, 1024, nullptr, Wb, 0, scr, r, lane); continue; } r -= I4;
        if (r < I5) { p0_transpose_item(P.w_out, 1024, 0, 1024, 1024, nullptr, Wout, 0, scr, r, lane); continue; } r -= I5;
        if (r < I6) { p0_transpose_item(P.w_up, 5632, 0, 1024, 5632, P.norm_ffn_g, Wup, 0, scr, r, lane); continue; } r -= I6;
        p0_transpose_item(P.w_down, 1024, 0, 2816, 1024, nullptr, Wdn, 0, scr, r, lane);
    }
    const int gt = bid * NTHREADS + tid, NGT = G * NTHREADS;
    for (int i = gt; i < 28672; i += NGT) ((v4u*)(Win + (size_t)8736 * 1024))[i] = (v4u){0u, 0u, 0u, 0u};
    float* ropeC = (float*)(P.ws + WS_ROPE); float* ropeS = ropeC + 4096 * 8;
    for (int i = gt; i < 4096 * 8; i += NGT) { const int pos = i >> 3, j = i & 7;
        const float inv = (float)exp(-(double)j * 0.125 * log(500000.0)); const float ang = (float)pos * inv;
        ropeC[i] = (float)cos((double)ang); ropeS[i] = (float)sin((double)ang); }
    bf16* XB = (bf16*)(P.ws + WS_XB); float* rstd1 = (float*)(P.ws + WS_RSTD1);
    for (int m = gw; m < NTOK; m += NGW) {
        const f32x4* xr = (const f32x4*)x_row(P, m) + lane; f32x4 v[4]; float s = 0.f;
#pragma unroll
        for (int j = 0; j < 4; ++j) { v[j] = xr[64 * j]; s += (v[j].x * v[j].x + v[j].y * v[j].y) + (v[j].z * v[j].z + v[j].w * v[j].w); }
        s = wave_sum(s);
        if (lane == 0) rstd1[m] = rsqrtf(s * (1.0f / 1024.0f) + EPS);
        unsigned long long* o8 = (unsigned long long*)(XB + (size_t)m * D) + lane;
#pragma unroll
        for (int j = 0; j < 4; ++j) o8[64 * j] = (unsigned long long)cvt_pk_bf16(v[j].x, v[j].y) | ((unsigned long long)cvt_pk_bf16(v[j].z, v[j].w) << 32);
    }
}

__device__ __forceinline__ void load8bf(const bf16* p, float* o) { const v4u w = *(const v4u*)p; o[0] = bflo(w.x); o[1] = bfhi(w.x); o[2] = bflo(w.y); o[3] = bfhi(w.y); o[4] = bflo(w.z); o[5] = bfhi(w.z); o[6] = bflo(w.w); o[7] = bfhi(w.w); }
__device__ __forceinline__ void phase_attn_naive(const bf16* ATT, bf16* AO, const float* ropeC, const float* ropeS, int S, int gt, int NGT) {
    for (int item = gt; item < TG * 8; item += NGT) {
        const int tok = item % TG, hg = item / TG; const int pos = tok % S, seq0 = tok - pos;
        float mrun = -1e30f, l = 0.f; float o[64];
#pragma unroll
        for (int d = 0; d < 64; ++d) o[d] = 0.f;
        for (int gi = 0; gi < 3; ++gi) {
            const int h = gi * 8 + hg, dil = (gi == 0) ? 1 : (gi == 1) ? 4 : 16;
            float q[64];
#pragma unroll
            for (int c = 0; c < 8; ++c) load8bf(ATT + (size_t)tok * ATTW + h * 64 + c * 8, q + c * 8);
#pragma unroll
            for (int i = 0; i < 8; ++i) { const float cs = ropeC[pos * 8 + i], sn = ropeS[pos * 8 + i], t1 = q[i], t2 = q[i + 8]; q[i] = t1 * cs - t2 * sn; q[i + 8] = t2 * cs + t1 * sn; }
            for (int mm = -64; mm <= 64; ++mm) {
                const int p2 = pos + mm * dil; if (p2 < 0 || p2 >= S) continue;
                const bf16* kr = ATT + (size_t)(seq0 + p2) * ATTW + 1536 + h * 64; float s = 0.f;
                { float k0[16]; load8bf(kr, k0); load8bf(kr + 8, k0 + 8);
#pragma unroll
                  for (int i = 0; i < 8; ++i) { const float cs = ropeC[p2 * 8 + i], sn = ropeS[p2 * 8 + i], t1 = k0[i], t2 = k0[i + 8]; s += q[i] * (t1 * cs - t2 * sn) + q[i + 8] * (t2 * cs + t1 * sn); } }
#pragma unroll
                for (int c = 2; c < 8; ++c) { float kk[8]; load8bf(kr + c * 8, kk);
#pragma unroll
                    for (int e = 0; e < 8; ++e) s += q[c * 8 + e] * kk[e]; }
                s *= 0.125f;
                const float mn = fmaxf(mrun, s), sc = __expf(mrun - mn), p = __expf(s - mn); mrun = mn; l = l * sc + p;
                const bf16* vr = ATT + (size_t)(seq0 + p2) * ATTW + 3072 + h * 64;
#pragma unroll
                for (int c = 0; c < 8; ++c) { float vv[8]; load8bf(vr + c * 8, vv);
#pragma unroll
                    for (int e = 0; e < 8; ++e) o[c * 8 + e] = o[c * 8 + e] * sc + p * vv[e]; }
            }
        }
        const float il = 1.0f / l; bf16* op = AO + (size_t)tok * 512 + hg * 64;
#pragma unroll
        for (int c = 0; c < 8; ++c) { v4u w; w.x = cvt_pk_bf16(o[c * 8] * il, o[c * 8 + 1] * il); w.y = cvt_pk_bf16(o[c * 8 + 2] * il, o[c * 8 + 3] * il); w.z = cvt_pk_bf16(o[c * 8 + 4] * il, o[c * 8 + 5] * il); w.w = cvt_pk_bf16(o[c * 8 + 6] * il, o[c * 8 + 7] * il); *(v4u*)(op + c * 8) = w; }
    }
}

__device__ __forceinline__ void phase_dnprep_naive(const Ptrs& P, const bf16* DNQ, const float* SMALL, bf16* CONV, float* GATE, int S, int gw, int NGW, int gt, int NGT, int lane) {
    for (int item = gw; item < TG * 24; item += NGW) {
        const int tok = item / 24, part = item % 24; const int pos = tok % S; const int c = part * 128 + lane * 2;
        float a0 = 0.f, a1 = 0.f;
#pragma unroll
        for (int i = 0; i < 5; ++i) { const int p2 = pos + i - 2; if (p2 >= 0 && p2 < S) { const unsigned w = *(const unsigned*)(DNQ + (size_t)(tok + i - 2) * DNW + c);
                a0 += bflo(w) * P.conv_w[i * DNW + c]; a1 += bfhi(w) * P.conv_w[i * DNW + c + 1]; } }
        a0 = siluf_(a0); a1 = siluf_(a1);
        if (part < 16) { const float ss = wave_sum(a0 * a0 + a1 * a1); float sc = rsqrtf(ss + EPS); if (part < 8) sc *= 0.08838834764831845f; a0 *= sc; a1 *= sc; }
        *(unsigned*)(CONV + (size_t)tok * DNW + c) = cvt_pk_bf16(a0, a1);
    }
    for (int i = gt; i < TG * 32; i += NGT) { const int j = i & 31, h = j & 7; const float s = SMALL[i]; float r;
        if (j < 16) r = 1.0f / (1.0f + expf(-s));
        else { const float al = (j < 24) ? P.a_log_f[h] : P.a_log_b[h], db = (j < 24) ? P.dt_f[h] : P.dt_b[h]; const float xx = s + db; const float sp = (xx > 20.f) ? xx : log1pf(expf(xx)); r = -expf(al) * sp; }
        GATE[i] = r; }
}

__device__ __forceinline__ void phase_scan_naive(const bf16* CONV, const float* GATE, bf16* OF, bf16* OB, int S, unsigned char* lds, int bid, int G) {
    const int tid = threadIdx.x, cl = tid >> 7, col = tid & 127; const int nchain = (TG / S) * 16;
    float* qs = (float*)lds + cl * 4096; float* ks = qs + 2048;
    for (int cb = bid; cb * 4 < nchain; cb += G) {
        const int chain = cb * 4 + cl; const int dir = chain & 1, h = (chain >> 1) & 7, b = chain >> 4;
        float St[128];
#pragma unroll
        for (int k = 0; k < 128; ++k) St[k] = 0.f;
        bf16* O = dir ? OB : OF;
        for (int tb = 0; tb < S; tb += 16) {
            __syncthreads();
#pragma unroll
            for (int i = 0; i < 16; ++i) { const int t = dir ? (S - 1 - (tb + i)) : (tb + i); const size_t row = (size_t)(b * S + t) * DNW;
                qs[i * 128 + col] = bf2f(CONV[row + h * 128 + col]); ks[i * 128 + col] = bf2f(CONV[row + 1024 + h * 128 + col]); }
            __syncthreads();
            for (int i = 0; i < 16; ++i) { const int t = dir ? (S - 1 - (tb + i)) : (tb + i); const size_t tokr = (size_t)(b * S + t);
                const float g = GATE[tokr * 32 + 16 + dir * 8 + h], beta = GATE[tokr * 32 + dir * 8 + h]; const float dec = expf(g);
                const float v = bf2f(CONV[tokr * DNW + 2048 + h * 128 + col]);
                float dot = 0.f;
#pragma unroll
                for (int k = 0; k < 128; ++k) { St[k] *= dec; dot += ks[i * 128 + k] * St[k]; }
                const float vn = beta * (v - dot); float o = 0.f;
#pragma unroll
                for (int k = 0; k < 128; ++k) { St[k] += ks[i * 128 + k] * vn; o += qs[i * 128 + k] * St[k]; }
                O[tokr * 1024 + h * 128 + col] = (bf16)(cvt_pk_bf16(o, 0.f) & 0xffffu); }
        }
    }
}

__device__ __forceinline__ void phase_combine(const Ptrs& P, const bf16* OF, const bf16* OB, const bf16* Z, bf16* DNOUT, int gw, int NGW, int lane) {
    for (int item = gw; item < TG * 8; item += NGW) { const size_t off = (size_t)item * 128 + lane * 2;
        const unsigned a = *(const unsigned*)(OF + off), b = *(const unsigned*)(OB + off), z = *(const unsigned*)(Z + off);
        const float o0 = bflo(a) + bflo(b), o1 = bfhi(a) + bfhi(b); const float ss = wave_sum(o0 * o0 + o1 * o1); const float rs = rsqrtf(ss * (1.0f / 128.0f) + EPS);
        const float y0 = o0 * rs * P.out_norm_g[lane * 2] * siluf_(bflo(z)), y1 = o1 * rs * P.out_norm_g[lane * 2 + 1] * siluf_(bfhi(z));
        *(unsigned*)(DNOUT + off) = cvt_pk_bf16(y0, y1); }
}

__device__ __forceinline__ float gelu_erf(float v) { return 0.5f * v * (1.0f + erff(v * 0.70710678118654752f)); }
__device__ __forceinline__ void phase_act_naive(const Ptrs& P, const bf16* UP, bf16* ACT, int S, int gt, int NGT) {
    for (int item = gt; item < TG * (DFF / 8); item += NGT) { const int tok = item / (DFF / 8), c = (item % (DFF / 8)) * 8; const int pos = tok % S;
        float a[8], vv[8];
#pragma unroll
        for (int e = 0; e < 8; ++e) a[e] = P.ffn_conv_b[c + e];
#pragma unroll
        for (int i = 0; i < 3; ++i) { const int p2 = pos + i - 1; if (p2 >= 0 && p2 < S) { float g[8]; load8bf(UP + (size_t)(tok + i - 1) * NUP + c, g);
#pragma unroll
                for (int e = 0; e < 8; ++e) a[e] += g[e] * P.ffn_conv_w[i * DFF + c + e]; } }
        load8bf(UP + (size_t)tok * NUP + DFF + c, vv);
#pragma unroll
        for (int e = 0; e < 8; ++e) a[e] = gelu_erf(a[e]) * vv[e];
        v4u w; w.x = cvt_pk_bf16(a[0], a[1]); w.y = cvt_pk_bf16(a[2], a[3]); w.z = cvt_pk_bf16(a[4], a[5]); w.w = cvt_pk_bf16(a[6], a[7]);
        *(v4u*)(ACT + (size_t)tok * DFF + c) = w; }
}

__device__ __forceinline__ void phase_final(const Ptrs& P, const float* ssq3, int gw, int NGW, int lane) {
    for (int m = gw; m < NTOK; m += NGW) { const float rs = rsqrtf(ssq3[m] * (1.0f / 1024.0f) + EPS); f32x4* xr = (f32x4*)(P.out + (size_t)m * D) + lane; const f32x4* gr = (const f32x4*)P.norm_final_g + lane;
#pragma unroll
        for (int j = 0; j < 4; ++j) xr[64 * j] = xr[64 * j] * rs * gr[64 * j]; }
}

#define EN(k) (ONLYK < 0 || ONLYK == (k))
constexpr int LDS_BYTES = 147456;
constexpr int STEPS_PER_GROUP = 12, NSTEPS = 1 + NGROUPS * STEPS_PER_GROUP + 1;

template <int ONLYK> __global__ void __launch_bounds__(NTHREADS, 2) fwd(Args args) {
    extern __shared__ __attribute__((aligned(16))) unsigned char lds[];
    Ptrs P;
    P.x_p = args.in[0]; P.x_s = args.in[1]; P.norm_mix_g = args.in[2]; P.w_in = args.in[3]; P.conv_w = args.in[4]; P.a_log_f = args.in[5]; P.a_log_b = args.in[6]; P.dt_f = args.in[7]; P.dt_b = args.in[8];
    P.out_norm_g = args.in[9]; P.w_a = args.in[10]; P.w_b = args.in[11]; P.w_out = args.in[12]; P.norm_ffn_g = args.in[13]; P.w_up = args.in[14]; P.ffn_conv_w = args.in[15]; P.ffn_conv_b = args.in[16]; P.w_down = args.in[17]; P.norm_final_g = args.in[18];
    P.out = args.out; P.ws = args.ws;
    const int tid = threadIdx.x, lane = tid & 63, wave = tid >> 6; const int bid = blockIdx.x, G = gridDim.x;
    const int gw = bid * NWAVES + wave, NGW = G * NWAVES, gt = bid * NTHREADS + tid, NGT = G * NTHREADS;
    unsigned char* ws = args.ws; unsigned char* ar = ws + WS_ARENA;
    bf16* Win = (bf16*)(ws + WS_WIN); bf16* Wup = (bf16*)(ws + WS_WUP); bf16* Wdn = (bf16*)(ws + WS_WDOWN); bf16* Wout = (bf16*)(ws + WS_WOUT); bf16* Wa = (bf16*)(ws + WS_WA); bf16* Wb = (bf16*)(ws + WS_WB);
    const float* ropeC = (const float*)(ws + WS_ROPE); const float* ropeS = ropeC + 4096 * 8;
    float* ssq2 = (float*)(ws + WS_CTL + CTL_SSQ2); float* ssq3 = (float*)(ws + WS_CTL + CTL_SSQ3);
    cg::grid_group grid = cg::this_grid();
    for (int step = args.lo; step < args.hi; ++step) {
        if (step == 0) {
if constexpr (EN(100)) {
            phase_prologue(P, lds, bid, G);
}
        } else if (step == NSTEPS - 1) {
if constexpr (EN(101)) {
            phase_final(P, ssq3, gw, NGW, lane);
}
        } else {
            const int g = (step - 1) / STEPS_PER_GROUP, k = (step - 1) % STEPS_PER_GROUP; const int t0 = g * TG; const int S = (g < 2) ? 2048 : 4096;
            bf16* XBg = (bf16*)(ws + WS_XB) + (size_t)t0 * D; const float* rstd1 = (const float*)(ws + WS_RSTD1) + t0;
            bf16* ATT = (bf16*)(ar + AR_ATT); bf16* DNQ = (bf16*)(ar + AR_DNQ); bf16* Z = (bf16*)(ar + AR_Z); float* SMALL = (float*)(ar + AR_SMALL); float* GATE = (float*)(ar + AR_GATE);
            bf16* AO = (bf16*)(ar + AR_AO); bf16* MIX = (bf16*)(ar + AR_MIX); bf16* CONV = (bf16*)(ar + AR_CONV); bf16* OF = (bf16*)(ar + AR_OF); bf16* OB = (bf16*)(ar + AR_OB); bf16* DNOUT = (bf16*)(ar + AR_DNOUT);
            bf16* Gt = (bf16*)(ar + AR_G); float* YA = (float*)(ar + AR_YA); bf16* UP = (bf16*)(ar + AR_UP); bf16* ACT = (bf16*)(ar + AR_ACT);
            float* OUTg = P.out + (size_t)t0 * D;
            if (k == 0) {
if constexpr (EN(0)) {
                pg8::Gemm gm{XBg, Win, TG, NPA, D}; pg8::StaticOrder So; So.init(TG, NPA, G, bid); pg8::EpiProjA E{ATT, DNQ, Z, SMALL, rstd1};
                pg8::gemm_phase<pg8::EpiProjA, pg8::StaticOrder, true, true>((LAS unsigned char*)lds, gm, So, E);
}
            } else if (k == 1) {
if constexpr (EN(1)) {
                phase_attn_naive(ATT, AO, ropeC, ropeS, S, gt, NGT);
}
            } else if (k == 2) {
if constexpr (EN(2)) {
                phase_dnprep_naive(P, DNQ, SMALL, CONV, GATE, S, gw, NGW, gt, NGT, lane);
}
            } else if (k == 3) {
if constexpr (EN(3)) {
                phase_scan_naive(CONV, GATE, OF, OB, S, lds, bid, G);
}
            } else if (k == 4) {
if constexpr (EN(4)) {
                phase_combine(P, OF, OB, Z, DNOUT, gw, NGW, lane);
}
            } else if (k == 5) {
if constexpr (EN(5)) {
                pg8::Gemm gm{XBg, Win + (size_t)NPA * D, TG, 2048, D}; pg8::StaticOrder So; So.init(TG, 2048, G, bid); pg8::EpiGates E{Gt, rstd1};
                pg8::gemm_phase<pg8::EpiGates, pg8::StaticOrder, true, true>((LAS unsigned char*)lds, gm, So, E);
}
            } else if (k == 6) {
if constexpr (EN(6)) {
                pg8::Gemm gm{AO, Wa, TG, D, 512}; pg8::StaticOrder So; So.init(TG, D, G, bid); pg8::EpiF32 E{YA, D};
                pg8::gemm_phase<pg8::EpiF32, pg8::StaticOrder, true, true>((LAS unsigned char*)lds, gm, So, E);
}
            } else if (k == 7) {
if constexpr (EN(7)) {
                pg8::Gemm gm{DNOUT, Wb, TG, D, D}; pg8::StaticOrder So; So.init(TG, D, G, bid); pg8::EpiMix E{Gt, YA, MIX};
                pg8::gemm_phase<pg8::EpiMix, pg8::StaticOrder, true, true>((LAS unsigned char*)lds, gm, So, E);
}
            } else if (k == 8) {
if constexpr (EN(8)) {
                pg8::Gemm gm{MIX, Wout, TG, D, D}; pg8::StaticOrder So; So.init(TG, D, G, bid);
                const float* RES = (g < 2) ? P.x_p + (size_t)t0 * D : P.x_s; pg8::EpiRes E{RES, OUTg, XBg, ssq2 + t0};
                pg8::gemm_phase<pg8::EpiRes, pg8::StaticOrder, true, true>((LAS unsigned char*)lds, gm, So, E);
}
            } else if (k == 9) {
if constexpr (EN(9)) {
                pg8::Gemm gm{XBg, Wup, TG, NUP, D}; pg8::StaticOrder So; So.init(TG, NUP, G, bid); pg8::EpiUp E{UP, ssq2 + t0};
                pg8::gemm_phase<pg8::EpiUp, pg8::StaticOrder, true, true>((LAS unsigned char*)lds, gm, So, E);
}
            } else if (k == 10) {
if constexpr (EN(10)) {
                phase_act_naive(P, UP, ACT, S, gt, NGT);
}
            } else {
if constexpr (EN(11)) {
                pg8::Gemm gm{ACT, Wdn, TG, D, DFF}; pg8::StaticOrder So; So.init(TG, D, G, bid); pg8::EpiRes E{OUTg, OUTg, nullptr, ssq3 + t0};
                pg8::gemm_phase<pg8::EpiRes, pg8::StaticOrder, true, true>((LAS unsigned char*)lds, gm, So, E);
}
            }
        }
        if (step + 1 < args.hi) grid.sync();
    }
}

template <int KK> static void launch_kind(int grid, hipStream_t stream, Args a) { hipLaunchKernelGGL(fwd<KK>, dim3(grid), dim3(NTHREADS), LDS_BYTES, stream, a); }
template <int KK> static bool set_lds() { return hipFuncSetAttribute((const void*)fwd<KK>, hipFuncAttributeMaxDynamicSharedMemorySize, LDS_BYTES) == hipSuccess; }
extern "C" void kernel_launch(void* const* d_in, const int* in_sizes, int n_in, void* d_out, int out_size, void* d_ws, size_t ws_size, hipStream_t stream) {
    static int grid = 0;
    if (grid == 0) {
        if (n_in != 19 || ws_size < WS_END) { fprintf(stderr, "kernel_launch: unexpected n_in %d / ws_size %zu (need %zu)\n", n_in, ws_size, (size_t)WS_END); grid = -1; return; }
        bool ok = set_lds<0>() && set_lds<1>() && set_lds<2>() && set_lds<3>() && set_lds<4>() && set_lds<5>() && set_lds<6>() && set_lds<7>() && set_lds<8>() && set_lds<9>() && set_lds<10>() && set_lds<11>() && set_lds<100>() && set_lds<101>();
        if (!ok) { fprintf(stderr, "kernel_launch: hipFuncSetAttribute failed\n"); grid = -1; return; }
        int dev = 0, cus = 0; (void)hipGetDevice(&dev); (void)hipDeviceGetAttribute(&cus, hipDeviceAttributeMultiprocessorCount, dev);
        grid = cus > 0 ? cus : 256;
    }
    if (grid < 0) return;
    (void)hipMemsetAsync((char*)d_ws + WS_CTL, 0, CTL_BYTES, stream);
    Args a{};
    for (int i = 0; i < 19; ++i) a.in[i] = (const float*)d_in[i];
    a.out = (float*)d_out; a.ws = (unsigned char*)d_ws;
    for (int s = 0; s < NSTEPS; ++s) { a.lo = s; a.hi = s + 1;
        if (s == 0) launch_kind<100>(grid, stream, a); else if (s == NSTEPS - 1) launch_kind<101>(grid, stream, a);
        else switch ((s - 1) % STEPS_PER_GROUP) {
            case 0: launch_kind<0>(grid, stream, a); break; case 1: launch_kind<1>(grid, stream, a); break; case 2: launch_kind<2>(grid, stream, a); break; case 3: launch_kind<3>(grid, stream, a); break;
            case 4: launch_kind<4>(grid, stream, a); break; case 5: launch_kind<5>(grid, stream, a); break; case 6: launch_kind<6>(grid, stream, a); break; case 7: launch_kind<7>(grid, stream, a); break;
            case 8: launch_kind<8>(grid, stream, a); break; case 9: launch_kind<9>(grid, stream, a); break; case 10: launch_kind<10>(grid, stream, a); break; default: launch_kind<11>(grid, stream, a); break; }
    }
}
```

```cpp
#include <hip/hip_runtime.h>
#include <hip/hip_cooperative_groups.h>
#include <cstdio>
#include <cstdint>
namespace cg = cooperative_groups;
namespace pg8 {
#define PG8_LAS __attribute__((address_space(3)))
typedef unsigned short bf16_t;
typedef short bf16x8 __attribute__((ext_vector_type(8)));
typedef float f32x4 __attribute__((ext_vector_type(4)));
typedef unsigned u32x4 __attribute__((ext_vector_type(4)));
constexpr int BM = 256, BK = 64, HALF = 128, HTB = HALF * BK * 2  , STAGE_BYTES = 8 * HTB, NXCD = 8, WGM = 8;

__host__ __device__ __forceinline__ int lds_byte(int r, int c) { const int st = (r >> 4) * 2 + (c >> 5), rr = r & 15, cc = c & 31, ob = rr * 64 + cc * 2; return st * 1024 + (ob ^ (((ob >> 9) & 1) << 5)); }
__host__ __device__ __forceinline__ void stage_rc(int b, int& R, int& C) { const int st = b / 1024, sb = b % 1024, swz = sb ^ (((sb >> 9) & 1) << 5); R = (st >> 1) * 16 + swz / 64; C = (st & 1) * 32 + (swz % 64) / 2; }
__host__ __device__ __forceinline__ int perm32(int rho) { const int n = rho >> 4, i = rho & 15; return 8 * (i >> 2) + 4 * n + (i & 3); }

struct Unit { int pm, pn; };
struct Gemm { const bf16_t* A; const bf16_t* Bt; int M, N, K; };

struct StaticOrder {
    int nM, nN, nwg, G, c;
    __host__ __device__ void init(int M, int N, int G_, int c_) { nM = M / BM; nN = N / BM; nwg = nM * nN; G = G_; c = c_; }
    __host__ __device__ bool next(int i, Unit& u) const {
        const long L = (long)i * G + c; if (L >= nwg) return false;
        int wgid = (int)L; { const int q = nwg / NXCD, r = nwg % NXCD, xcd = wgid % NXCD, off = wgid / NXCD; wgid = (xcd < r ? xcd * (q + 1) : r * (q + 1) + (xcd - r) * q) + off; }
        const int nig = WGM * nN, gid = wgid / nig, fm = gid * WGM, gsz = (nM - fm) < WGM ? (nM - fm) : WGM;
        u.pm = fm + ((wgid % nig) % gsz); u.pn = (wgid % nig) / gsz; return true;
    }
    __device__ __forceinline__ void a_ready(const Unit&) const {}
    __device__ __forceinline__ void done(const Unit&) const {}
};

__device__ __forceinline__ unsigned cvt_pk_bf16(float lo, float hi) { unsigned r; asm volatile("v_cvt_pk_bf16_f32 %0, %1, %2" : "=v"(r) : "v"(lo), "v"(hi)); return r; }
typedef float f32x2 __attribute__((ext_vector_type(2)));
typedef unsigned u32x2 __attribute__((ext_vector_type(2)));
__device__ __forceinline__ float bflo(unsigned w) { return __uint_as_float(w << 16); }
__device__ __forceinline__ float bfhi(unsigned w) { return __uint_as_float(w & 0xffff0000u); }
__device__ __forceinline__ float sigmoidf_(float x) { return 1.0f / (1.0f + __expf(-x)); }
constexpr float RMS_EPS = 1e-6f;
__device__ __forceinline__ f32x2 gelu_pk(f32x2 v) {
    const f32x2 av = __builtin_elementwise_abs(v), d = av * 0.2316418882f + 1.0f;
    f32x2 t; t.x = __builtin_amdgcn_rcpf(d.x); t.y = __builtin_amdgcn_rcpf(d.y);
    f32x2 q = t * 0.5307027145f + (-0.7265760135f); q = q * t + 0.7107068705f; q = q * t + (-0.142248368f); q = q * t + 0.127414796f; q = q * t;
    const f32x2 s = (v * v) * (-0.72134752044f);
    f32x2 e; e.x = __builtin_amdgcn_exp2f(s.x); e.y = __builtin_amdgcn_exp2f(s.y);
    const f32x2 m = v * (q * e), r = v - m;
    f32x2 o; o.x = v.x < 0.f ? m.x : r.x; o.y = v.y < 0.f ? m.y : r.y; return o;
}

struct EpiProjA {
    static constexpr bool PERM = true, AFTER_DRAIN = false;
    bf16_t* ATT; bf16_t* DNQ; bf16_t* Z; float* SMALL; const float* rstd;
    __device__ __forceinline__ void operator()(const f32x4 (&acc)[2][2][4][2], const Unit& u, int wr, int wc, int fr, int fq) const {
        const int row0 = u.pm * BM + wr * 64 + fr; const int pn = u.pn;
        bf16_t* base; int ldc, colt;
        if (pn < 18) { base = ATT; ldc = 4608; colt = pn * 256; } else if (pn < 30) { base = DNQ; ldc = 3072; colt = (pn - 18) * 256; } else { base = Z; ldc = 1024; colt = (pn - 30) * 256; }
        const int col0 = colt + wc * 32 + 8 * fq;
#pragma unroll
        for (int ai = 0; ai < 2; ++ai)
#pragma unroll
            for (int m = 0; m < 4; ++m) { const int r = row0 + ai * HALF + m * 16; const float rs = rstd[r];
#pragma unroll
                for (int bj = 0; bj < 2; ++bj) { const f32x4 v0 = acc[ai][bj][m][0] * rs, v1 = acc[ai][bj][m][1] * rs;
                    if (pn < 34) { u32x4 w; w.x = cvt_pk_bf16(v0[0], v0[1]); w.y = cvt_pk_bf16(v0[2], v0[3]); w.z = cvt_pk_bf16(v1[0], v1[1]); w.w = cvt_pk_bf16(v1[2], v1[3]);
                        *(u32x4*)(base + (size_t)r * ldc + col0 + bj * HALF) = w; }
                    else if (bj == 0 && wc == 0) { float* sp = SMALL + (size_t)r * 32 + 8 * fq; *(f32x4*)sp = v0; *(f32x4*)(sp + 4) = v1; } } }
    }
};
struct EpiGates {
    static constexpr bool PERM = true, AFTER_DRAIN = false;
    bf16_t* G; const float* rstd;
    __device__ __forceinline__ void operator()(const f32x4 (&acc)[2][2][4][2], const Unit& u, int wr, int wc, int fr, int fq) const {
        const int row0 = u.pm * BM + wr * 64 + fr; const int col0 = u.pn * BM + wc * 32 + 8 * fq;
#pragma unroll
        for (int ai = 0; ai < 2; ++ai)
#pragma unroll
            for (int m = 0; m < 4; ++m) { const int r = row0 + ai * HALF + m * 16; const float rs = rstd[r];
#pragma unroll
                for (int bj = 0; bj < 2; ++bj) { const f32x4 v0 = acc[ai][bj][m][0] * rs, v1 = acc[ai][bj][m][1] * rs;
                    u32x4 w; w.x = cvt_pk_bf16(sigmoidf_(v0[0]), sigmoidf_(v0[1])); w.y = cvt_pk_bf16(sigmoidf_(v0[2]), sigmoidf_(v0[3])); w.z = cvt_pk_bf16(sigmoidf_(v1[0]), sigmoidf_(v1[1])); w.w = cvt_pk_bf16(sigmoidf_(v1[2]), sigmoidf_(v1[3]));
                    *(u32x4*)(G + (size_t)r * 2048 + col0 + bj * HALF) = w; } }
    }
};
struct EpiF32 {
    static constexpr bool PERM = false, AFTER_DRAIN = false;
    float* C; int ldc;
    __device__ __forceinline__ void operator()(const f32x4 (&acc)[2][2][4][2], const Unit& u, int wr, int wc, int fr, int fq) const {
        const int row0 = u.pm * BM + wr * 64 + fr, col0 = u.pn * BM + wc * 32 + 4 * fq;
#pragma unroll
        for (int ai = 0; ai < 2; ++ai)
#pragma unroll
            for (int m = 0; m < 4; ++m) { float* rowp = C + (size_t)(row0 + ai * HALF + m * 16) * ldc + col0;
#pragma unroll
                for (int bj = 0; bj < 2; ++bj)
#pragma unroll
                    for (int n = 0; n < 2; ++n) *(f32x4*)(rowp + bj * HALF + n * 16) = acc[ai][bj][m][n]; }
    }
};
struct EpiMix {
    static constexpr bool PERM = true, AFTER_DRAIN = false;
    const bf16_t* G; const float* YA; bf16_t* MIX;
    __device__ __forceinline__ void operator()(const f32x4 (&acc)[2][2][4][2], const Unit& u, int wr, int wc, int fr, int fq) const {
        const int row0 = u.pm * BM + wr * 64 + fr; const int col0 = u.pn * BM + wc * 32 + 8 * fq;
#pragma unroll
        for (int ai = 0; ai < 2; ++ai)
#pragma unroll
            for (int m = 0; m < 4; ++m) { const int r = row0 + ai * HALF + m * 16;
#pragma unroll
                for (int bj = 0; bj < 2; ++bj) { const int c = col0 + bj * HALF;
                    const u32x4 ga = *(const u32x4*)(G + (size_t)r * 2048 + c), gb = *(const u32x4*)(G + (size_t)r * 2048 + 1024 + c);
                    const f32x4 y0 = *(const f32x4*)(YA + (size_t)r * 1024 + c), y1 = *(const f32x4*)(YA + (size_t)r * 1024 + c + 4);
                    const f32x4 a0 = acc[ai][bj][m][0], a1 = acc[ai][bj][m][1];
                    u32x4 w;
                    w.x = cvt_pk_bf16(bflo(ga.x) * y0[0] + bflo(gb.x) * a0[0], bfhi(ga.x) * y0[1] + bfhi(gb.x) * a0[1]);
                    w.y = cvt_pk_bf16(bflo(ga.y) * y0[2] + bflo(gb.y) * a0[2], bfhi(ga.y) * y0[3] + bfhi(gb.y) * a0[3]);
                    w.z = cvt_pk_bf16(bflo(ga.z) * y1[0] + bflo(gb.z) * a1[0], bfhi(ga.z) * y1[1] + bfhi(gb.z) * a1[1]);
                    w.w = cvt_pk_bf16(bflo(ga.w) * y1[2] + bflo(gb.w) * a1[2], bfhi(ga.w) * y1[3] + bfhi(gb.w) * a1[3]);
                    *(u32x4*)(MIX + (size_t)r * 1024 + c) = w; } }
    }
};
struct EpiRes {
    static constexpr bool PERM = false, AFTER_DRAIN = false;
    const float* RES; float* OUT; bf16_t* XB; float* ssq;
    __device__ __forceinline__ void operator()(const f32x4 (&acc)[2][2][4][2], const Unit& u, int wr, int wc, int fr, int fq) const {
        const int row0 = u.pm * BM + wr * 64 + fr, col0 = u.pn * BM + wc * 32 + 4 * fq;
#pragma unroll
        for (int ai = 0; ai < 2; ++ai)
#pragma unroll
            for (int m = 0; m < 4; ++m) { const int r = row0 + ai * HALF + m * 16; const size_t off = (size_t)r * 1024 + col0; float s = 0.f;
#pragma unroll
                for (int bj = 0; bj < 2; ++bj)
#pragma unroll
                    for (int n = 0; n < 2; ++n) { const size_t o2 = off + bj * HALF + n * 16; const f32x4 v = *(const f32x4*)(RES + o2) + acc[ai][bj][m][n];
                        *(f32x4*)(OUT + o2) = v; s += (v[0] * v[0] + v[1] * v[1]) + (v[2] * v[2] + v[3] * v[3]);
                        if (XB) { u32x2 w; w.x = cvt_pk_bf16(v[0], v[1]); w.y = cvt_pk_bf16(v[2], v[3]); *(u32x2*)(XB + o2) = w; } }
                s += __shfl_xor(s, 16); s += __shfl_xor(s, 32);
                if (fq == 0) atomicAdd(ssq + r, s); }
    }
};
struct EpiUp {
    static constexpr bool PERM = true, AFTER_DRAIN = false;
    bf16_t* UP; const float* ssq;
    __device__ __forceinline__ void operator()(const f32x4 (&acc)[2][2][4][2], const Unit& u, int wr, int wc, int fr, int fq) const {
        const int row0 = u.pm * BM + wr * 64 + fr; const int col0 = u.pn * BM + wc * 32 + 8 * fq;
#pragma unroll
        for (int ai = 0; ai < 2; ++ai)
#pragma unroll
            for (int m = 0; m < 4; ++m) { const int r = row0 + ai * HALF + m * 16; const float rs = rsqrtf(ssq[r] * (1.0f / 1024.0f) + RMS_EPS);
#pragma unroll
                for (int bj = 0; bj < 2; ++bj) { const f32x4 v0 = acc[ai][bj][m][0] * rs, v1 = acc[ai][bj][m][1] * rs;
                    u32x4 w; w.x = cvt_pk_bf16(v0[0], v0[1]); w.y = cvt_pk_bf16(v0[2], v0[3]); w.z = cvt_pk_bf16(v1[0], v1[1]); w.w = cvt_pk_bf16(v1[2], v1[3]);
                    *(u32x4*)(UP + (size_t)r * 5632 + col0 + bj * HALF) = w; } }
    }
};
template <class Epi, class Sched, bool ALIGN_EPI = false, bool SP2 = false>
__device__ __forceinline__ void gemm_phase(PG8_LAS unsigned char* lds, const Gemm g, const Sched& S, const Epi& E, int tid_) {
    asm volatile("" : "+v"(tid_)); const int tid = tid_, wid = __builtin_amdgcn_readfirstlane(tid >> 6), lane = tid & 63, wr = wid >> 2, wc = wid & 3, fr = lane & 15, fq = lane >> 4;
    const int K = g.K, nt = K / BK;
    unsigned voffA[2], voffB[2];
#pragma unroll
    for (int i = 0; i < 2; ++i) { int R, C; stage_rc(tid * 16 + i * 8192, R, C); const int Rb = Epi::PERM ? ((R & ~31) + perm32(R & 31)) : R;
        voffA[i] = (unsigned)(R * K + C) * 2u; voffB[i] = (unsigned)(Rb * K + C) * 2u; }
    const size_t kstep = (size_t)(BK * 2);
    const size_t hstep = (size_t)HALF * K * 2;
    const size_t tstep = 2 * hstep;
    const unsigned ldsw = (unsigned)wid * 1024u;
    const int aoff = lds_byte(wr * 64 + fr, fq * 8), boff = lds_byte(wc * 32 + fr, fq * 8);
#define PG8_SA(b, h) (((b) * 2 + (h)) * HTB)
#define PG8_SB(b, h) ((4 + (b) * 2 + (h)) * HTB)
#define PG8_STAGE(bufoff, gbase, voff) do { _Pragma("unroll") for (int _i = 0; _i < 2; ++_i) \
        __builtin_amdgcn_global_load_lds((const unsigned*)((const char*)(gbase) + (voff)[_i]), (PG8_LAS unsigned*)(lds + (bufoff) + ldsw + _i * 8192), 16, 0, 0); } while (0)
#define PG8_LDA(dst, b, h) do { _Pragma("unroll") for (int m = 0; m < 4; ++m) _Pragma("unroll") for (int k = 0; k < 2; ++k) dst[m][k] = *(const PG8_LAS bf16x8*)(lds + PG8_SA(b, h) + aoff + m * 2048 + k * 1024); } while (0)
#define PG8_LDB(dst, b, h) do { _Pragma("unroll") for (int n = 0; n < 2; ++n) _Pragma("unroll") for (int k = 0; k < 2; ++k) dst[n][k] = *(const PG8_LAS bf16x8*)(lds + PG8_SB(b, h) + boff + n * 2048 + k * 1024); } while (0)
#define PG8_MMA(ai, bj, At, Bt) do { __builtin_amdgcn_s_setprio(1); _Pragma("unroll") for (int m = 0; m < 4; ++m) _Pragma("unroll") for (int n = 0; n < 2; ++n) _Pragma("unroll") for (int k = 0; k < 2; ++k) \
        acc[ai][bj][m][n] = __builtin_amdgcn_mfma_f32_16x16x32_bf16(Bt[n][k], At[m][k], acc[ai][bj][m][n], 0, 0, 0); __builtin_amdgcn_s_setprio(0); } while (0)
#define PG8_WAIT_V(n) asm volatile("s_waitcnt vmcnt(" #n ")" ::: "memory")
#define PG8_WAIT_L(n) asm volatile("s_waitcnt lgkmcnt(" #n ")" ::: "memory")
#define PG8_BAR __builtin_amdgcn_s_barrier()
#define PG8_SCHED __builtin_amdgcn_sched_barrier(0)
    Unit cur, nxt; int ui = 0;
    if (!S.next(0, cur)) return;
    f32x4 acc[2][2][4][2];
    f32x4 zz_ = (f32x4){0.f, 0.f, 0.f, 0.f}; asm volatile("" : "+v"(zz_));
#pragma unroll
    for (int a = 0; a < 2; ++a)
#pragma unroll
        for (int b = 0; b < 2; ++b)
#pragma unroll
            for (int m = 0; m < 4; ++m)
#pragma unroll
                for (int n = 0; n < 2; ++n) acc[a][b][m][n] = zz_;
    bf16x8 At[4][2], B0[2][2], B1[2][2];
    const char* cA = (const char*)g.A + (size_t)cur.pm * tstep; const char* cB = (const char*)g.Bt + (size_t)cur.pn * tstep;
    S.a_ready(cur);
    if constexpr (SP2) {
        PG8_STAGE(PG8_SB(0, 0), cB, voffB); PG8_STAGE(PG8_SB(0, 1), cB + hstep, voffB); PG8_STAGE(PG8_SA(0, 0), cA, voffA); PG8_STAGE(PG8_SA(0, 1), cA + hstep, voffA);
        if (wr == 1) PG8_BAR;
        PG8_WAIT_V(2); PG8_BAR;
        PG8_STAGE(PG8_SB(1, 0), cB + kstep, voffB); PG8_STAGE(PG8_SA(1, 0), cA + kstep, voffA); PG8_STAGE(PG8_SB(1, 1), cB + hstep + kstep, voffB);
        PG8_WAIT_V(6); PG8_BAR;
    } else {
        PG8_STAGE(PG8_SB(0, 0), cB, voffB); PG8_STAGE(PG8_SA(0, 0), cA, voffA); PG8_STAGE(PG8_SB(0, 1), cB + hstep, voffB); PG8_STAGE(PG8_SA(0, 1), cA + hstep, voffA);
        if (wr == 1) PG8_BAR;
        PG8_WAIT_V(4); PG8_BAR;
        PG8_STAGE(PG8_SB(1, 0), cB + kstep, voffB); PG8_STAGE(PG8_SA(1, 0), cA + kstep, voffA); PG8_STAGE(PG8_SB(1, 1), cB + hstep + kstep, voffB);
        PG8_WAIT_V(6); PG8_BAR;
    }
    for (;;) {
        const bool has_next = S.next(ui + 1, nxt);
        const char* nA = has_next ? (const char*)g.A + (size_t)nxt.pm * tstep : cA; const char* nB = has_next ? (const char*)g.Bt + (size_t)nxt.pn * tstep : cB;
        for (int t = 0; t < nt; t += 2) {
            const bool last = (t == nt - 2);
            const char* a1 = cA + (size_t)(t + 1) * kstep;
            const char* a2 = last ? nA : cA + (size_t)(t + 2) * kstep; const char* b2 = last ? nB : cB + (size_t)(t + 2) * kstep;
            const char* a3 = a2 + kstep; const char* b3 = b2 + kstep;
            if (last && has_next) S.a_ready(nxt);
            if constexpr (SP2) {
            PG8_LDB(B0, 0, 0); PG8_LDB(B1, 0, 1); PG8_SCHED; PG8_LDA(At, 0, 0); PG8_STAGE(PG8_SA(1, 1), a1 + hstep, voffA);
            PG8_WAIT_V(8); PG8_WAIT_L(0); PG8_BAR; PG8_MMA(0, 0, At, B0); PG8_MMA(0, 1, At, B1); PG8_BAR; PG8_SCHED;
            PG8_LDA(At, 0, 1); PG8_STAGE(PG8_SB(0, 0), b2, voffB); PG8_STAGE(PG8_SB(0, 1), b2 + hstep, voffB); PG8_STAGE(PG8_SA(0, 0), a2, voffA);
            PG8_WAIT_V(8); PG8_WAIT_L(0); PG8_BAR; PG8_MMA(1, 0, At, B0); PG8_MMA(1, 1, At, B1); PG8_BAR; PG8_SCHED;
            PG8_LDB(B0, 1, 0); PG8_LDB(B1, 1, 1); PG8_SCHED; PG8_LDA(At, 1, 0); PG8_STAGE(PG8_SA(0, 1), a2 + hstep, voffA);
            PG8_WAIT_V(8); PG8_WAIT_L(0); PG8_BAR; PG8_MMA(0, 0, At, B0); PG8_MMA(0, 1, At, B1); PG8_BAR; PG8_SCHED;
            PG8_LDA(At, 1, 1); PG8_STAGE(PG8_SB(1, 0), b3, voffB); PG8_STAGE(PG8_SB(1, 1), b3 + hstep, voffB); PG8_STAGE(PG8_SA(1, 0), a3, voffA);
            PG8_WAIT_V(8); PG8_WAIT_L(0); PG8_BAR; PG8_MMA(1, 0, At, B0); PG8_MMA(1, 1, At, B1); PG8_BAR; PG8_SCHED;
            } else {
            PG8_LDB(B0, 0, 0); PG8_SCHED; PG8_LDA(At, 0, 0); PG8_STAGE(PG8_SA(1, 1), a1 + hstep, voffA);
            PG8_WAIT_L(8); PG8_BAR; PG8_WAIT_L(0); PG8_MMA(0, 0, At, B0); PG8_BAR; PG8_SCHED;
            PG8_LDB(B1, 0, 1); PG8_STAGE(PG8_SB(0, 0), b2, voffB);
            PG8_BAR; PG8_WAIT_L(0); PG8_MMA(0, 1, At, B1); PG8_BAR;
            PG8_LDA(At, 0, 1); PG8_STAGE(PG8_SA(0, 0), a2, voffA);
            PG8_BAR; PG8_WAIT_L(0); PG8_MMA(1, 0, At, B0); PG8_BAR; PG8_SCHED;
            PG8_STAGE(PG8_SB(0, 1), b2 + hstep, voffB);
            PG8_WAIT_V(6); PG8_BAR; PG8_MMA(1, 1, At, B1); PG8_BAR;
            PG8_LDB(B0, 1, 0); PG8_SCHED; PG8_LDA(At, 1, 0); PG8_STAGE(PG8_SA(0, 1), a2 + hstep, voffA);
            PG8_WAIT_L(8); PG8_BAR; PG8_WAIT_L(0); PG8_MMA(0, 0, At, B0); PG8_BAR; PG8_SCHED;
            PG8_LDB(B1, 1, 1); PG8_STAGE(PG8_SB(1, 0), b3, voffB);
            PG8_BAR; PG8_WAIT_L(0); PG8_MMA(0, 1, At, B1); PG8_BAR;
            PG8_LDA(At, 1, 1); PG8_STAGE(PG8_SA(1, 0), a3, voffA);
            PG8_BAR; PG8_WAIT_L(0); PG8_MMA(1, 0, At, B0); PG8_BAR; PG8_SCHED;
            PG8_STAGE(PG8_SB(1, 1), b3 + hstep, voffB);
            PG8_WAIT_V(6); PG8_BAR; PG8_MMA(1, 1, At, B1); PG8_BAR;
            }
        }
        if constexpr (ALIGN_EPI) { if (wr == 0) PG8_BAR; }
        if constexpr (!Epi::AFTER_DRAIN) { E(acc, cur, wr, wc, fr, fq); S.done(cur); }
        if (!has_next) break;
        zz_ = (f32x4){0.f, 0.f, 0.f, 0.f}; asm volatile("" : "+v"(zz_));
#pragma unroll
        for (int a = 0; a < 2; ++a)
#pragma unroll
            for (int b = 0; b < 2; ++b)
#pragma unroll
                for (int m = 0; m < 4; ++m)
#pragma unroll
                    for (int n = 0; n < 2; ++n) acc[a][b][m][n] = zz_;
        cur = nxt; cA = nA; cB = nB; ++ui;
        if constexpr (ALIGN_EPI) { if (wr == 1) PG8_BAR; }
    }
    PG8_WAIT_V(0);
    if constexpr (!ALIGN_EPI) { if (wr == 0) PG8_BAR; }
    PG8_BAR;
    if constexpr (Epi::AFTER_DRAIN) { E.fused(acc, cur, wr, wc, fr, fq, lds, wid, lane); S.done(cur); }
#undef PG8_SA
#undef PG8_SB
#undef PG8_STAGE
#undef PG8_LDA
#undef PG8_LDB
#undef PG8_MMA
#undef PG8_WAIT_V
#undef PG8_WAIT_L
#undef PG8_BAR
#undef PG8_SCHED
}
}

#define LAS __attribute__((address_space(3)))
typedef unsigned short bf16;
typedef float f32x4 __attribute__((ext_vector_type(4)));
typedef unsigned v4u __attribute__((ext_vector_type(4)));
typedef unsigned v2u __attribute__((ext_vector_type(2)));
using pg8::cvt_pk_bf16; using pg8::bflo; using pg8::bfhi;

constexpr int NWAVES = 8, NTHREADS = 512;
constexpr int D = 1024, NTOK = 49152, TG = 16384, NGROUPS = 3;
constexpr int ATTW = 4608, DNW = 3072, NPA = 8960  , NIN_T = 11008, DFF = 2816, NUP = 5632;
constexpr float EPS = 1e-6f;

constexpr size_t MiB = 1u << 20;
constexpr size_t WS_CTL = 0, CTL_BYTES = 1 * MiB;
constexpr size_t CTL_SSQ2 = 256 * 1024, CTL_SSQ3 = 512 * 1024;
constexpr size_t WS_WIN = 1 * MiB, WS_WUP = 23 * MiB, WS_WDOWN = 34 * MiB, WS_WOUT = 40 * MiB, WS_WA = 42 * MiB, WS_WB = 43 * MiB;
constexpr size_t WS_ROPE = 45 * MiB, WS_RSTD1 = 46 * MiB, WS_XB = 48 * MiB, WS_ARENA = 144 * MiB, WS_END = 512 * MiB;
constexpr size_t AR_ATT = 0, AR_DNQ = 144 * MiB, AR_Z = 240 * MiB, AR_SMALL = 272 * MiB, AR_GATE = 274 * MiB, AR_AO = 276 * MiB, AR_MIX = 292 * MiB;
constexpr size_t AR_CONV = 0;
constexpr size_t AR_OF = 144 * MiB, AR_OB = 176 * MiB, AR_DNOUT = 208 * MiB;
constexpr size_t AR_G = 0, AR_YA = 64 * MiB;
constexpr size_t AR_UP = 0, AR_ACT = 176 * MiB;
static_assert(WS_ARENA + AR_MIX + 32 * MiB <= WS_END, "ws map");

struct Args { const float* in[19]; float* out; unsigned char* ws; int lo, hi; };

__device__ __forceinline__ float wave_sum(float v) {
#pragma unroll
    for (int o = 1; o < 64; o <<= 1) v += __shfl_xor(v, o);
    return v;
}
__device__ __forceinline__ float bf2f(bf16 u) { return __uint_as_float((unsigned)u << 16); }
__device__ __forceinline__ float siluf_(float x) { return x / (1.0f + __expf(-x)); }

__device__ __forceinline__ void p0_transpose_item(const float* W, int ldw, int col_off, int K, int ncols, const float* gain, bf16* WT, int row_off, LAS float* scr, int item, int lane) {
    const int nblk = ncols / 32, kb = item / nblk, nb = item % nblk, k0 = 64 * kb, n0 = 32 * nb;
#pragma unroll 8
    for (int i = 0; i < 32; ++i) { const int kk = 2 * i + (lane >> 5); float w = W[(size_t)(k0 + kk) * ldw + col_off + n0 + (lane & 31)]; if (gain) w *= gain[k0 + kk]; scr[kk * 33 + (lane & 31)] = w; }
    asm volatile("s_waitcnt lgkmcnt(0)" ::: "memory");
    const int c = lane & 7;
#pragma unroll
    for (int j = 0; j < 4; ++j) { const int n = (lane >> 3) + 8 * j; const LAS float* s = scr + (8 * c) * 33 + n;
        v4u o; o.x = cvt_pk_bf16(s[0 * 33], s[1 * 33]); o.y = cvt_pk_bf16(s[2 * 33], s[3 * 33]); o.z = cvt_pk_bf16(s[4 * 33], s[5 * 33]); o.w = cvt_pk_bf16(s[6 * 33], s[7 * 33]);
        *(v4u*)(WT + (size_t)(row_off + n0 + n) * K + k0 + 8 * c) = o; }
    asm volatile("s_waitcnt lgkmcnt(0)" ::: "memory");
}

struct Ptrs {
    const float *x_p, *x_s, *norm_mix_g, *w_in, *conv_w, *a_log_f, *a_log_b, *dt_f, *dt_b, *out_norm_g, *w_a, *w_b, *w_out, *norm_ffn_g, *w_up, *ffn_conv_w, *ffn_conv_b, *w_down, *norm_final_g;
    float* out; unsigned char* ws;
};
__device__ __forceinline__ const float* x_row(const Ptrs& P, int tok) { return tok < 32768 ? P.x_p + (size_t)tok * D : P.x_s + (size_t)(tok - 32768) * D; }

__device__ __forceinline__ void phase_prologue(const Ptrs& P, unsigned char* lds, int bid, int G, int tid) {
    const int lane = tid & 63, wave = tid >> 6;
    LAS float* scr = (LAS float*)((LAS unsigned char*)lds + wave * 16384);
    const int gw = bid * NWAVES + wave, NGW = G * NWAVES;
    bf16* Win = (bf16*)(P.ws + WS_WIN); bf16* Wup = (bf16*)(P.ws + WS_WUP); bf16* Wdn = (bf16*)(P.ws + WS_WDOWN); bf16* Wout = (bf16*)(P.ws + WS_WOUT); bf16* Wa = (bf16*)(P.ws + WS_WA); bf16* Wb = (bf16*)(P.ws + WS_WB);
    constexpr int I1 = 16 * 273, I2 = 16 * 64, I3 = 8 * 32, I4 = 16 * 32, I5 = 16 * 32, I6 = 16 * 176, I7 = 44 * 32;
    constexpr int NIT = I1 + I2 + I3 + I4 + I5 + I6 + I7;
    for (int it = gw; it < NIT; it += NGW) {
        int r = it;
        if (r < I1) { p0_transpose_item(P.w_in, 10784, 0, 1024, 8736, P.norm_mix_g, Win, 0, scr, r, lane); continue; } r -= I1;
        if (r < I2) { p0_transpose_item(P.w_in, 10784, 8736, 1024, 2048, P.norm_mix_g, Win, 8960, scr, r, lane); continue; } r -= I2;
        if (r < I3) { p0_transpose_item(P.w_a, 1024, 0, 512, 1024, nullptr, Wa, 0, scr, r, lane); continue; } r -= I3;
        if (r < I4) { p0_transpose_item(P.w_b, 1024, 0, 1024, 1024, nullptr, Wb, 0, scr, r, lane); continue; } r -= I4;
        if (r < I5) { p0_transpose_item(P.w_out, 1024, 0, 1024, 1024, nullptr, Wout, 0, scr, r, lane); continue; } r -= I5;
        if (r < I6) { p0_transpose_item(P.w_up, 5632, 0, 1024, 5632, P.norm_ffn_g, Wup, 0, scr, r, lane); continue; } r -= I6;
        p0_transpose_item(P.w_down, 1024, 0, 2816, 1024, nullptr, Wdn, 0, scr, r, lane);
    }
    const int gt = bid * NTHREADS + tid, NGT = G * NTHREADS;
    for (int i = gt; i < 28672; i += NGT) ((v4u*)(Win + (size_t)8736 * 1024))[i] = (v4u){0u, 0u, 0u, 0u};
    float* ropeC = (float*)(P.ws + WS_ROPE); float* ropeS = ropeC + 4096 * 8;
    for (int i = gt; i < 4096 * 8; i += NGT) { const int pos = i >> 3, j = i & 7;
        const float invt[8] = {1.0f, 0.19392274f, 0.03760603f, 0.0072926646f, 0.0014142136f, 0.0002742482f, 5.3182957e-05f, 1.0313385e-05f};
        const float inv = invt[j]; const float ang = (float)pos * inv;
        const float c_hi = 0.15915494f, c_lo = 6.4206382e-09f;
        const float kq = rintf(ang * c_hi); float r = fmaf(ang, c_hi, -kq); r = fmaf(ang, c_lo, r);
        ropeC[i] = __builtin_amdgcn_cosf(r); ropeS[i] = __builtin_amdgcn_sinf(r); }
    bf16* XB = (bf16*)(P.ws + WS_XB); float* rstd1 = (float*)(P.ws + WS_RSTD1);
    for (int m = gw; m < NTOK; m += NGW) {
        const f32x4* xr = (const f32x4*)x_row(P, m) + lane; f32x4 v[4]; float s = 0.f;
#pragma unroll
        for (int j = 0; j < 4; ++j) { v[j] = xr[64 * j]; s += (v[j].x * v[j].x + v[j].y * v[j].y) + (v[j].z * v[j].z + v[j].w * v[j].w); }
        s = wave_sum(s);
        if (lane == 0) rstd1[m] = rsqrtf(s * (1.0f / 1024.0f) + EPS);
        unsigned long long* o8 = (unsigned long long*)(XB + (size_t)m * D) + lane;
#pragma unroll
        for (int j = 0; j < 4; ++j) o8[64 * j] = (unsigned long long)cvt_pk_bf16(v[j].x, v[j].y) | ((unsigned long long)cvt_pk_bf16(v[j].z, v[j].w) << 32);
    }
}

__device__ __forceinline__ void load8bf(const bf16* p, float* o) { const v4u w = *(const v4u*)p; o[0] = bflo(w.x); o[1] = bfhi(w.x); o[2] = bflo(w.y); o[3] = bfhi(w.y); o[4] = bflo(w.z); o[5] = bfhi(w.z); o[6] = bflo(w.w); o[7] = bfhi(w.w); }
__device__ __forceinline__ void phase_attn_naive(const bf16* ATT, bf16* AO, const float* ropeC, const float* ropeS, int S, int gt, int NGT) {
    for (int item = gt; item < TG * 8; item += NGT) {
        const int tok = item % TG, hg = item / TG; const int pos = tok % S, seq0 = tok - pos;
        float mrun = -1e30f, l = 0.f; float o[64];
#pragma unroll
        for (int d = 0; d < 64; ++d) o[d] = 0.f;
        for (int gi = 0; gi < 3; ++gi) {
            const int h = gi * 8 + hg, dil = (gi == 0) ? 1 : (gi == 1) ? 4 : 16;
            float q[64];
#pragma unroll
            for (int c = 0; c < 8; ++c) load8bf(ATT + (size_t)tok * ATTW + h * 64 + c * 8, q + c * 8);
#pragma unroll
            for (int i = 0; i < 8; ++i) { const float cs = ropeC[pos * 8 + i], sn = ropeS[pos * 8 + i], t1 = q[i], t2 = q[i + 8]; q[i] = t1 * cs - t2 * sn; q[i + 8] = t2 * cs + t1 * sn; }
            for (int mm = -64; mm <= 64; ++mm) {
                const int p2 = pos + mm * dil; if (p2 < 0 || p2 >= S) continue;
                const bf16* kr = ATT + (size_t)(seq0 + p2) * ATTW + 1536 + h * 64; float s = 0.f;
                { float k0[16]; load8bf(kr, k0); load8bf(kr + 8, k0 + 8);
#pragma unroll
                  for (int i = 0; i < 8; ++i) { const float cs = ropeC[p2 * 8 + i], sn = ropeS[p2 * 8 + i], t1 = k0[i], t2 = k0[i + 8]; s += q[i] * (t1 * cs - t2 * sn) + q[i + 8] * (t2 * cs + t1 * sn); } }
#pragma unroll
                for (int c = 2; c < 8; ++c) { float kk[8]; load8bf(kr + c * 8, kk);
#pragma unroll
                    for (int e = 0; e < 8; ++e) s += q[c * 8 + e] * kk[e]; }
                s *= 0.125f;
                const float mn = fmaxf(mrun, s), sc = __expf(mrun - mn), p = __expf(s - mn); mrun = mn; l = l * sc + p;
                const bf16* vr = ATT + (size_t)(seq0 + p2) * ATTW + 3072 + h * 64;
#pragma unroll
                for (int c = 0; c < 8; ++c) { float vv[8]; load8bf(vr + c * 8, vv);
#pragma unroll
                    for (int e = 0; e < 8; ++e) o[c * 8 + e] = o[c * 8 + e] * sc + p * vv[e]; }
            }
        }
        const float il = 1.0f / l; bf16* op = AO + (size_t)tok * 512 + hg * 64;
#pragma unroll
        for (int c = 0; c < 8; ++c) { v4u w; w.x = cvt_pk_bf16(o[c * 8] * il, o[c * 8 + 1] * il); w.y = cvt_pk_bf16(o[c * 8 + 2] * il, o[c * 8 + 3] * il); w.z = cvt_pk_bf16(o[c * 8 + 4] * il, o[c * 8 + 5] * il); w.w = cvt_pk_bf16(o[c * 8 + 6] * il, o[c * 8 + 7] * il); *(v4u*)(op + c * 8) = w; }
    }
}

__device__ __forceinline__ void phase_dnprep_naive(const Ptrs& P, const bf16* DNQ, const float* SMALL, bf16* CONV, float* GATE, int S, int gw, int NGW, int gt, int NGT, int lane) {
    for (int item = gw; item < TG * 24; item += NGW) {
        const int tok = item / 24, part = item % 24; const int pos = tok % S; const int c = part * 128 + lane * 2;
        float a0 = 0.f, a1 = 0.f;
#pragma unroll
        for (int i = 0; i < 5; ++i) { const int p2 = pos + i - 2; if (p2 >= 0 && p2 < S) { const unsigned w = *(const unsigned*)(DNQ + (size_t)(tok + i - 2) * DNW + c);
                a0 += bflo(w) * P.conv_w[i * DNW + c]; a1 += bfhi(w) * P.conv_w[i * DNW + c + 1]; } }
        a0 = siluf_(a0); a1 = siluf_(a1);
        if (part < 16) { const float ss = wave_sum(a0 * a0 + a1 * a1); float sc = rsqrtf(ss + EPS); if (part < 8) sc *= 0.08838834764831845f; a0 *= sc; a1 *= sc; }
        *(unsigned*)(CONV + (size_t)tok * DNW + c) = cvt_pk_bf16(a0, a1);
    }
    for (int i = gt; i < TG * 32; i += NGT) { const int j = i & 31, h = j & 7; const float s = SMALL[i]; float r;
        if (j < 16) r = 1.0f / (1.0f + __expf(-s));
        else { const float al = (j < 24) ? P.a_log_f[h] : P.a_log_b[h], db = (j < 24) ? P.dt_f[h] : P.dt_b[h]; const float xx = s + db; const float sp = (xx > 20.f) ? xx : __logf(1.0f + __expf(xx)); r = -__expf(al) * sp; }
        GATE[i] = r; }
}

__device__ __forceinline__ void phase_scan_naive(const bf16* CONV, const float* GATE, bf16* OF, bf16* OB, int S, unsigned char* lds, int bid, int G, int tid) {
    const int col = tid >> 2, kq = tid & 3; const int nchain = (TG / S) * 16;
    float* qs = (float*)lds; float* ks = qs + 2048;
    for (int chain = bid; chain < nchain; chain += G) {
        const int dir = chain & 1, h = (chain >> 1) & 7, b = chain >> 4;
        float St[32];
#pragma unroll
        for (int k = 0; k < 32; ++k) St[k] = 0.f;
        bf16* O = dir ? OB : OF;
        for (int tb = 0; tb < S; tb += 16) {
            __syncthreads();
#pragma unroll
            for (int i = 0; i < 4; ++i) { const int ii = i * 4 + kq; const int t = dir ? (S - 1 - (tb + ii)) : (tb + ii); const size_t row = (size_t)(b * S + t) * DNW;
                qs[ii * 128 + col] = bf2f(CONV[row + h * 128 + col]); ks[ii * 128 + col] = bf2f(CONV[row + 1024 + h * 128 + col]); }
            __syncthreads();
            for (int i = 0; i < 16; ++i) { const int t = dir ? (S - 1 - (tb + i)) : (tb + i); const size_t tokr = (size_t)(b * S + t);
                const float g = GATE[tokr * 32 + 16 + dir * 8 + h], beta = GATE[tokr * 32 + dir * 8 + h]; const float dec = __expf(g);
                const float v = bf2f(CONV[tokr * DNW + 2048 + h * 128 + col]);
                const float* kr = ks + i * 128 + kq * 32; const float* qr = qs + i * 128 + kq * 32;
                float dot = 0.f;
#pragma unroll
                for (int k = 0; k < 32; ++k) { St[k] *= dec; dot += kr[k] * St[k]; }
                dot += __shfl_xor(dot, 1); dot += __shfl_xor(dot, 2);
                const float vn = beta * (v - dot); float o = 0.f;
#pragma unroll
                for (int k = 0; k < 32; ++k) { St[k] += kr[k] * vn; o += qr[k] * St[k]; }
                o += __shfl_xor(o, 1); o += __shfl_xor(o, 2);
                if (kq == 0) O[tokr * 1024 + h * 128 + col] = (bf16)(cvt_pk_bf16(o, 0.f) & 0xffffu); }
        }
    }
}

__device__ __forceinline__ void phase_combine(const Ptrs& P, const bf16* OF, const bf16* OB, const bf16* Z, bf16* DNOUT, int gw, int NGW, int lane) {
    for (int item = gw; item < TG * 8; item += NGW) { const size_t off = (size_t)item * 128 + lane * 2;
        const unsigned a = *(const unsigned*)(OF + off), b = *(const unsigned*)(OB + off), z = *(const unsigned*)(Z + off);
        const float o0 = bflo(a) + bflo(b), o1 = bfhi(a) + bfhi(b); const float ss = wave_sum(o0 * o0 + o1 * o1); const float rs = rsqrtf(ss * (1.0f / 128.0f) + EPS);
        const float y0 = o0 * rs * P.out_norm_g[lane * 2] * siluf_(bflo(z)), y1 = o1 * rs * P.out_norm_g[lane * 2 + 1] * siluf_(bfhi(z));
        *(unsigned*)(DNOUT + off) = cvt_pk_bf16(y0, y1); }
}

__device__ __forceinline__ float gelu_erf(float v) { const pg8::f32x2 r = pg8::gelu_pk((pg8::f32x2){v, v}); return r.x; }
__device__ __forceinline__ void phase_act_naive(const Ptrs& P, const bf16* UP, bf16* ACT, int S, int gt, int NGT) {
    for (int item = gt; item < TG * (DFF / 8); item += NGT) { const int tok = item / (DFF / 8), c = (item % (DFF / 8)) * 8; const int pos = tok % S;
        float a[8], vv[8];
#pragma unroll
        for (int e = 0; e < 8; ++e) a[e] = P.ffn_conv_b[c + e];
#pragma unroll
        for (int i = 0; i < 3; ++i) { const int p2 = pos + i - 1; if (p2 >= 0 && p2 < S) { float g[8]; load8bf(UP + (size_t)(tok + i - 1) * NUP + c, g);
#pragma unroll
                for (int e = 0; e < 8; ++e) a[e] += g[e] * P.ffn_conv_w[i * DFF + c + e]; } }
        load8bf(UP + (size_t)tok * NUP + DFF + c, vv);
#pragma unroll
        for (int e = 0; e < 8; ++e) a[e] = gelu_erf(a[e]) * vv[e];
        v4u w; w.x = cvt_pk_bf16(a[0], a[1]); w.y = cvt_pk_bf16(a[2], a[3]); w.z = cvt_pk_bf16(a[4], a[5]); w.w = cvt_pk_bf16(a[6], a[7]);
        *(v4u*)(ACT + (size_t)tok * DFF + c) = w; }
}

__device__ __forceinline__ void phase_final(const Ptrs& P, const float* ssq3, int gw, int NGW, int lane) {
    for (int m = gw; m < NTOK; m += NGW) { const float rs = rsqrtf(ssq3[m] * (1.0f / 1024.0f) + EPS); f32x4* xr = (f32x4*)(P.out + (size_t)m * D) + lane; const f32x4* gr = (const f32x4*)P.norm_final_g + lane;
#pragma unroll
        for (int j = 0; j < 4; ++j) xr[64 * j] = xr[64 * j] * rs * gr[64 * j]; }
}

#define EN(k) (ONLYK < 0 || ONLYK == (k))
constexpr int LDS_BYTES = 147456;
constexpr int STEPS_PER_GROUP = 12, NSTEPS = 1 + NGROUPS * STEPS_PER_GROUP + 1;

#define LDP(i) ((const float*)ap->in[i])
#define MKP() Ptrs P; P.x_p = LDP(0); P.x_s = LDP(1); P.norm_mix_g = LDP(2); P.w_in = LDP(3); P.conv_w = LDP(4); P.a_log_f = LDP(5); P.a_log_b = LDP(6); P.dt_f = LDP(7); P.dt_b = LDP(8); \
        P.out_norm_g = LDP(9); P.w_a = LDP(10); P.w_b = LDP(11); P.w_out = LDP(12); P.norm_ffn_g = LDP(13); P.w_up = LDP(14); P.ffn_conv_w = LDP(15); P.ffn_conv_b = LDP(16); P.w_down = LDP(17); P.norm_final_g = LDP(18); \
        P.out = ap->out; P.ws = ap->ws;
#define WSP ((unsigned char*)ap->ws)
#define ARP (WSP + WS_ARENA)
#define Win ((bf16*)(WSP + WS_WIN))
#define Wup ((bf16*)(WSP + WS_WUP))
#define Wdn ((bf16*)(WSP + WS_WDOWN))
#define Wout ((bf16*)(WSP + WS_WOUT))
#define Wa ((bf16*)(WSP + WS_WA))
#define Wb ((bf16*)(WSP + WS_WB))
#define ropeC ((const float*)(WSP + WS_ROPE))
#define ropeS (ropeC + 4096 * 8)
#define ssq2 ((float*)(WSP + WS_CTL + CTL_SSQ2))
#define ssq3 ((float*)(WSP + WS_CTL + CTL_SSQ3))
#define XBg ((bf16*)(WSP + WS_XB) + (size_t)t0 * D)
#define rstd1 ((const float*)(WSP + WS_RSTD1) + t0)
#define ATT ((bf16*)(ARP + AR_ATT))
#define DNQ ((bf16*)(ARP + AR_DNQ))
#define Z ((bf16*)(ARP + AR_Z))
#define SMALL ((float*)(ARP + AR_SMALL))
#define GATE ((float*)(ARP + AR_GATE))
#define AO ((bf16*)(ARP + AR_AO))
#define MIX ((bf16*)(ARP + AR_MIX))
#define CONV ((bf16*)(ARP + AR_CONV))
#define OF ((bf16*)(ARP + AR_OF))
#define OB ((bf16*)(ARP + AR_OB))
#define DNOUT ((bf16*)(ARP + AR_DNOUT))
#define Gt ((bf16*)(ARP + AR_G))
#define YA ((float*)(ARP + AR_YA))
#define UP ((bf16*)(ARP + AR_UP))
#define ACT ((bf16*)(ARP + AR_ACT))
#define OUTg ((float*)ap->out + (size_t)t0 * D)
#define STEP_PRE() int tid = wave_u * 64 + (int)__builtin_amdgcn_mbcnt_hi(~0u, __builtin_amdgcn_mbcnt_lo(~0u, 0u)), bid = blockIdx.x; typedef const __attribute__((address_space(4))) Args* kargp_t; kargp_t ap = (kargp_t)__builtin_amdgcn_kernarg_segment_ptr(); asm volatile("" : "+v"(tid), "+s"(bid), "+s"(ap)); \
        const int lane = tid & 63, wave = tid >> 6, gw = bid * NWAVES + wave, gt = bid * NTHREADS + tid; (void)lane; (void)wave; (void)gw; (void)gt;
template <int ONLYK, int STEP> __device__ __forceinline__ void run_step(unsigned char* lds, int G, int NGW, int NGT, int wave_u) {
    STEP_PRE();
    constexpr int g = (STEP - 1) / STEPS_PER_GROUP, k = (STEP - 1) % STEPS_PER_GROUP; constexpr int t0 = g * TG; constexpr int S = (g < 2) ? 2048 : 4096;
    if constexpr (STEP == 0) {
        if constexpr (EN(100)) { MKP(); phase_prologue(P, lds, bid, G, tid); }
    } else if constexpr (STEP == NSTEPS - 1) {
        if constexpr (EN(101)) { MKP(); phase_final(P, ssq3, gw, NGW, lane); }
    } else {
            if constexpr (k == 0) {
if constexpr (EN(0)) {
                pg8::Gemm gm{XBg, Win, TG, NPA, D}; pg8::StaticOrder So; So.init(TG, NPA, G, bid); pg8::EpiProjA E{ATT, DNQ, Z, SMALL, rstd1};
                pg8::gemm_phase<pg8::EpiProjA, pg8::StaticOrder, true, true>((LAS unsigned char*)lds, gm, So, E, tid);
}
            } else if constexpr (k == 1) {
if constexpr (EN(1)) {
                phase_attn_naive(ATT, AO, ropeC, ropeS, S, gt, NGT);
}
            } else if constexpr (k == 2) {
if constexpr (EN(2)) {
                MKP(); phase_dnprep_naive(P, DNQ, SMALL, CONV, GATE, S, gw, NGW, gt, NGT, lane);
}
            } else if constexpr (k == 3) {
if constexpr (EN(3)) {
                phase_scan_naive(CONV, GATE, OF, OB, S, lds, bid, G, tid);
}
            } else if constexpr (k == 4) {
if constexpr (EN(4)) {
                MKP(); phase_combine(P, OF, OB, Z, DNOUT, gw, NGW, lane);
}
            } else if constexpr (k == 5) {
if constexpr (EN(5)) {
                pg8::Gemm gm{XBg, Win + (size_t)NPA * D, TG, 2048, D}; pg8::StaticOrder So; So.init(TG, 2048, G, bid); pg8::EpiGates E{Gt, rstd1};
                pg8::gemm_phase<pg8::EpiGates, pg8::StaticOrder, true, true>((LAS unsigned char*)lds, gm, So, E, tid);
}
            } else if constexpr (k == 6) {
if constexpr (EN(6)) {
                pg8::Gemm gm{AO, Wa, TG, D, 512}; pg8::StaticOrder So; So.init(TG, D, G, bid); pg8::EpiF32 E{YA, D};
                pg8::gemm_phase<pg8::EpiF32, pg8::StaticOrder, true, true>((LAS unsigned char*)lds, gm, So, E, tid);
}
            } else if constexpr (k == 7) {
if constexpr (EN(7)) {
                pg8::Gemm gm{DNOUT, Wb, TG, D, D}; pg8::StaticOrder So; So.init(TG, D, G, bid); pg8::EpiMix E{Gt, YA, MIX};
                pg8::gemm_phase<pg8::EpiMix, pg8::StaticOrder, true, true>((LAS unsigned char*)lds, gm, So, E, tid);
}
            } else if constexpr (k == 8) {
if constexpr (EN(8)) {
                pg8::Gemm gm{MIX, Wout, TG, D, D}; pg8::StaticOrder So; So.init(TG, D, G, bid);
                const float* RES = (g < 2) ? LDP(0) + (size_t)t0 * D : LDP(1); pg8::EpiRes E{RES, OUTg, XBg, ssq2 + t0};
                pg8::gemm_phase<pg8::EpiRes, pg8::StaticOrder, true, true>((LAS unsigned char*)lds, gm, So, E, tid);
}
            } else if constexpr (k == 9) {
if constexpr (EN(9)) {
                pg8::Gemm gm{XBg, Wup, TG, NUP, D}; pg8::StaticOrder So; So.init(TG, NUP, G, bid); pg8::EpiUp E{UP, ssq2 + t0};
                pg8::gemm_phase<pg8::EpiUp, pg8::StaticOrder, true, true>((LAS unsigned char*)lds, gm, So, E, tid);
}
            } else if constexpr (k == 10) {
if constexpr (EN(10)) {
                MKP(); phase_act_naive(P, UP, ACT, S, gt, NGT);
}
            } else {
if constexpr (EN(11)) {
                pg8::Gemm gm{ACT, Wdn, TG, D, DFF}; pg8::StaticOrder So; So.init(TG, D, G, bid); pg8::EpiRes E{OUTg, OUTg, nullptr, ssq3 + t0};
                pg8::gemm_phase<pg8::EpiRes, pg8::StaticOrder, true, true>((LAS unsigned char*)lds, gm, So, E, tid);
}
            }
    }
}
template <int ONLYK, int STEP> __device__ __forceinline__ void run_steps(unsigned char* lds, cg::grid_group& grid, int lo, int hi, int G, int NGW, int NGT, int wave_u) {
    if constexpr (STEP < NSTEPS) {
        if (lo <= STEP && STEP < hi) { run_step<ONLYK, STEP>(lds, G, NGW, NGT, wave_u); if (STEP + 1 < hi) grid.sync(); }
        run_steps<ONLYK, STEP + 1>(lds, grid, lo, hi, G, NGW, NGT, wave_u);
    }
}
template <int ONLYK> __global__ void __launch_bounds__(NTHREADS, 2) fwd(Args args) {
    extern __shared__ __attribute__((aligned(16))) unsigned char lds[];
    const int G = gridDim.x, NGW = G * NWAVES, NGT = G * NTHREADS;
    cg::grid_group grid = cg::this_grid();
    const int wave_u = __builtin_amdgcn_readfirstlane((int)threadIdx.x >> 6);
    run_steps<ONLYK, 0>(lds, grid, args.lo, args.hi, G, NGW, NGT, wave_u);
}

#ifndef ONE_LAUNCH
#define ONE_LAUNCH 1
#endif
#if !ONE_LAUNCH
template <int KK> static void launch_kind(int grid, hipStream_t stream, Args a) { hipLaunchKernelGGL(fwd<KK>, dim3(grid), dim3(NTHREADS), LDS_BYTES, stream, a); }
template <int KK> static bool set_lds() { return hipFuncSetAttribute((const void*)fwd<KK>, hipFuncAttributeMaxDynamicSharedMemorySize, LDS_BYTES) == hipSuccess; }
#endif
extern "C" void kernel_launch(void* const* d_in, const int* in_sizes, int n_in, void* d_out, int out_size, void* d_ws, size_t ws_size, hipStream_t stream) {
    static int grid = 0;
    if (grid == 0) {
        if (n_in != 19 || ws_size < WS_END) { fprintf(stderr, "kernel_launch: unexpected n_in %d / ws_size %zu (need %zu)\n", n_in, ws_size, (size_t)WS_END); grid = -1; return; }
        int dev = 0, cus = 0; (void)hipGetDevice(&dev); (void)hipDeviceGetAttribute(&cus, hipDeviceAttributeMultiprocessorCount, dev);
#if ONE_LAUNCH
        if (hipFuncSetAttribute((const void*)fwd<-1>, hipFuncAttributeMaxDynamicSharedMemorySize, LDS_BYTES) != hipSuccess) { fprintf(stderr, "kernel_launch: hipFuncSetAttribute failed\n"); grid = -1; return; }
        int per_cu = 0;
        if (hipOccupancyMaxActiveBlocksPerMultiprocessor(&per_cu, (const void*)fwd<-1>, NTHREADS, LDS_BYTES) != hipSuccess || per_cu < 1) { fprintf(stderr, "kernel_launch: occupancy query failed / %d blocks per CU\n", per_cu); grid = -1; return; }
        grid = cus;
#else
        bool ok = set_lds<0>() && set_lds<1>() && set_lds<2>() && set_lds<3>() && set_lds<4>() && set_lds<5>() && set_lds<6>() && set_lds<7>() && set_lds<8>() && set_lds<9>() && set_lds<10>() && set_lds<11>() && set_lds<100>() && set_lds<101>();
        if (!ok) { fprintf(stderr, "kernel_launch: hipFuncSetAttribute failed\n"); grid = -1; return; }
        grid = cus > 0 ? cus : 256;
#endif
    }
    if (grid < 0) return;
    (void)hipMemsetAsync((char*)d_ws + WS_CTL, 0, CTL_BYTES, stream);
    Args a{};
    for (int i = 0; i < 19; ++i) a.in[i] = (const float*)d_in[i];
    a.out = (float*)d_out; a.ws = (unsigned char*)d_ws;
#if ONE_LAUNCH
    a.lo = 0; a.hi = NSTEPS; void* kargs[] = {&a};
    hipError_t e = hipLaunchCooperativeKernel((const void*)fwd<-1>, dim3(grid), dim3(NTHREADS), kargs, LDS_BYTES, stream);
    if (e != hipSuccess) fprintf(stderr, "cooperative launch failed: %s (grid %d)\n", hipGetErrorString(e), grid);
#else
    for (int s = 0; s < NSTEPS; ++s) { a.lo = s; a.hi = s + 1;
        if (s == 0) launch_kind<100>(grid, stream, a); else if (s == NSTEPS - 1) launch_kind<101>(grid, stream, a);
        else switch ((s - 1) % STEPS_PER_GROUP) {
            case 0: launch_kind<0>(grid, stream, a); break; case 1: launch_kind<1>(grid, stream, a); break; case 2: launch_kind<2>(grid, stream, a); break; case 3: launch_kind<3>(grid, stream, a); break;
            case 4: launch_kind<4>(grid, stream, a); break; case 5: launch_kind<5>(grid, stream, a); break; case 6: launch_kind<6>(grid, stream, a); break; case 7: launch_kind<7>(grid, stream, a); break;
            case 8: launch_kind<8>(grid, stream, a); break; case 9: launch_kind<9>(grid, stream, a); break; case 10: launch_kind<10>(grid, stream, a); break; default: launch_kind<11>(grid, stream, a); break; }
    }
#endif
}
```

```cpp
#include <hip/hip_runtime.h>
#include <hip/hip_cooperative_groups.h>
#include <cstdio>
#include <cstdint>
namespace cg = cooperative_groups;
namespace pg8 {
#define PG8_LAS __attribute__((address_space(3)))
typedef unsigned short bf16_t;
typedef short bf16x8 __attribute__((ext_vector_type(8)));
typedef float f32x4 __attribute__((ext_vector_type(4)));
typedef unsigned u32x4 __attribute__((ext_vector_type(4)));
constexpr int BM = 256, BK = 64, HALF = 128, HTB = HALF * BK * 2  , STAGE_BYTES = 8 * HTB, NXCD = 8, WGM = 8;

__host__ __device__ __forceinline__ int lds_byte(int r, int c) { const int st = (r >> 4) * 2 + (c >> 5), rr = r & 15, cc = c & 31, ob = rr * 64 + cc * 2; return st * 1024 + (ob ^ (((ob >> 9) & 1) << 5)); }
__host__ __device__ __forceinline__ void stage_rc(int b, int& R, int& C) { const int st = b / 1024, sb = b % 1024, swz = sb ^ (((sb >> 9) & 1) << 5); R = (st >> 1) * 16 + swz / 64; C = (st & 1) * 32 + (swz % 64) / 2; }
__host__ __device__ __forceinline__ int perm32(int rho) { const int n = rho >> 4, i = rho & 15; return 8 * (i >> 2) + 4 * n + (i & 3); }

struct Unit { int pm, pn; };
struct Gemm { const bf16_t* A; const bf16_t* Bt; int M, N, K; };

struct StaticOrder {
    int nM, nN, nwg, G, c;
    __host__ __device__ void init(int M, int N, int G_, int c_) { nM = M / BM; nN = N / BM; nwg = nM * nN; G = G_; c = c_; }
    __host__ __device__ bool next(int i, Unit& u) const {
        const long L = (long)i * G + c; if (L >= nwg) return false;
        int wgid = (int)L; { const int q = nwg / NXCD, r = nwg % NXCD, xcd = wgid % NXCD, off = wgid / NXCD; wgid = (xcd < r ? xcd * (q + 1) : r * (q + 1) + (xcd - r) * q) + off; }
        const int nig = WGM * nN, gid = wgid / nig, fm = gid * WGM, gsz = (nM - fm) < WGM ? (nM - fm) : WGM;
        u.pm = fm + ((wgid % nig) % gsz); u.pn = (wgid % nig) / gsz; return true;
    }
    __device__ __forceinline__ void a_ready(const Unit&) const {}
    __device__ __forceinline__ void done(const Unit&) const {}
};

__device__ __forceinline__ unsigned cvt_pk_bf16(float lo, float hi) { unsigned r; asm volatile("v_cvt_pk_bf16_f32 %0, %1, %2" : "=v"(r) : "v"(lo), "v"(hi)); return r; }
typedef float f32x2 __attribute__((ext_vector_type(2)));
typedef unsigned u32x2 __attribute__((ext_vector_type(2)));
__device__ __forceinline__ float bflo(unsigned w) { return __uint_as_float(w << 16); }
__device__ __forceinline__ float bfhi(unsigned w) { return __uint_as_float(w & 0xffff0000u); }
__device__ __forceinline__ float sigmoidf_(float x) { return 1.0f / (1.0f + __expf(-x)); }
constexpr float RMS_EPS = 1e-6f;
__device__ __forceinline__ f32x2 gelu_pk(f32x2 v) {
    const f32x2 av = __builtin_elementwise_abs(v), d = av * 0.2316418882f + 1.0f;
    f32x2 t; t.x = __builtin_amdgcn_rcpf(d.x); t.y = __builtin_amdgcn_rcpf(d.y);
    f32x2 q = t * 0.5307027145f + (-0.7265760135f); q = q * t + 0.7107068705f; q = q * t + (-0.142248368f); q = q * t + 0.127414796f; q = q * t;
    const f32x2 s = (v * v) * (-0.72134752044f);
    f32x2 e; e.x = __builtin_amdgcn_exp2f(s.x); e.y = __builtin_amdgcn_exp2f(s.y);
    const f32x2 m = v * (q * e), r = v - m;
    f32x2 o; o.x = v.x < 0.f ? m.x : r.x; o.y = v.y < 0.f ? m.y : r.y; return o;
}

struct EpiProjA {
    static constexpr bool PERM = true, AFTER_DRAIN = false;
    bf16_t* ATT; bf16_t* DNQ; bf16_t* Z; float* SMALL; const float* rstd; const float* ropeC; const float* ropeS; int smask;
    __device__ __forceinline__ void operator()(const f32x4 (&acc)[2][2][4][2], const Unit& u, int wr, int wc, int fr, int fq) const {
        const int row0 = u.pm * BM + wr * 64 + fr; const int pn = u.pn;
        bf16_t* base; int ldc, colt;
        if (pn < 18) { base = ATT; ldc = 4608; colt = pn * 256; } else if (pn < 30) { base = DNQ; ldc = 3072; colt = (pn - 18) * 256; } else { base = Z; ldc = 1024; colt = (pn - 30) * 256; }
        const int col0 = colt + wc * 32 + 8 * fq;
        const bool do_rope = (pn < 12) && ((wc & 1) == 0);
        const float qs = (pn < 6) ? 0.18033688011112042f : 1.0f;
#pragma unroll
        for (int ai = 0; ai < 2; ++ai)
#pragma unroll
            for (int m = 0; m < 4; ++m) { const int r = row0 + ai * HALF + m * 16; const float rs = rstd[r];
                f32x4 c0 = {1.f, 1.f, 1.f, 1.f}, c1 = c0, s0 = {0.f, 0.f, 0.f, 0.f}, s1 = s0;
                if (do_rope) { const int pos = r & smask; c0 = *(const f32x4*)(ropeC + pos * 8); c1 = *(const f32x4*)(ropeC + pos * 8 + 4); s0 = *(const f32x4*)(ropeS + pos * 8); s1 = *(const f32x4*)(ropeS + pos * 8 + 4);
                    if (fq == 0) { s0 = -s0; s1 = -s1; } if (fq >= 2) { c0 = (f32x4){1.f, 1.f, 1.f, 1.f}; c1 = c0; s0 = (f32x4){0.f, 0.f, 0.f, 0.f}; s1 = s0; } }
#pragma unroll
                for (int bj = 0; bj < 2; ++bj) { f32x4 v0 = acc[ai][bj][m][0] * rs, v1 = acc[ai][bj][m][1] * rs;
                    if (do_rope) { f32x4 p0, p1;
#pragma unroll
                        for (int e = 0; e < 4; ++e) { p0[e] = __shfl_xor(v0[e], 16); p1[e] = __shfl_xor(v1[e], 16); }
                        v0 = v0 * c0 + p0 * s0; v1 = v1 * c1 + p1 * s1; }
                    v0 = v0 * qs; v1 = v1 * qs;
                    if (pn < 34) { u32x4 w; w.x = cvt_pk_bf16(v0[0], v0[1]); w.y = cvt_pk_bf16(v0[2], v0[3]); w.z = cvt_pk_bf16(v1[0], v1[1]); w.w = cvt_pk_bf16(v1[2], v1[3]);
                        *(u32x4*)(base + (size_t)r * ldc + col0 + bj * HALF) = w; }
                    else if (bj == 0 && wc == 0) { float* sp = SMALL + (size_t)r * 32 + 8 * fq; *(f32x4*)sp = v0; *(f32x4*)(sp + 4) = v1; } } }
    }
};
struct EpiGates {
    static constexpr bool PERM = true, AFTER_DRAIN = false;
    bf16_t* G; const float* rstd;
    __device__ __forceinline__ void operator()(const f32x4 (&acc)[2][2][4][2], const Unit& u, int wr, int wc, int fr, int fq) const {
        const int row0 = u.pm * BM + wr * 64 + fr; const int col0 = u.pn * BM + wc * 32 + 8 * fq;
#pragma unroll
        for (int ai = 0; ai < 2; ++ai)
#pragma unroll
            for (int m = 0; m < 4; ++m) { const int r = row0 + ai * HALF + m * 16; const float rs = rstd[r];
#pragma unroll
                for (int bj = 0; bj < 2; ++bj) { const f32x4 v0 = acc[ai][bj][m][0] * rs, v1 = acc[ai][bj][m][1] * rs;
                    u32x4 w; w.x = cvt_pk_bf16(sigmoidf_(v0[0]), sigmoidf_(v0[1])); w.y = cvt_pk_bf16(sigmoidf_(v0[2]), sigmoidf_(v0[3])); w.z = cvt_pk_bf16(sigmoidf_(v1[0]), sigmoidf_(v1[1])); w.w = cvt_pk_bf16(sigmoidf_(v1[2]), sigmoidf_(v1[3]));
                    *(u32x4*)(G + (size_t)r * 2048 + col0 + bj * HALF) = w; } }
    }
};
struct EpiF32 {
    static constexpr bool PERM = false, AFTER_DRAIN = false;
    float* C; int ldc;
    __device__ __forceinline__ void operator()(const f32x4 (&acc)[2][2][4][2], const Unit& u, int wr, int wc, int fr, int fq) const {
        const int row0 = u.pm * BM + wr * 64 + fr, col0 = u.pn * BM + wc * 32 + 4 * fq;
#pragma unroll
        for (int ai = 0; ai < 2; ++ai)
#pragma unroll
            for (int m = 0; m < 4; ++m) { float* rowp = C + (size_t)(row0 + ai * HALF + m * 16) * ldc + col0;
#pragma unroll
                for (int bj = 0; bj < 2; ++bj)
#pragma unroll
                    for (int n = 0; n < 2; ++n) *(f32x4*)(rowp + bj * HALF + n * 16) = acc[ai][bj][m][n]; }
    }
};
struct EpiMix {
    static constexpr bool PERM = true, AFTER_DRAIN = false;
    const bf16_t* G; const float* YA; bf16_t* MIX;
    __device__ __forceinline__ void operator()(const f32x4 (&acc)[2][2][4][2], const Unit& u, int wr, int wc, int fr, int fq) const {
        const int row0 = u.pm * BM + wr * 64 + fr; const int col0 = u.pn * BM + wc * 32 + 8 * fq;
#pragma unroll
        for (int ai = 0; ai < 2; ++ai)
#pragma unroll
            for (int m = 0; m < 4; ++m) { const int r = row0 + ai * HALF + m * 16;
#pragma unroll
                for (int bj = 0; bj < 2; ++bj) { const int c = col0 + bj * HALF;
                    const u32x4 ga = *(const u32x4*)(G + (size_t)r * 2048 + c), gb = *(const u32x4*)(G + (size_t)r * 2048 + 1024 + c);
                    const f32x4 y0 = *(const f32x4*)(YA + (size_t)r * 1024 + c), y1 = *(const f32x4*)(YA + (size_t)r * 1024 + c + 4);
                    const f32x4 a0 = acc[ai][bj][m][0], a1 = acc[ai][bj][m][1];
                    u32x4 w;
                    w.x = cvt_pk_bf16(bflo(ga.x) * y0[0] + bflo(gb.x) * a0[0], bfhi(ga.x) * y0[1] + bfhi(gb.x) * a0[1]);
                    w.y = cvt_pk_bf16(bflo(ga.y) * y0[2] + bflo(gb.y) * a0[2], bfhi(ga.y) * y0[3] + bfhi(gb.y) * a0[3]);
                    w.z = cvt_pk_bf16(bflo(ga.z) * y1[0] + bflo(gb.z) * a1[0], bfhi(ga.z) * y1[1] + bfhi(gb.z) * a1[1]);
                    w.w = cvt_pk_bf16(bflo(ga.w) * y1[2] + bflo(gb.w) * a1[2], bfhi(ga.w) * y1[3] + bfhi(gb.w) * a1[3]);
                    *(u32x4*)(MIX + (size_t)r * 1024 + c) = w; } }
    }
};
struct EpiRes {
    static constexpr bool PERM = false, AFTER_DRAIN = false;
    const float* RES; float* OUT; bf16_t* XB; float* ssq;
    __device__ __forceinline__ void operator()(const f32x4 (&acc)[2][2][4][2], const Unit& u, int wr, int wc, int fr, int fq) const {
        const int row0 = u.pm * BM + wr * 64 + fr, col0 = u.pn * BM + wc * 32 + 4 * fq;
#pragma unroll
        for (int ai = 0; ai < 2; ++ai)
#pragma unroll
            for (int m = 0; m < 4; ++m) { const int r = row0 + ai * HALF + m * 16; const size_t off = (size_t)r * 1024 + col0; float s = 0.f;
#pragma unroll
                for (int bj = 0; bj < 2; ++bj)
#pragma unroll
                    for (int n = 0; n < 2; ++n) { const size_t o2 = off + bj * HALF + n * 16; const f32x4 v = *(const f32x4*)(RES + o2) + acc[ai][bj][m][n];
                        *(f32x4*)(OUT + o2) = v; s += (v[0] * v[0] + v[1] * v[1]) + (v[2] * v[2] + v[3] * v[3]);
                        if (XB) { u32x2 w; w.x = cvt_pk_bf16(v[0], v[1]); w.y = cvt_pk_bf16(v[2], v[3]); *(u32x2*)(XB + o2) = w; } }
                s += __shfl_xor(s, 16); s += __shfl_xor(s, 32);
                if (fq == 0) atomicAdd(ssq + r, s); }
    }
};
struct EpiUp {
    static constexpr bool PERM = true, AFTER_DRAIN = false;
    bf16_t* UP; const float* ssq;
    __device__ __forceinline__ void operator()(const f32x4 (&acc)[2][2][4][2], const Unit& u, int wr, int wc, int fr, int fq) const {
        const int row0 = u.pm * BM + wr * 64 + fr; const int col0 = u.pn * BM + wc * 32 + 8 * fq;
#pragma unroll
        for (int ai = 0; ai < 2; ++ai)
#pragma unroll
            for (int m = 0; m < 4; ++m) { const int r = row0 + ai * HALF + m * 16; const float rs = rsqrtf(ssq[r] * (1.0f / 1024.0f) + RMS_EPS);
#pragma unroll
                for (int bj = 0; bj < 2; ++bj) { const f32x4 v0 = acc[ai][bj][m][0] * rs, v1 = acc[ai][bj][m][1] * rs;
                    u32x4 w; w.x = cvt_pk_bf16(v0[0], v0[1]); w.y = cvt_pk_bf16(v0[2], v0[3]); w.z = cvt_pk_bf16(v1[0], v1[1]); w.w = cvt_pk_bf16(v1[2], v1[3]);
                    *(u32x4*)(UP + (size_t)r * 5632 + col0 + bj * HALF) = w; } }
    }
};
template <class Epi, class Sched, bool ALIGN_EPI = false, bool SP2 = false>
__device__ __forceinline__ void gemm_phase(PG8_LAS unsigned char* lds, const Gemm g, const Sched& S, const Epi& E, int tid_) {
    asm volatile("" : "+v"(tid_)); const int tid = tid_, wid = __builtin_amdgcn_readfirstlane(tid >> 6), lane = tid & 63, wr = wid >> 2, wc = wid & 3, fr = lane & 15, fq = lane >> 4;
    const int K = g.K, nt = K / BK;
    unsigned voffA[2], voffB[2];
#pragma unroll
    for (int i = 0; i < 2; ++i) { int R, C; stage_rc(tid * 16 + i * 8192, R, C); const int Rb = Epi::PERM ? ((R & ~31) + perm32(R & 31)) : R;
        voffA[i] = (unsigned)(R * K + C) * 2u; voffB[i] = (unsigned)(Rb * K + C) * 2u; }
    const size_t kstep = (size_t)(BK * 2);
    const size_t hstep = (size_t)HALF * K * 2;
    const size_t tstep = 2 * hstep;
    const unsigned ldsw = (unsigned)wid * 1024u;
    const int aoff = lds_byte(wr * 64 + fr, fq * 8), boff = lds_byte(wc * 32 + fr, fq * 8);
#define PG8_SA(b, h) (((b) * 2 + (h)) * HTB)
#define PG8_SB(b, h) ((4 + (b) * 2 + (h)) * HTB)
#define PG8_STAGE(bufoff, gbase, voff) do { _Pragma("unroll") for (int _i = 0; _i < 2; ++_i) \
        __builtin_amdgcn_global_load_lds((const unsigned*)((const char*)(gbase) + (voff)[_i]), (PG8_LAS unsigned*)(lds + (bufoff) + ldsw + _i * 8192), 16, 0, 0); } while (0)
#define PG8_LDA(dst, b, h) do { _Pragma("unroll") for (int m = 0; m < 4; ++m) _Pragma("unroll") for (int k = 0; k < 2; ++k) dst[m][k] = *(const PG8_LAS bf16x8*)(lds + PG8_SA(b, h) + aoff + m * 2048 + k * 1024); } while (0)
#define PG8_LDB(dst, b, h) do { _Pragma("unroll") for (int n = 0; n < 2; ++n) _Pragma("unroll") for (int k = 0; k < 2; ++k) dst[n][k] = *(const PG8_LAS bf16x8*)(lds + PG8_SB(b, h) + boff + n * 2048 + k * 1024); } while (0)
#define PG8_MMA(ai, bj, At, Bt) do { __builtin_amdgcn_s_setprio(1); _Pragma("unroll") for (int m = 0; m < 4; ++m) _Pragma("unroll") for (int n = 0; n < 2; ++n) _Pragma("unroll") for (int k = 0; k < 2; ++k) \
        acc[ai][bj][m][n] = __builtin_amdgcn_mfma_f32_16x16x32_bf16(Bt[n][k], At[m][k], acc[ai][bj][m][n], 0, 0, 0); __builtin_amdgcn_s_setprio(0); } while (0)
#define PG8_WAIT_V(n) asm volatile("s_waitcnt vmcnt(" #n ")" ::: "memory")
#define PG8_WAIT_L(n) asm volatile("s_waitcnt lgkmcnt(" #n ")" ::: "memory")
#define PG8_BAR __builtin_amdgcn_s_barrier()
#define PG8_SCHED __builtin_amdgcn_sched_barrier(0)
    Unit cur, nxt; int ui = 0;
    if (!S.next(0, cur)) return;
    f32x4 acc[2][2][4][2];
    f32x4 zz_ = (f32x4){0.f, 0.f, 0.f, 0.f}; asm volatile("" : "+v"(zz_));
#pragma unroll
    for (int a = 0; a < 2; ++a)
#pragma unroll
        for (int b = 0; b < 2; ++b)
#pragma unroll
            for (int m = 0; m < 4; ++m)
#pragma unroll
                for (int n = 0; n < 2; ++n) acc[a][b][m][n] = zz_;
    bf16x8 At[4][2], B0[2][2], B1[2][2];
    const char* cA = (const char*)g.A + (size_t)cur.pm * tstep; const char* cB = (const char*)g.Bt + (size_t)cur.pn * tstep;
    S.a_ready(cur);
    if constexpr (SP2) {
        PG8_STAGE(PG8_SB(0, 0), cB, voffB); PG8_STAGE(PG8_SB(0, 1), cB + hstep, voffB); PG8_STAGE(PG8_SA(0, 0), cA, voffA); PG8_STAGE(PG8_SA(0, 1), cA + hstep, voffA);
        if (wr == 1) PG8_BAR;
        PG8_WAIT_V(2); PG8_BAR;
        PG8_STAGE(PG8_SB(1, 0), cB + kstep, voffB); PG8_STAGE(PG8_SA(1, 0), cA + kstep, voffA); PG8_STAGE(PG8_SB(1, 1), cB + hstep + kstep, voffB);
        PG8_WAIT_V(6); PG8_BAR;
    } else {
        PG8_STAGE(PG8_SB(0, 0), cB, voffB); PG8_STAGE(PG8_SA(0, 0), cA, voffA); PG8_STAGE(PG8_SB(0, 1), cB + hstep, voffB); PG8_STAGE(PG8_SA(0, 1), cA + hstep, voffA);
        if (wr == 1) PG8_BAR;
        PG8_WAIT_V(4); PG8_BAR;
        PG8_STAGE(PG8_SB(1, 0), cB + kstep, voffB); PG8_STAGE(PG8_SA(1, 0), cA + kstep, voffA); PG8_STAGE(PG8_SB(1, 1), cB + hstep + kstep, voffB);
        PG8_WAIT_V(6); PG8_BAR;
    }
    for (;;) {
        const bool has_next = S.next(ui + 1, nxt);
        const char* nA = has_next ? (const char*)g.A + (size_t)nxt.pm * tstep : cA; const char* nB = has_next ? (const char*)g.Bt + (size_t)nxt.pn * tstep : cB;
        for (int t = 0; t < nt; t += 2) {
            const bool last = (t == nt - 2);
            const char* a1 = cA + (size_t)(t + 1) * kstep;
            const char* a2 = last ? nA : cA + (size_t)(t + 2) * kstep; const char* b2 = last ? nB : cB + (size_t)(t + 2) * kstep;
            const char* a3 = a2 + kstep; const char* b3 = b2 + kstep;
            if (last && has_next) S.a_ready(nxt);
            if constexpr (SP2) {
            PG8_LDB(B0, 0, 0); PG8_LDB(B1, 0, 1); PG8_SCHED; PG8_LDA(At, 0, 0); PG8_STAGE(PG8_SA(1, 1), a1 + hstep, voffA);
            PG8_WAIT_V(8); PG8_WAIT_L(0); PG8_BAR; PG8_MMA(0, 0, At, B0); PG8_MMA(0, 1, At, B1); PG8_BAR; PG8_SCHED;
            PG8_LDA(At, 0, 1); PG8_STAGE(PG8_SB(0, 0), b2, voffB); PG8_STAGE(PG8_SB(0, 1), b2 + hstep, voffB); PG8_STAGE(PG8_SA(0, 0), a2, voffA);
            PG8_WAIT_V(8); PG8_WAIT_L(0); PG8_BAR; PG8_MMA(1, 0, At, B0); PG8_MMA(1, 1, At, B1); PG8_BAR; PG8_SCHED;
            PG8_LDB(B0, 1, 0); PG8_LDB(B1, 1, 1); PG8_SCHED; PG8_LDA(At, 1, 0); PG8_STAGE(PG8_SA(0, 1), a2 + hstep, voffA);
            PG8_WAIT_V(8); PG8_WAIT_L(0); PG8_BAR; PG8_MMA(0, 0, At, B0); PG8_MMA(0, 1, At, B1); PG8_BAR; PG8_SCHED;
            PG8_LDA(At, 1, 1); PG8_STAGE(PG8_SB(1, 0), b3, voffB); PG8_STAGE(PG8_SB(1, 1), b3 + hstep, voffB); PG8_STAGE(PG8_SA(1, 0), a3, voffA);
            PG8_WAIT_V(8); PG8_WAIT_L(0); PG8_BAR; PG8_MMA(1, 0, At, B0); PG8_MMA(1, 1, At, B1); PG8_BAR; PG8_SCHED;
            } else {
            PG8_LDB(B0, 0, 0); PG8_SCHED; PG8_LDA(At, 0, 0); PG8_STAGE(PG8_SA(1, 1), a1 + hstep, voffA);
            PG8_WAIT_L(8); PG8_BAR; PG8_WAIT_L(0); PG8_MMA(0, 0, At, B0); PG8_BAR; PG8_SCHED;
            PG8_LDB(B1, 0, 1); PG8_STAGE(PG8_SB(0, 0), b2, voffB);
            PG8_BAR; PG8_WAIT_L(0); PG8_MMA(0, 1, At, B1); PG8_BAR;
            PG8_LDA(At, 0, 1); PG8_STAGE(PG8_SA(0, 0), a2, voffA);
            PG8_BAR; PG8_WAIT_L(0); PG8_MMA(1, 0, At, B0); PG8_BAR; PG8_SCHED;
            PG8_STAGE(PG8_SB(0, 1), b2 + hstep, voffB);
            PG8_WAIT_V(6); PG8_BAR; PG8_MMA(1, 1, At, B1); PG8_BAR;
            PG8_LDB(B0, 1, 0); PG8_SCHED; PG8_LDA(At, 1, 0); PG8_STAGE(PG8_SA(0, 1), a2 + hstep, voffA);
            PG8_WAIT_L(8); PG8_BAR; PG8_WAIT_L(0); PG8_MMA(0, 0, At, B0); PG8_BAR; PG8_SCHED;
            PG8_LDB(B1, 1, 1); PG8_STAGE(PG8_SB(1, 0), b3, voffB);
            PG8_BAR; PG8_WAIT_L(0); PG8_MMA(0, 1, At, B1); PG8_BAR;
            PG8_LDA(At, 1, 1); PG8_STAGE(PG8_SA(1, 0), a3, voffA);
            PG8_BAR; PG8_WAIT_L(0); PG8_MMA(1, 0, At, B0); PG8_BAR; PG8_SCHED;
            PG8_STAGE(PG8_SB(1, 1), b3 + hstep, voffB);
            PG8_WAIT_V(6); PG8_BAR; PG8_MMA(1, 1, At, B1); PG8_BAR;
            }
        }
        if constexpr (ALIGN_EPI) { if (wr == 0) PG8_BAR; }
        if constexpr (!Epi::AFTER_DRAIN) { E(acc, cur, wr, wc, fr, fq); S.done(cur); }
        if (!has_next) break;
        zz_ = (f32x4){0.f, 0.f, 0.f, 0.f}; asm volatile("" : "+v"(zz_));
#pragma unroll
        for (int a = 0; a < 2; ++a)
#pragma unroll
            for (int b = 0; b < 2; ++b)
#pragma unroll
                for (int m = 0; m < 4; ++m)
#pragma unroll
                    for (int n = 0; n < 2; ++n) acc[a][b][m][n] = zz_;
        cur = nxt; cA = nA; cB = nB; ++ui;
        if constexpr (ALIGN_EPI) { if (wr == 1) PG8_BAR; }
    }
    PG8_WAIT_V(0);
    if constexpr (!ALIGN_EPI) { if (wr == 0) PG8_BAR; }
    PG8_BAR;
    if constexpr (Epi::AFTER_DRAIN) { E.fused(acc, cur, wr, wc, fr, fq, lds, wid, lane); S.done(cur); }
#undef PG8_SA
#undef PG8_SB
#undef PG8_STAGE
#undef PG8_LDA
#undef PG8_LDB
#undef PG8_MMA
#undef PG8_WAIT_V
#undef PG8_WAIT_L
#undef PG8_BAR
#undef PG8_SCHED
}
}

#define LAS __attribute__((address_space(3)))
typedef unsigned short bf16;
typedef float f32x4 __attribute__((ext_vector_type(4)));
typedef unsigned v4u __attribute__((ext_vector_type(4)));
typedef unsigned v2u __attribute__((ext_vector_type(2)));
using pg8::cvt_pk_bf16; using pg8::bflo; using pg8::bfhi;

constexpr int NWAVES = 8, NTHREADS = 512;
constexpr int D = 1024, NTOK = 49152, TG = 16384, NGROUPS = 3;
constexpr int ATTW = 4608, DNW = 3072, NPA = 8960  , NIN_T = 11008, DFF = 2816, NUP = 5632;
constexpr float EPS = 1e-6f;

constexpr size_t MiB = 1u << 20;
constexpr size_t WS_CTL = 0, CTL_BYTES = 1 * MiB;
constexpr size_t CTL_SSQ2 = 256 * 1024, CTL_SSQ3 = 512 * 1024;
constexpr size_t WS_WIN = 1 * MiB, WS_WUP = 23 * MiB, WS_WDOWN = 34 * MiB, WS_WOUT = 40 * MiB, WS_WA = 42 * MiB, WS_WB = 43 * MiB;
constexpr size_t WS_ROPE = 45 * MiB, WS_RSTD1 = 46 * MiB, WS_XB = 48 * MiB, WS_ARENA = 144 * MiB, WS_END = 512 * MiB;
constexpr size_t AR_ATT = 0, AR_DNQ = 144 * MiB, AR_Z = 240 * MiB, AR_SMALL = 272 * MiB, AR_GATE = 274 * MiB, AR_AO = 276 * MiB, AR_MIX = 292 * MiB;
constexpr size_t AR_CONV = 0;
constexpr size_t AR_OF = 144 * MiB, AR_OB = 176 * MiB, AR_DNOUT = 208 * MiB;
constexpr size_t AR_G = 0, AR_YA = 64 * MiB;
constexpr size_t AR_UP = 0, AR_ACT = 176 * MiB;
static_assert(WS_ARENA + AR_MIX + 50 * MiB <= WS_END, "ws map");

struct Args { const float* in[19]; float* out; unsigned char* ws; int lo, hi; };

__device__ __forceinline__ float wave_sum(float v) {
#pragma unroll
    for (int o = 1; o < 64; o <<= 1) v += __shfl_xor(v, o);
    return v;
}
__device__ __forceinline__ float bf2f(bf16 u) { return __uint_as_float((unsigned)u << 16); }
__device__ __forceinline__ float siluf_(float x) { return x / (1.0f + __expf(-x)); }

__device__ __forceinline__ void p0_transpose_item(const float* W, int ldw, int col_off, int K, int ncols, const float* gain, bf16* WT, int row_off, LAS float* scr, int item, int lane) {
    const int nblk = ncols / 32, kb = item / nblk, nb = item % nblk, k0 = 64 * kb, n0 = 32 * nb;
#pragma unroll 8
    for (int i = 0; i < 32; ++i) { const int kk = 2 * i + (lane >> 5); float w = W[(size_t)(k0 + kk) * ldw + col_off + n0 + (lane & 31)]; if (gain) w *= gain[k0 + kk]; scr[kk * 33 + (lane & 31)] = w; }
    asm volatile("s_waitcnt lgkmcnt(0)" ::: "memory");
    const int c = lane & 7;
#pragma unroll
    for (int j = 0; j < 4; ++j) { const int n = (lane >> 3) + 8 * j; const LAS float* s = scr + (8 * c) * 33 + n;
        v4u o; o.x = cvt_pk_bf16(s[0 * 33], s[1 * 33]); o.y = cvt_pk_bf16(s[2 * 33], s[3 * 33]); o.z = cvt_pk_bf16(s[4 * 33], s[5 * 33]); o.w = cvt_pk_bf16(s[6 * 33], s[7 * 33]);
        *(v4u*)(WT + (size_t)(row_off + n0 + n) * K + k0 + 8 * c) = o; }
    asm volatile("s_waitcnt lgkmcnt(0)" ::: "memory");
}

struct Ptrs {
    const float *x_p, *x_s, *norm_mix_g, *w_in, *conv_w, *a_log_f, *a_log_b, *dt_f, *dt_b, *out_norm_g, *w_a, *w_b, *w_out, *norm_ffn_g, *w_up, *ffn_conv_w, *ffn_conv_b, *w_down, *norm_final_g;
    float* out; unsigned char* ws;
};
__device__ __forceinline__ const float* x_row(const Ptrs& P, int tok) { return tok < 32768 ? P.x_p + (size_t)tok * D : P.x_s + (size_t)(tok - 32768) * D; }

__device__ __forceinline__ void phase_prologue(const Ptrs& P, unsigned char* lds, int bid, int G, int tid) {
    const int lane = tid & 63, wave = tid >> 6;
    LAS float* scr = (LAS float*)((LAS unsigned char*)lds + wave * 16384);
    const int gw = bid * NWAVES + wave, NGW = G * NWAVES;
    bf16* Win = (bf16*)(P.ws + WS_WIN); bf16* Wup = (bf16*)(P.ws + WS_WUP); bf16* Wdn = (bf16*)(P.ws + WS_WDOWN); bf16* Wout = (bf16*)(P.ws + WS_WOUT); bf16* Wa = (bf16*)(P.ws + WS_WA); bf16* Wb = (bf16*)(P.ws + WS_WB);
    constexpr int I1 = 16 * 273, I2 = 16 * 64, I3 = 8 * 32, I4 = 16 * 32, I5 = 16 * 32, I6 = 16 * 176, I7 = 44 * 32;
    constexpr int NIT = I1 + I2 + I3 + I4 + I5 + I6 + I7;
    for (int it = gw; it < NIT; it += NGW) {
        int r = it;
        if (r < I1) { p0_transpose_item(P.w_in, 10784, 0, 1024, 8736, P.norm_mix_g, Win, 0, scr, r, lane); continue; } r -= I1;
        if (r < I2) { p0_transpose_item(P.w_in, 10784, 8736, 1024, 2048, P.norm_mix_g, Win, 8960, scr, r, lane); continue; } r -= I2;
        if (r < I3) { p0_transpose_item(P.w_a, 1024, 0, 512, 1024, nullptr, Wa, 0, scr, r, lane); continue; } r -= I3;
        if (r < I4) { p0_transpose_item(P.w_b, 1024, 0, 1024, 1024, nullptr, Wb, 0, scr, r, lane); continue; } r -= I4;
        if (r < I5) { p0_transpose_item(P.w_out, 1024, 0, 1024, 1024, nullptr, Wout, 0, scr, r, lane); continue; } r -= I5;
        if (r < I6) { p0_transpose_item(P.w_up, 5632, 0, 1024, 5632, P.norm_ffn_g, Wup, 0, scr, r, lane); continue; } r -= I6;
        p0_transpose_item(P.w_down, 1024, 0, 2816, 1024, nullptr, Wdn, 0, scr, r, lane);
    }
    const int gt = bid * NTHREADS + tid, NGT = G * NTHREADS;
    for (int i = gt; i < 28672; i += NGT) ((v4u*)(Win + (size_t)8736 * 1024))[i] = (v4u){0u, 0u, 0u, 0u};
    float* ropeC = (float*)(P.ws + WS_ROPE); float* ropeS = ropeC + 4096 * 8;
    for (int i = gt; i < 4096 * 8; i += NGT) { const int pos = i >> 3, j = i & 7;
        const float invt[8] = {1.0f, 0.19392274f, 0.03760603f, 0.0072926646f, 0.0014142136f, 0.0002742482f, 5.3182957e-05f, 1.0313385e-05f};
        const float inv = invt[j]; const float ang = (float)pos * inv;
        const float c_hi = 0.15915494f, c_lo = 6.4206382e-09f;
        const float kq = rintf(ang * c_hi); float r = fmaf(ang, c_hi, -kq); r = fmaf(ang, c_lo, r);
        ropeC[i] = __builtin_amdgcn_cosf(r); ropeS[i] = __builtin_amdgcn_sinf(r); }
    bf16* XB = (bf16*)(P.ws + WS_XB); float* rstd1 = (float*)(P.ws + WS_RSTD1);
    for (int m = gw; m < NTOK; m += NGW) {
        const f32x4* xr = (const f32x4*)x_row(P, m) + lane; f32x4 v[4]; float s = 0.f;
#pragma unroll
        for (int j = 0; j < 4; ++j) { v[j] = xr[64 * j]; s += (v[j].x * v[j].x + v[j].y * v[j].y) + (v[j].z * v[j].z + v[j].w * v[j].w); }
        s = wave_sum(s);
        if (lane == 0) rstd1[m] = rsqrtf(s * (1.0f / 1024.0f) + EPS);
        unsigned long long* o8 = (unsigned long long*)(XB + (size_t)m * D) + lane;
#pragma unroll
        for (int j = 0; j < 4; ++j) o8[64 * j] = (unsigned long long)cvt_pk_bf16(v[j].x, v[j].y) | ((unsigned long long)cvt_pk_bf16(v[j].z, v[j].w) << 32);
    }
}

__device__ __forceinline__ void load8bf(const bf16* p, float* o) { const v4u w = *(const v4u*)p; o[0] = bflo(w.x); o[1] = bfhi(w.x); o[2] = bflo(w.y); o[3] = bfhi(w.y); o[4] = bflo(w.z); o[5] = bfhi(w.z); o[6] = bflo(w.w); o[7] = bfhi(w.w); }
typedef short bf16x8_t __attribute__((ext_vector_type(8)));
typedef float f32x16 __attribute__((ext_vector_type(16)));
typedef short s16x4_t __attribute__((ext_vector_type(4)));
__device__ __forceinline__ void phase_attn(const bf16* ATT, bf16* PO, float* LSE, int S, unsigned char* lds_, int bid, int G, int tid) {
    LAS unsigned char* lds = (LAS unsigned char*)lds_;
    const int lane = tid & 63, w = __builtin_amdgcn_readfirstlane(tid >> 6), ql = lane & 31, h2 = lane >> 5;
    const int NU = S >> 8, nunits = (TG / S) * 24 * NU;
    constexpr int KOFF = 0, VOFF = 49152;
    for (int u = bid; u < nunits; u += G) {
        const int idx = u % NU, bh = u / NU, h = bh % 24, b = bh / 24; const int gi = h >> 3, dil = (gi == 0) ? 1 : (gi == 1) ? 4 : 16, L = S / dil;
        const int seq0 = b * S;
        const bool two = (L < 256);
        const int r0 = two ? 2 * idx : idx % dil, p0 = two ? 0 : (idx / dil) * 256, sbase = two ? 0 : p0 - 64, nrows = two ? 256 : 384;
        { const int ri = lane >> 3, c = lane & 7;
          for (int pc = w; pc < nrows / 8; pc += NWAVES) { const int row = pc * 8 + ri; int cls, pos;
              if (two) { cls = r0 + (row >> 7); pos = row & 127; } else { cls = r0; pos = sbase + row; pos = pos < 0 ? 0 : (pos >= L ? L - 1 : pos); }
              const bf16* src = ATT + (size_t)(seq0 + cls + dil * pos) * ATTW + h * 64;
              __builtin_amdgcn_global_load_lds((const unsigned*)(src + 1536 + ((c ^ ri) << 3)), (LAS unsigned*)(lds + KOFF + pc * 1024), 16, 0, 0);
              __builtin_amdgcn_global_load_lds((const unsigned*)(src + 3072 + ((c ^ (((ri >> 1) & 1) << 2)) << 3)), (LAS unsigned*)(lds + VOFF + pc * 1024), 16, 0, 0); } }
        const int cls = two ? r0 + (w >> 2) : r0; const int qp0 = two ? 32 * (w & 3) : p0 + 32 * w;
        const int tokq = seq0 + cls + dil * (qp0 + ql);
        bf16x8_t qf[4];
#pragma unroll
        for (int s4 = 0; s4 < 4; ++s4) qf[s4] = *(const bf16x8_t*)(ATT + (size_t)tokq * ATTW + h * 64 + 16 * s4 + 8 * h2);
        const int lrow0 = (two ? (w >> 2) * 128 : 0) + qp0 - 64 - sbase;
        __syncthreads();
        f32x16 St[5]; float mx = -1e30f;
#pragma unroll
        for (int t = 0; t < 5; ++t) { const int kp0 = qp0 - 64 + 32 * t; const bool ok = (kp0 >= 0) && (kp0 < L);
            if (ok) { const int R = lrow0 + 32 * t + ql; f32x16 a = {};
#pragma unroll
                for (int s4 = 0; s4 < 4; ++s4) { const bf16x8_t kf = *(const LAS bf16x8_t*)(lds + KOFF + R * 128 + (((2 * s4 + h2) ^ (R & 7)) << 4)); a = __builtin_amdgcn_mfma_f32_32x32x16_bf16(kf, qf[s4], a, 0, 0, 0); }
#pragma unroll
                for (int rg = 0; rg < 16; ++rg) { const int row = (rg & 3) + 8 * (rg >> 2) + 4 * h2; if ((t == 0 && row < ql) || (t == 4 && row > ql)) a[rg] = -1e30f; mx = fmaxf(mx, a[rg]); }
                St[t] = a; }
            else { St[t] = (f32x16){}; } }
        mx = fmaxf(mx, __shfl_xor(mx, 32));
        float lsum = 0.f; f32x16 O0 = {}, O1 = {};
#pragma unroll
        for (int t = 0; t < 5; ++t) { const int kp0 = qp0 - 64 + 32 * t; const bool ok = (kp0 >= 0) && (kp0 < L);
            if (ok) { f32x16 p = St[t];
#pragma unroll
                for (int rg = 0; rg < 16; ++rg) { p[rg] = __builtin_amdgcn_exp2f(p[rg] - mx); lsum += p[rg]; }
#pragma unroll
                for (int s2 = 0; s2 < 2; ++s2) { v4u pk; pk.x = cvt_pk_bf16(p[8 * s2], p[8 * s2 + 1]); pk.y = cvt_pk_bf16(p[8 * s2 + 2], p[8 * s2 + 3]); pk.z = cvt_pk_bf16(p[8 * s2 + 4], p[8 * s2 + 5]); pk.w = cvt_pk_bf16(p[8 * s2 + 6], p[8 * s2 + 7]);
                    const bf16x8_t pb = __builtin_bit_cast(bf16x8_t, pk);
#pragma unroll
                    for (int dt = 0; dt < 2; ++dt) { const int g16 = (lane >> 4) & 1, qq = (lane & 15) >> 2, pp = lane & 3;
                        const int k0 = lrow0 + 32 * t + 16 * s2 + 4 * h2 + qq, k1 = k0 + 8;
                        const int a0 = VOFF + k0 * 128 + (((dt ^ ((k0 >> 1) & 1)) << 6) | (g16 << 5) | (pp << 3)), a1 = VOFF + k1 * 128 + (((dt ^ ((k1 >> 1) & 1)) << 6) | (g16 << 5) | (pp << 3));
                        const s16x4_t lo = __builtin_bit_cast(s16x4_t, __builtin_amdgcn_ds_read_tr16_b64_v4i16((LAS s16x4_t*)(lds + a0))), hi = __builtin_bit_cast(s16x4_t, __builtin_amdgcn_ds_read_tr16_b64_v4i16((LAS s16x4_t*)(lds + a1)));
                        const bf16x8_t vf = (bf16x8_t){lo[0], lo[1], lo[2], lo[3], hi[0], hi[1], hi[2], hi[3]};
                        if (dt == 0) O0 = __builtin_amdgcn_mfma_f32_32x32x16_bf16(vf, pb, O0, 0, 0, 0); else O1 = __builtin_amdgcn_mfma_f32_32x32x16_bf16(vf, pb, O1, 0, 0, 0); } } } }
        lsum += __shfl_xor(lsum, 32);
        const float il = 1.0f / lsum;
        bf16* po = PO + ((size_t)tokq * 24 + h) * 64;
#pragma unroll
        for (int g4 = 0; g4 < 4; ++g4) { v2u w0, w1; w0.x = cvt_pk_bf16(O0[4 * g4] * il, O0[4 * g4 + 1] * il); w0.y = cvt_pk_bf16(O0[4 * g4 + 2] * il, O0[4 * g4 + 3] * il); w1.x = cvt_pk_bf16(O1[4 * g4] * il, O1[4 * g4 + 1] * il); w1.y = cvt_pk_bf16(O1[4 * g4 + 2] * il, O1[4 * g4 + 3] * il);
            *(v2u*)(po + 8 * g4 + 4 * h2) = w0; *(v2u*)(po + 32 + 8 * g4 + 4 * h2) = w1; }
        if (h2 == 0) LSE[(size_t)tokq * 24 + h] = mx + __builtin_amdgcn_logf(lsum);
        __syncthreads();
    }
}
__device__ __forceinline__ void phase_attn_combine(const bf16* PO, const float* LSE, bf16* AO, int gt, int NGT) {
    for (int item = gt; item < TG * 64; item += NGT) { const int tok = item >> 6, hg = (item >> 3) & 7, c = item & 7;
        const float l0 = LSE[(size_t)tok * 24 + hg], l1 = LSE[(size_t)tok * 24 + 8 + hg], l2 = LSE[(size_t)tok * 24 + 16 + hg]; const float m = fmaxf(l0, fmaxf(l1, l2));
        float w0 = __builtin_amdgcn_exp2f(l0 - m), w1 = __builtin_amdgcn_exp2f(l1 - m), w2 = __builtin_amdgcn_exp2f(l2 - m); const float inv = 1.0f / (w0 + w1 + w2); w0 *= inv; w1 *= inv; w2 *= inv;
        float a[8], b8[8], c8[8]; load8bf(PO + ((size_t)tok * 24 + hg) * 64 + c * 8, a); load8bf(PO + ((size_t)tok * 24 + 8 + hg) * 64 + c * 8, b8); load8bf(PO + ((size_t)tok * 24 + 16 + hg) * 64 + c * 8, c8);
#pragma unroll
        for (int e = 0; e < 8; ++e) a[e] = w0 * a[e] + w1 * b8[e] + w2 * c8[e];
        v4u o; o.x = cvt_pk_bf16(a[0], a[1]); o.y = cvt_pk_bf16(a[2], a[3]); o.z = cvt_pk_bf16(a[4], a[5]); o.w = cvt_pk_bf16(a[6], a[7]);
        *(v4u*)(AO + (size_t)tok * 512 + hg * 64 + c * 8) = o; }
}

__device__ __forceinline__ void phase_dnprep_naive(const Ptrs& P, const bf16* DNQ, const float* SMALL, bf16* CONV, float* GATE, int S, int gw, int NGW, int gt, int NGT, int lane) {
    for (int item = gw; item < TG * 24; item += NGW) {
        const int tok = item / 24, part = item % 24; const int pos = tok % S; const int c = part * 128 + lane * 2;
        float a0 = 0.f, a1 = 0.f;
#pragma unroll
        for (int i = 0; i < 5; ++i) { const int p2 = pos + i - 2; if (p2 >= 0 && p2 < S) { const unsigned w = *(const unsigned*)(DNQ + (size_t)(tok + i - 2) * DNW + c);
                a0 += bflo(w) * P.conv_w[i * DNW + c]; a1 += bfhi(w) * P.conv_w[i * DNW + c + 1]; } }
        a0 = siluf_(a0); a1 = siluf_(a1);
        if (part < 16) { const float ss = wave_sum(a0 * a0 + a1 * a1); float sc = rsqrtf(ss + EPS); if (part < 8) sc *= 0.08838834764831845f; a0 *= sc; a1 *= sc; }
        *(unsigned*)(CONV + (size_t)tok * DNW + c) = cvt_pk_bf16(a0, a1);
    }
    for (int i = gt; i < TG * 32; i += NGT) { const int j = i & 31, h = j & 7; const float s = SMALL[i]; float r;
        if (j < 16) r = 1.0f / (1.0f + __expf(-s));
        else { const float al = (j < 24) ? P.a_log_f[h] : P.a_log_b[h], db = (j < 24) ? P.dt_f[h] : P.dt_b[h]; const float xx = s + db; const float sp = (xx > 20.f) ? xx : __logf(1.0f + __expf(xx)); r = -__expf(al) * sp; }
        GATE[i] = r; }
}

__device__ __forceinline__ void phase_scan_naive(const bf16* CONV, const float* GATE, bf16* OF, bf16* OB, int S, unsigned char* lds, int bid, int G, int tid) {
    const int col = tid >> 2, kq = tid & 3; const int nchain = (TG / S) * 16;
    float* qs = (float*)lds; float* ks = qs + 2048;
    for (int chain = bid; chain < nchain; chain += G) {
        const int dir = chain & 1, h = (chain >> 1) & 7, b = chain >> 4;
        float St[32];
#pragma unroll
        for (int k = 0; k < 32; ++k) St[k] = 0.f;
        bf16* O = dir ? OB : OF;
        for (int tb = 0; tb < S; tb += 16) {
            __syncthreads();
#pragma unroll
            for (int i = 0; i < 4; ++i) { const int ii = i * 4 + kq; const int t = dir ? (S - 1 - (tb + ii)) : (tb + ii); const size_t row = (size_t)(b * S + t) * DNW;
                qs[ii * 128 + col] = bf2f(CONV[row + h * 128 + col]); ks[ii * 128 + col] = bf2f(CONV[row + 1024 + h * 128 + col]); }
            __syncthreads();
            for (int i = 0; i < 16; ++i) { const int t = dir ? (S - 1 - (tb + i)) : (tb + i); const size_t tokr = (size_t)(b * S + t);
                const float g = GATE[tokr * 32 + 16 + dir * 8 + h], beta = GATE[tokr * 32 + dir * 8 + h]; const float dec = __expf(g);
                const float v = bf2f(CONV[tokr * DNW + 2048 + h * 128 + col]);
                const float* kr = ks + i * 128 + kq * 32; const float* qr = qs + i * 128 + kq * 32;
                float dot = 0.f;
#pragma unroll
                for (int k = 0; k < 32; ++k) { St[k] *= dec; dot += kr[k] * St[k]; }
                dot += __shfl_xor(dot, 1); dot += __shfl_xor(dot, 2);
                const float vn = beta * (v - dot); float o = 0.f;
#pragma unroll
                for (int k = 0; k < 32; ++k) { St[k] += kr[k] * vn; o += qr[k] * St[k]; }
                o += __shfl_xor(o, 1); o += __shfl_xor(o, 2);
                if (kq == 0) O[tokr * 1024 + h * 128 + col] = (bf16)(cvt_pk_bf16(o, 0.f) & 0xffffu); }
        }
    }
}

__device__ __forceinline__ void phase_combine(const Ptrs& P, const bf16* OF, const bf16* OB, const bf16* Z, bf16* DNOUT, int gw, int NGW, int lane) {
    for (int item = gw; item < TG * 8; item += NGW) { const size_t off = (size_t)item * 128 + lane * 2;
        const unsigned a = *(const unsigned*)(OF + off), b = *(const unsigned*)(OB + off), z = *(const unsigned*)(Z + off);
        const float o0 = bflo(a) + bflo(b), o1 = bfhi(a) + bfhi(b); const float ss = wave_sum(o0 * o0 + o1 * o1); const float rs = rsqrtf(ss * (1.0f / 128.0f) + EPS);
        const float y0 = o0 * rs * P.out_norm_g[lane * 2] * siluf_(bflo(z)), y1 = o1 * rs * P.out_norm_g[lane * 2 + 1] * siluf_(bfhi(z));
        *(unsigned*)(DNOUT + off) = cvt_pk_bf16(y0, y1); }
}

__device__ __forceinline__ float gelu_erf(float v) { const pg8::f32x2 r = pg8::gelu_pk((pg8::f32x2){v, v}); return r.x; }
__device__ __forceinline__ void phase_act_naive(const Ptrs& P, const bf16* UP, bf16* ACT, int S, int gt, int NGT) {
    for (int item = gt; item < TG * (DFF / 8); item += NGT) { const int tok = item / (DFF / 8), c = (item % (DFF / 8)) * 8; const int pos = tok % S;
        float a[8], vv[8];
#pragma unroll
        for (int e = 0; e < 8; ++e) a[e] = P.ffn_conv_b[c + e];
#pragma unroll
        for (int i = 0; i < 3; ++i) { const int p2 = pos + i - 1; if (p2 >= 0 && p2 < S) { float g[8]; load8bf(UP + (size_t)(tok + i - 1) * NUP + c, g);
#pragma unroll
                for (int e = 0; e < 8; ++e) a[e] += g[e] * P.ffn_conv_w[i * DFF + c + e]; } }
        load8bf(UP + (size_t)tok * NUP + DFF + c, vv);
#pragma unroll
        for (int e = 0; e < 8; ++e) a[e] = gelu_erf(a[e]) * vv[e];
        v4u w; w.x = cvt_pk_bf16(a[0], a[1]); w.y = cvt_pk_bf16(a[2], a[3]); w.z = cvt_pk_bf16(a[4], a[5]); w.w = cvt_pk_bf16(a[6], a[7]);
        *(v4u*)(ACT + (size_t)tok * DFF + c) = w; }
}

__device__ __forceinline__ void phase_final(const Ptrs& P, const float* ssq3, int gw, int NGW, int lane) {
    for (int m = gw; m < NTOK; m += NGW) { const float rs = rsqrtf(ssq3[m] * (1.0f / 1024.0f) + EPS); f32x4* xr = (f32x4*)(P.out + (size_t)m * D) + lane; const f32x4* gr = (const f32x4*)P.norm_final_g + lane;
#pragma unroll
        for (int j = 0; j < 4; ++j) xr[64 * j] = xr[64 * j] * rs * gr[64 * j]; }
}

#define EN(k) (ONLYK < 0 || ONLYK == (k))
constexpr int LDS_BYTES = 147456;
constexpr int STEPS_PER_GROUP = 12, NSTEPS = 1 + NGROUPS * STEPS_PER_GROUP + 1;

#define LDP(i) ((const float*)ap->in[i])
#define MKP() Ptrs P; P.x_p = LDP(0); P.x_s = LDP(1); P.norm_mix_g = LDP(2); P.w_in = LDP(3); P.conv_w = LDP(4); P.a_log_f = LDP(5); P.a_log_b = LDP(6); P.dt_f = LDP(7); P.dt_b = LDP(8); \
        P.out_norm_g = LDP(9); P.w_a = LDP(10); P.w_b = LDP(11); P.w_out = LDP(12); P.norm_ffn_g = LDP(13); P.w_up = LDP(14); P.ffn_conv_w = LDP(15); P.ffn_conv_b = LDP(16); P.w_down = LDP(17); P.norm_final_g = LDP(18); \
        P.out = ap->out; P.ws = ap->ws;
#define WSP ((unsigned char*)ap->ws)
#define ARP (WSP + WS_ARENA)
#define Win ((bf16*)(WSP + WS_WIN))
#define Wup ((bf16*)(WSP + WS_WUP))
#define Wdn ((bf16*)(WSP + WS_WDOWN))
#define Wout ((bf16*)(WSP + WS_WOUT))
#define Wa ((bf16*)(WSP + WS_WA))
#define Wb ((bf16*)(WSP + WS_WB))
#define ropeC ((const float*)(WSP + WS_ROPE))
#define ropeS (ropeC + 4096 * 8)
#define ssq2 ((float*)(WSP + WS_CTL + CTL_SSQ2))
#define ssq3 ((float*)(WSP + WS_CTL + CTL_SSQ3))
#define XBg ((bf16*)(WSP + WS_XB) + (size_t)t0 * D)
#define rstd1 ((const float*)(WSP + WS_RSTD1) + t0)
#define ATT ((bf16*)(ARP + AR_ATT))
#define DNQ ((bf16*)(ARP + AR_DNQ))
#define Z ((bf16*)(ARP + AR_Z))
#define SMALL ((float*)(ARP + AR_SMALL))
#define GATE ((float*)(ARP + AR_GATE))
#define AO ((bf16*)(ARP + AR_AO))
#define MIX ((bf16*)(ARP + AR_MIX))
#define CONV ((bf16*)(ARP + AR_CONV))
#define PO ((bf16*)(ARP + AR_MIX))
#define LSE2 ((float*)(ARP + AR_MIX + 48 * MiB))
#define OF ((bf16*)(ARP + AR_OF))
#define OB ((bf16*)(ARP + AR_OB))
#define DNOUT ((bf16*)(ARP + AR_DNOUT))
#define Gt ((bf16*)(ARP + AR_G))
#define YA ((float*)(ARP + AR_YA))
#define UP ((bf16*)(ARP + AR_UP))
#define ACT ((bf16*)(ARP + AR_ACT))
#define OUTg ((float*)ap->out + (size_t)t0 * D)
#define STEP_PRE() int tid = wave_u * 64 + (int)__builtin_amdgcn_mbcnt_hi(~0u, __builtin_amdgcn_mbcnt_lo(~0u, 0u)), bid = blockIdx.x; typedef const __attribute__((address_space(4))) Args* kargp_t; kargp_t ap = (kargp_t)__builtin_amdgcn_kernarg_segment_ptr(); asm volatile("" : "+v"(tid), "+s"(bid), "+s"(ap)); \
        const int lane = tid & 63, wave = tid >> 6, gw = bid * NWAVES + wave, gt = bid * NTHREADS + tid; (void)lane; (void)wave; (void)gw; (void)gt;
template <int ONLYK, int STEP> __device__ __forceinline__ void run_step(unsigned char* lds, int G, int NGW, int NGT, int wave_u) {
    STEP_PRE();
    constexpr int g = (STEP - 1) / STEPS_PER_GROUP, k = (STEP - 1) % STEPS_PER_GROUP; constexpr int t0 = g * TG; constexpr int S = (g < 2) ? 2048 : 4096;
    if constexpr (STEP == 0) {
        if constexpr (EN(100)) { MKP(); phase_prologue(P, lds, bid, G, tid); }
    } else if constexpr (STEP == NSTEPS - 1) {
        if constexpr (EN(101)) { MKP(); phase_final(P, ssq3, gw, NGW, lane); }
    } else {
            if constexpr (k == 0) {
if constexpr (EN(0)) {
                pg8::Gemm gm{XBg, Win, TG, NPA, D}; pg8::StaticOrder So; So.init(TG, NPA, G, bid); pg8::EpiProjA E{ATT, DNQ, Z, SMALL, rstd1, ropeC, ropeS, S - 1};
                pg8::gemm_phase<pg8::EpiProjA, pg8::StaticOrder, true, true>((LAS unsigned char*)lds, gm, So, E, tid);
}
            } else if constexpr (k == 1) {
if constexpr (EN(1)) {
                phase_attn(ATT, PO, LSE2, S, lds, bid, G, tid);
}
            } else if constexpr (k == 2) {
if constexpr (EN(2)) {
                MKP(); phase_dnprep_naive(P, DNQ, SMALL, CONV, GATE, S, gw, NGW, gt, NGT, lane);
}
            } else if constexpr (k == 3) {
if constexpr (EN(3)) {
                phase_scan_naive(CONV, GATE, OF, OB, S, lds, bid, G, tid);
}
            } else if constexpr (k == 4) {
if constexpr (EN(4)) {
                phase_attn_combine(PO, LSE2, AO, gt, NGT); MKP(); phase_combine(P, OF, OB, Z, DNOUT, gw, NGW, lane);
}
            } else if constexpr (k == 5) {
if constexpr (EN(5)) {
                pg8::Gemm gm{XBg, Win + (size_t)NPA * D, TG, 2048, D}; pg8::StaticOrder So; So.init(TG, 2048, G, bid); pg8::EpiGates E{Gt, rstd1};
                pg8::gemm_phase<pg8::EpiGates, pg8::StaticOrder, true, true>((LAS unsigned char*)lds, gm, So, E, tid);
}
            } else if constexpr (k == 6) {
if constexpr (EN(6)) {
                pg8::Gemm gm{AO, Wa, TG, D, 512}; pg8::StaticOrder So; So.init(TG, D, G, bid); pg8::EpiF32 E{YA, D};
                pg8::gemm_phase<pg8::EpiF32, pg8::StaticOrder, true, true>((LAS unsigned char*)lds, gm, So, E, tid);
}
            } else if constexpr (k == 7) {
if constexpr (EN(7)) {
                pg8::Gemm gm{DNOUT, Wb, TG, D, D}; pg8::StaticOrder So; So.init(TG, D, G, bid); pg8::EpiMix E{Gt, YA, MIX};
                pg8::gemm_phase<pg8::EpiMix, pg8::StaticOrder, true, true>((LAS unsigned char*)lds, gm, So, E, tid);
}
            } else if constexpr (k == 8) {
if constexpr (EN(8)) {
                pg8::Gemm gm{MIX, Wout, TG, D, D}; pg8::StaticOrder So; So.init(TG, D, G, bid);
                const float* RES = (g < 2) ? LDP(0) + (size_t)t0 * D : LDP(1); pg8::EpiRes E{RES, OUTg, XBg, ssq2 + t0};
                pg8::gemm_phase<pg8::EpiRes, pg8::StaticOrder, true, true>((LAS unsigned char*)lds, gm, So, E, tid);
}
            } else if constexpr (k == 9) {
if constexpr (EN(9)) {
                pg8::Gemm gm{XBg, Wup, TG, NUP, D}; pg8::StaticOrder So; So.init(TG, NUP, G, bid); pg8::EpiUp E{UP, ssq2 + t0};
                pg8::gemm_phase<pg8::EpiUp, pg8::StaticOrder, true, true>((LAS unsigned char*)lds, gm, So, E, tid);
}
            } else if constexpr (k == 10) {
if constexpr (EN(10)) {
                MKP(); phase_act_naive(P, UP, ACT, S, gt, NGT);
}
            } else {
if constexpr (EN(11)) {
                pg8::Gemm gm{ACT, Wdn, TG, D, DFF}; pg8::StaticOrder So; So.init(TG, D, G, bid); pg8::EpiRes E{OUTg, OUTg, nullptr, ssq3 + t0};
                pg8::gemm_phase<pg8::EpiRes, pg8::StaticOrder, true, true>((LAS unsigned char*)lds, gm, So, E, tid);
}
            }
    }
}
template <int ONLYK, int STEP> __device__ __forceinline__ void run_steps(unsigned char* lds, cg::grid_group& grid, int lo, int hi, int G, int NGW, int NGT, int wave_u) {
    if constexpr (STEP < NSTEPS) {
        if (lo <= STEP && STEP < hi) { run_step<ONLYK, STEP>(lds, G, NGW, NGT, wave_u); if (STEP + 1 < hi) grid.sync(); }
        run_steps<ONLYK, STEP + 1>(lds, grid, lo, hi, G, NGW, NGT, wave_u);
    }
}
template <int ONLYK> __global__ void __launch_bounds__(NTHREADS, 2) fwd(Args args) {
    extern __shared__ __attribute__((aligned(16))) unsigned char lds[];
    const int G = gridDim.x, NGW = G * NWAVES, NGT = G * NTHREADS;
    cg::grid_group grid = cg::this_grid();
    const int wave_u = __builtin_amdgcn_readfirstlane((int)threadIdx.x >> 6);
    run_steps<ONLYK, 0>(lds, grid, args.lo, args.hi, G, NGW, NGT, wave_u);
}

#ifndef ONE_LAUNCH
#define ONE_LAUNCH 1
#endif
#if !ONE_LAUNCH
template <int KK> static void launch_kind(int grid, hipStream_t stream, Args a) { hipLaunchKernelGGL(fwd<KK>, dim3(grid), dim3(NTHREADS), LDS_BYTES, stream, a); }
template <int KK> static bool set_lds() { return hipFuncSetAttribute((const void*)fwd<KK>, hipFuncAttributeMaxDynamicSharedMemorySize, LDS_BYTES) == hipSuccess; }
#endif
extern "C" void kernel_launch(void* const* d_in, const int* in_sizes, int n_in, void* d_out, int out_size, void* d_ws, size_t ws_size, hipStream_t stream) {
    static int grid = 0;
    if (grid == 0) {
        if (n_in != 19 || ws_size < WS_END) { fprintf(stderr, "kernel_launch: unexpected n_in %d / ws_size %zu (need %zu)\n", n_in, ws_size, (size_t)WS_END); grid = -1; return; }
        int dev = 0, cus = 0; (void)hipGetDevice(&dev); (void)hipDeviceGetAttribute(&cus, hipDeviceAttributeMultiprocessorCount, dev);
#if ONE_LAUNCH
        if (hipFuncSetAttribute((const void*)fwd<-1>, hipFuncAttributeMaxDynamicSharedMemorySize, LDS_BYTES) != hipSuccess) { fprintf(stderr, "kernel_launch: hipFuncSetAttribute failed\n"); grid = -1; return; }
        int per_cu = 0;
        if (hipOccupancyMaxActiveBlocksPerMultiprocessor(&per_cu, (const void*)fwd<-1>, NTHREADS, LDS_BYTES) != hipSuccess || per_cu < 1) { fprintf(stderr, "kernel_launch: occupancy query failed / %d blocks per CU\n", per_cu); grid = -1; return; }
        grid = cus;
#else
        bool ok = set_lds<0>() && set_lds<1>() && set_lds<2>() && set_lds<3>() && set_lds<4>() && set_lds<5>() && set_lds<6>() && set_lds<7>() && set_lds<8>() && set_lds<9>() && set_lds<10>() && set_lds<11>() && set_lds<100>() && set_lds<101>();
        if (!ok) { fprintf(stderr, "kernel_launch: hipFuncSetAttribute failed\n"); grid = -1; return; }
        grid = cus > 0 ? cus : 256;
#endif
    }
    if (grid < 0) return;
    (void)hipMemsetAsync((char*)d_ws + WS_CTL, 0, CTL_BYTES, stream);
    Args a{};
    for (int i = 0; i < 19; ++i) a.in[i] = (const float*)d_in[i];
    a.out = (float*)d_out; a.ws = (unsigned char*)d_ws;
#if ONE_LAUNCH
    a.lo = 0; a.hi = NSTEPS; void* kargs[] = {&a};
    hipError_t e = hipLaunchCooperativeKernel((const void*)fwd<-1>, dim3(grid), dim3(NTHREADS), kargs, LDS_BYTES, stream);
    if (e != hipSuccess) fprintf(stderr, "cooperative launch failed: %s (grid %d)\n", hipGetErrorString(e), grid);
#else
    for (int s = 0; s < NSTEPS; ++s) { a.lo = s; a.hi = s + 1;
        if (s == 0) launch_kind<100>(grid, stream, a); else if (s == NSTEPS - 1) launch_kind<101>(grid, stream, a);
        else switch ((s - 1) % STEPS_PER_GROUP) {
            case 0: launch_kind<0>(grid, stream, a); break; case 1: launch_kind<1>(grid, stream, a); break; case 2: launch_kind<2>(grid, stream, a); break; case 3: launch_kind<3>(grid, stream, a); break;
            case 4: launch_kind<4>(grid, stream, a); break; case 5: launch_kind<5>(grid, stream, a); break; case 6: launch_kind<6>(grid, stream, a); break; case 7: launch_kind<7>(grid, stream, a); break;
            case 8: launch_kind<8>(grid, stream, a); break; case 9: launch_kind<9>(grid, stream, a); break; case 10: launch_kind<10>(grid, stream, a); break; default: launch_kind<11>(grid, stream, a); break; }
    }
#endif
}
```

```cpp
#include <hip/hip_runtime.h>
#include <hip/hip_cooperative_groups.h>
#include <cstdio>
#include <cstdint>
namespace cg = cooperative_groups;
namespace pg8 {
#define PG8_LAS __attribute__((address_space(3)))
typedef unsigned short bf16_t;
typedef short bf16x8 __attribute__((ext_vector_type(8)));
typedef float f32x4 __attribute__((ext_vector_type(4)));
typedef unsigned u32x4 __attribute__((ext_vector_type(4)));
constexpr int BM = 256, BK = 64, HALF = 128, HTB = HALF * BK * 2  , STAGE_BYTES = 8 * HTB, NXCD = 8, WGM = 8;

__host__ __device__ __forceinline__ int lds_byte(int r, int c) { const int st = (r >> 4) * 2 + (c >> 5), rr = r & 15, cc = c & 31, ob = rr * 64 + cc * 2; return st * 1024 + (ob ^ (((ob >> 9) & 1) << 5)); }
__host__ __device__ __forceinline__ void stage_rc(int b, int& R, int& C) { const int st = b / 1024, sb = b % 1024, swz = sb ^ (((sb >> 9) & 1) << 5); R = (st >> 1) * 16 + swz / 64; C = (st & 1) * 32 + (swz % 64) / 2; }
__host__ __device__ __forceinline__ int perm32(int rho) { const int n = rho >> 4, i = rho & 15; return 8 * (i >> 2) + 4 * n + (i & 3); }

struct Unit { int pm, pn; };
struct Gemm { const bf16_t* A; const bf16_t* Bt; int M, N, K; };

struct StaticOrder {
    int nM, nN, nwg, G, c;
    __host__ __device__ void init(int M, int N, int G_, int c_) { nM = M / BM; nN = N / BM; nwg = nM * nN; G = G_; c = c_; }
    __host__ __device__ bool next(int i, Unit& u) const {
        const long L = (long)i * G + c; if (L >= nwg) return false;
        int wgid = (int)L; { const int q = nwg / NXCD, r = nwg % NXCD, xcd = wgid % NXCD, off = wgid / NXCD; wgid = (xcd < r ? xcd * (q + 1) : r * (q + 1) + (xcd - r) * q) + off; }
        const int nig = WGM * nN, gid = wgid / nig, fm = gid * WGM, gsz = (nM - fm) < WGM ? (nM - fm) : WGM;
        u.pm = fm + ((wgid % nig) % gsz); u.pn = (wgid % nig) / gsz; return true;
    }
    __device__ __forceinline__ void a_ready(const Unit&) const {}
    __device__ __forceinline__ void done(const Unit&) const {}
};

typedef float f32x2_cv __attribute__((ext_vector_type(2))); typedef __bf16 bf16x2_cv __attribute__((ext_vector_type(2)));
__device__ __forceinline__ unsigned cvt_pk_bf16(float lo, float hi) { const f32x2_cv v = {lo, hi}; const bf16x2_cv b = __builtin_convertvector(v, bf16x2_cv); return __builtin_bit_cast(unsigned, b); }
typedef float f32x2 __attribute__((ext_vector_type(2)));
typedef unsigned u32x2 __attribute__((ext_vector_type(2)));
__device__ __forceinline__ float bflo(unsigned w) { return __uint_as_float(w << 16); }
__device__ __forceinline__ float bfhi(unsigned w) { return __uint_as_float(w & 0xffff0000u); }
__device__ __forceinline__ float sigmoidf_(float x) { return 1.0f / (1.0f + __expf(-x)); }
constexpr float RMS_EPS = 1e-6f;
__device__ __forceinline__ f32x2 gelu_pk(f32x2 v) {
    const f32x2 av = __builtin_elementwise_abs(v), d = av * 0.2316418882f + 1.0f;
    f32x2 t; t.x = __builtin_amdgcn_rcpf(d.x); t.y = __builtin_amdgcn_rcpf(d.y);
    f32x2 q = t * 0.5307027145f + (-0.7265760135f); q = q * t + 0.7107068705f; q = q * t + (-0.142248368f); q = q * t + 0.127414796f; q = q * t;
    const f32x2 s = (v * v) * (-0.72134752044f);
    f32x2 e; e.x = __builtin_amdgcn_exp2f(s.x); e.y = __builtin_amdgcn_exp2f(s.y);
    const f32x2 m = v * (q * e), r = v - m;
    f32x2 o; o.x = v.x < 0.f ? m.x : r.x; o.y = v.y < 0.f ? m.y : r.y; return o;
}

struct EpiProjA {
    static constexpr bool PERM = true, AFTER_DRAIN = false;
    bf16_t* ATT; bf16_t* DNQ; bf16_t* Z; float* SMALL; const float* rstd; const float* ropeC; const float* ropeS; int smask;
    __device__ __forceinline__ void operator()(const f32x4 (&acc)[2][2][4][2], const Unit& u, int wr, int wc, int fr, int fq) const {
        const int row0 = u.pm * BM + wr * 64 + fr; const int pn = u.pn;
        bf16_t* base; int ldc, colt;
        if (pn < 18) { base = ATT; ldc = 4608; colt = pn * 256; } else if (pn < 30) { base = DNQ; ldc = 3072; colt = (pn - 18) * 256; } else { base = Z; ldc = 1024; colt = (pn - 30) * 256; }
        const int col0 = colt + wc * 32 + 8 * fq;
        const bool do_rope = (pn < 12) && ((wc & 1) == 0);
        const float qs = (pn < 6) ? 0.18033688011112042f : 1.0f;
#pragma unroll
        for (int ai = 0; ai < 2; ++ai)
#pragma unroll
            for (int m = 0; m < 4; ++m) { const int r = row0 + ai * HALF + m * 16; const float rs = rstd[r];
                f32x4 c0 = {1.f, 1.f, 1.f, 1.f}, c1 = c0, s0 = {0.f, 0.f, 0.f, 0.f}, s1 = s0;
                if (do_rope) { const int pos = r & smask; c0 = *(const f32x4*)(ropeC + pos * 8); c1 = *(const f32x4*)(ropeC + pos * 8 + 4); s0 = *(const f32x4*)(ropeS + pos * 8); s1 = *(const f32x4*)(ropeS + pos * 8 + 4);
                    if (fq == 0) { s0 = -s0; s1 = -s1; } if (fq >= 2) { c0 = (f32x4){1.f, 1.f, 1.f, 1.f}; c1 = c0; s0 = (f32x4){0.f, 0.f, 0.f, 0.f}; s1 = s0; } }
#pragma unroll
                for (int bj = 0; bj < 2; ++bj) { f32x4 v0 = acc[ai][bj][m][0] * rs, v1 = acc[ai][bj][m][1] * rs;
                    if (do_rope) { f32x4 p0, p1;
#pragma unroll
                        for (int e = 0; e < 4; ++e) { p0[e] = __shfl_xor(v0[e], 16); p1[e] = __shfl_xor(v1[e], 16); }
                        v0 = v0 * c0 + p0 * s0; v1 = v1 * c1 + p1 * s1; }
                    v0 = v0 * qs; v1 = v1 * qs;
                    if (pn < 34) { u32x4 w; w.x = cvt_pk_bf16(v0[0], v0[1]); w.y = cvt_pk_bf16(v0[2], v0[3]); w.z = cvt_pk_bf16(v1[0], v1[1]); w.w = cvt_pk_bf16(v1[2], v1[3]);
                        *(u32x4*)(base + (size_t)r * ldc + col0 + bj * HALF) = w; }
                    else if (bj == 0 && wc == 0) { float* sp = SMALL + (size_t)r * 32 + 8 * fq; *(f32x4*)sp = v0; *(f32x4*)(sp + 4) = v1; } } }
    }
};
struct EpiGates {
    static constexpr bool PERM = true, AFTER_DRAIN = false;
    bf16_t* G; const float* rstd;
    __device__ __forceinline__ void operator()(const f32x4 (&acc)[2][2][4][2], const Unit& u, int wr, int wc, int fr, int fq) const {
        const int row0 = u.pm * BM + wr * 64 + fr; const int col0 = u.pn * BM + wc * 32 + 8 * fq;
#pragma unroll
        for (int ai = 0; ai < 2; ++ai)
#pragma unroll
            for (int m = 0; m < 4; ++m) { const int r = row0 + ai * HALF + m * 16; const float rs = rstd[r];
#pragma unroll
                for (int bj = 0; bj < 2; ++bj) { const f32x4 v0 = acc[ai][bj][m][0] * rs, v1 = acc[ai][bj][m][1] * rs;
                    u32x4 w; w.x = cvt_pk_bf16(sigmoidf_(v0[0]), sigmoidf_(v0[1])); w.y = cvt_pk_bf16(sigmoidf_(v0[2]), sigmoidf_(v0[3])); w.z = cvt_pk_bf16(sigmoidf_(v1[0]), sigmoidf_(v1[1])); w.w = cvt_pk_bf16(sigmoidf_(v1[2]), sigmoidf_(v1[3]));
                    *(u32x4*)(G + (size_t)r * 2048 + col0 + bj * HALF) = w; } }
    }
};
struct EpiF32 {
    static constexpr bool PERM = false, AFTER_DRAIN = false;
    float* C; int ldc;
    __device__ __forceinline__ void operator()(const f32x4 (&acc)[2][2][4][2], const Unit& u, int wr, int wc, int fr, int fq) const {
        const int row0 = u.pm * BM + wr * 64 + fr, col0 = u.pn * BM + wc * 32 + 4 * fq;
#pragma unroll
        for (int ai = 0; ai < 2; ++ai)
#pragma unroll
            for (int m = 0; m < 4; ++m) { float* rowp = C + (size_t)(row0 + ai * HALF + m * 16) * ldc + col0;
#pragma unroll
                for (int bj = 0; bj < 2; ++bj)
#pragma unroll
                    for (int n = 0; n < 2; ++n) *(f32x4*)(rowp + bj * HALF + n * 16) = acc[ai][bj][m][n]; }
    }
};
struct EpiMix {
    static constexpr bool PERM = true, AFTER_DRAIN = false;
    const bf16_t* G; const float* YA; bf16_t* MIX;
    __device__ __forceinline__ void operator()(const f32x4 (&acc)[2][2][4][2], const Unit& u, int wr, int wc, int fr, int fq) const {
        const int row0 = u.pm * BM + wr * 64 + fr; const int col0 = u.pn * BM + wc * 32 + 8 * fq;
#pragma unroll
        for (int ai = 0; ai < 2; ++ai)
#pragma unroll
            for (int m = 0; m < 4; ++m) { const int r = row0 + ai * HALF + m * 16;
#pragma unroll
                for (int bj = 0; bj < 2; ++bj) { const int c = col0 + bj * HALF;
                    const u32x4 ga = *(const u32x4*)(G + (size_t)r * 2048 + c), gb = *(const u32x4*)(G + (size_t)r * 2048 + 1024 + c);
                    const f32x4 y0 = *(const f32x4*)(YA + (size_t)r * 1024 + c), y1 = *(const f32x4*)(YA + (size_t)r * 1024 + c + 4);
                    const f32x4 a0 = acc[ai][bj][m][0], a1 = acc[ai][bj][m][1];
                    u32x4 w;
                    w.x = cvt_pk_bf16(bflo(ga.x) * y0[0] + bflo(gb.x) * a0[0], bfhi(ga.x) * y0[1] + bfhi(gb.x) * a0[1]);
                    w.y = cvt_pk_bf16(bflo(ga.y) * y0[2] + bflo(gb.y) * a0[2], bfhi(ga.y) * y0[3] + bfhi(gb.y) * a0[3]);
                    w.z = cvt_pk_bf16(bflo(ga.z) * y1[0] + bflo(gb.z) * a1[0], bfhi(ga.z) * y1[1] + bfhi(gb.z) * a1[1]);
                    w.w = cvt_pk_bf16(bflo(ga.w) * y1[2] + bflo(gb.w) * a1[2], bfhi(ga.w) * y1[3] + bfhi(gb.w) * a1[3]);
                    *(u32x4*)(MIX + (size_t)r * 1024 + c) = w; } }
    }
};
struct EpiRes {
    static constexpr bool PERM = false, AFTER_DRAIN = false;
    const float* RES; float* OUT; bf16_t* XB; float* ssq;
    __device__ __forceinline__ void operator()(const f32x4 (&acc)[2][2][4][2], const Unit& u, int wr, int wc, int fr, int fq) const {
        const int row0 = u.pm * BM + wr * 64 + fr, col0 = u.pn * BM + wc * 32 + 4 * fq;
#pragma unroll
        for (int ai = 0; ai < 2; ++ai)
#pragma unroll
            for (int m = 0; m < 4; ++m) { const int r = row0 + ai * HALF + m * 16; const size_t off = (size_t)r * 1024 + col0; float s = 0.f;
#pragma unroll
                for (int bj = 0; bj < 2; ++bj)
#pragma unroll
                    for (int n = 0; n < 2; ++n) { const size_t o2 = off + bj * HALF + n * 16; const f32x4 v = *(const f32x4*)(RES + o2) + acc[ai][bj][m][n];
                        *(f32x4*)(OUT + o2) = v; s += (v[0] * v[0] + v[1] * v[1]) + (v[2] * v[2] + v[3] * v[3]);
                        if (XB) { u32x2 w; w.x = cvt_pk_bf16(v[0], v[1]); w.y = cvt_pk_bf16(v[2], v[3]); *(u32x2*)(XB + o2) = w; } }
                s += __shfl_xor(s, 16); s += __shfl_xor(s, 32);
                if (fq == 0) atomicAdd(ssq + r, s); }
    }
};
struct EpiUp {
    static constexpr bool PERM = true, AFTER_DRAIN = false;
    bf16_t* UP; const float* ssq;
    __device__ __forceinline__ void operator()(const f32x4 (&acc)[2][2][4][2], const Unit& u, int wr, int wc, int fr, int fq) const {
        const int row0 = u.pm * BM + wr * 64 + fr; const int col0 = u.pn * BM + wc * 32 + 8 * fq;
#pragma unroll
        for (int ai = 0; ai < 2; ++ai)
#pragma unroll
            for (int m = 0; m < 4; ++m) { const int r = row0 + ai * HALF + m * 16; const float rs = rsqrtf(ssq[r] * (1.0f / 1024.0f) + RMS_EPS);
#pragma unroll
                for (int bj = 0; bj < 2; ++bj) { const f32x4 v0 = acc[ai][bj][m][0] * rs, v1 = acc[ai][bj][m][1] * rs;
                    u32x4 w; w.x = cvt_pk_bf16(v0[0], v0[1]); w.y = cvt_pk_bf16(v0[2], v0[3]); w.z = cvt_pk_bf16(v1[0], v1[1]); w.w = cvt_pk_bf16(v1[2], v1[3]);
                    *(u32x4*)(UP + (size_t)r * 5632 + col0 + bj * HALF) = w; } }
    }
};
template <class Epi, class Sched, bool ALIGN_EPI = false, bool SP2 = false>
__device__ __forceinline__ void gemm_phase(PG8_LAS unsigned char* lds, const Gemm g, const Sched& S, const Epi& E, int tid_) {
    asm volatile("" : "+v"(tid_)); const int tid = tid_, wid = __builtin_amdgcn_readfirstlane(tid >> 6), lane = tid & 63, wr = wid >> 2, wc = wid & 3, fr = lane & 15, fq = lane >> 4;
    const int K = g.K, nt = K / BK;
    unsigned voffA[2], voffB[2];
#pragma unroll
    for (int i = 0; i < 2; ++i) { int R, C; stage_rc(tid * 16 + i * 8192, R, C); const int Rb = Epi::PERM ? ((R & ~31) + perm32(R & 31)) : R;
        voffA[i] = (unsigned)(R * K + C) * 2u; voffB[i] = (unsigned)(Rb * K + C) * 2u; }
    const size_t kstep = (size_t)(BK * 2);
    const size_t hstep = (size_t)HALF * K * 2;
    const size_t tstep = 2 * hstep;
    const unsigned ldsw = (unsigned)wid * 1024u;
    const int aoff = lds_byte(wr * 64 + fr, fq * 8), boff = lds_byte(wc * 32 + fr, fq * 8);
#define PG8_SA(b, h) (((b) * 2 + (h)) * HTB)
#define PG8_SB(b, h) ((4 + (b) * 2 + (h)) * HTB)
#define PG8_STAGE(bufoff, gbase, voff) do { _Pragma("unroll") for (int _i = 0; _i < 2; ++_i) \
        __builtin_amdgcn_global_load_lds((const unsigned*)((const char*)(gbase) + (voff)[_i]), (PG8_LAS unsigned*)(lds + (bufoff) + ldsw + _i * 8192), 16, 0, 0); } while (0)
#define PG8_LDA(dst, b, h) do { _Pragma("unroll") for (int m = 0; m < 4; ++m) _Pragma("unroll") for (int k = 0; k < 2; ++k) dst[m][k] = *(const PG8_LAS bf16x8*)(lds + PG8_SA(b, h) + aoff + m * 2048 + k * 1024); } while (0)
#define PG8_LDB(dst, b, h) do { _Pragma("unroll") for (int n = 0; n < 2; ++n) _Pragma("unroll") for (int k = 0; k < 2; ++k) dst[n][k] = *(const PG8_LAS bf16x8*)(lds + PG8_SB(b, h) + boff + n * 2048 + k * 1024); } while (0)
#define PG8_MMA(ai, bj, At, Bt) do { __builtin_amdgcn_s_setprio(1); _Pragma("unroll") for (int m = 0; m < 4; ++m) _Pragma("unroll") for (int n = 0; n < 2; ++n) _Pragma("unroll") for (int k = 0; k < 2; ++k) \
        acc[ai][bj][m][n] = __builtin_amdgcn_mfma_f32_16x16x32_bf16(Bt[n][k], At[m][k], acc[ai][bj][m][n], 0, 0, 0); __builtin_amdgcn_s_setprio(0); } while (0)
#define PG8_WAIT_V(n) asm volatile("s_waitcnt vmcnt(" #n ")" ::: "memory")
#define PG8_WAIT_L(n) asm volatile("s_waitcnt lgkmcnt(" #n ")" ::: "memory")
#define PG8_BAR __builtin_amdgcn_s_barrier()
#define PG8_SCHED __builtin_amdgcn_sched_barrier(0)
    Unit cur, nxt; int ui = 0;
    if (!S.next(0, cur)) return;
    f32x4 acc[2][2][4][2];
    f32x4 zz_ = (f32x4){0.f, 0.f, 0.f, 0.f}; asm volatile("" : "+v"(zz_));
#pragma unroll
    for (int a = 0; a < 2; ++a)
#pragma unroll
        for (int b = 0; b < 2; ++b)
#pragma unroll
            for (int m = 0; m < 4; ++m)
#pragma unroll
                for (int n = 0; n < 2; ++n) acc[a][b][m][n] = zz_;
    bf16x8 At[4][2], B0[2][2], B1[2][2];
    const char* cA = (const char*)g.A + (size_t)cur.pm * tstep; const char* cB = (const char*)g.Bt + (size_t)cur.pn * tstep;
    S.a_ready(cur);
    if constexpr (SP2) {
        PG8_STAGE(PG8_SB(0, 0), cB, voffB); PG8_STAGE(PG8_SB(0, 1), cB + hstep, voffB); PG8_STAGE(PG8_SA(0, 0), cA, voffA); PG8_STAGE(PG8_SA(0, 1), cA + hstep, voffA);
        if (wr == 1) PG8_BAR;
        PG8_WAIT_V(2); PG8_BAR;
        PG8_STAGE(PG8_SB(1, 0), cB + kstep, voffB); PG8_STAGE(PG8_SA(1, 0), cA + kstep, voffA); PG8_STAGE(PG8_SB(1, 1), cB + hstep + kstep, voffB);
        PG8_WAIT_V(6); PG8_BAR;
    } else {
        PG8_STAGE(PG8_SB(0, 0), cB, voffB); PG8_STAGE(PG8_SA(0, 0), cA, voffA); PG8_STAGE(PG8_SB(0, 1), cB + hstep, voffB); PG8_STAGE(PG8_SA(0, 1), cA + hstep, voffA);
        if (wr == 1) PG8_BAR;
        PG8_WAIT_V(4); PG8_BAR;
        PG8_STAGE(PG8_SB(1, 0), cB + kstep, voffB); PG8_STAGE(PG8_SA(1, 0), cA + kstep, voffA); PG8_STAGE(PG8_SB(1, 1), cB + hstep + kstep, voffB);
        PG8_WAIT_V(6); PG8_BAR;
    }
    for (;;) {
        const bool has_next = S.next(ui + 1, nxt);
        const char* nA = has_next ? (const char*)g.A + (size_t)nxt.pm * tstep : cA; const char* nB = has_next ? (const char*)g.Bt + (size_t)nxt.pn * tstep : cB;
        for (int t = 0; t < nt; t += 2) {
            const bool last = (t == nt - 2);
            const char* a1 = cA + (size_t)(t + 1) * kstep;
            const char* a2 = last ? nA : cA + (size_t)(t + 2) * kstep; const char* b2 = last ? nB : cB + (size_t)(t + 2) * kstep;
            const char* a3 = a2 + kstep; const char* b3 = b2 + kstep;
            if (last && has_next) S.a_ready(nxt);
            if constexpr (SP2) {
            PG8_LDB(B0, 0, 0); PG8_LDB(B1, 0, 1); PG8_SCHED; PG8_LDA(At, 0, 0); PG8_STAGE(PG8_SA(1, 1), a1 + hstep, voffA);
            PG8_WAIT_V(8); PG8_WAIT_L(0); PG8_BAR; PG8_MMA(0, 0, At, B0); PG8_MMA(0, 1, At, B1); PG8_BAR; PG8_SCHED;
            PG8_LDA(At, 0, 1); PG8_STAGE(PG8_SB(0, 0), b2, voffB); PG8_STAGE(PG8_SB(0, 1), b2 + hstep, voffB); PG8_STAGE(PG8_SA(0, 0), a2, voffA);
            PG8_WAIT_V(8); PG8_WAIT_L(0); PG8_BAR; PG8_MMA(1, 0, At, B0); PG8_MMA(1, 1, At, B1); PG8_BAR; PG8_SCHED;
            PG8_LDB(B0, 1, 0); PG8_LDB(B1, 1, 1); PG8_SCHED; PG8_LDA(At, 1, 0); PG8_STAGE(PG8_SA(0, 1), a2 + hstep, voffA);
            PG8_WAIT_V(8); PG8_WAIT_L(0); PG8_BAR; PG8_MMA(0, 0, At, B0); PG8_MMA(0, 1, At, B1); PG8_BAR; PG8_SCHED;
            PG8_LDA(At, 1, 1); PG8_STAGE(PG8_SB(1, 0), b3, voffB); PG8_STAGE(PG8_SB(1, 1), b3 + hstep, voffB); PG8_STAGE(PG8_SA(1, 0), a3, voffA);
            PG8_WAIT_V(8); PG8_WAIT_L(0); PG8_BAR; PG8_MMA(1, 0, At, B0); PG8_MMA(1, 1, At, B1); PG8_BAR; PG8_SCHED;
            } else {
            PG8_LDB(B0, 0, 0); PG8_SCHED; PG8_LDA(At, 0, 0); PG8_STAGE(PG8_SA(1, 1), a1 + hstep, voffA);
            PG8_WAIT_L(8); PG8_BAR; PG8_WAIT_L(0); PG8_MMA(0, 0, At, B0); PG8_BAR; PG8_SCHED;
            PG8_LDB(B1, 0, 1); PG8_STAGE(PG8_SB(0, 0), b2, voffB);
            PG8_BAR; PG8_WAIT_L(0); PG8_MMA(0, 1, At, B1); PG8_BAR;
            PG8_LDA(At, 0, 1); PG8_STAGE(PG8_SA(0, 0), a2, voffA);
            PG8_BAR; PG8_WAIT_L(0); PG8_MMA(1, 0, At, B0); PG8_BAR; PG8_SCHED;
            PG8_STAGE(PG8_SB(0, 1), b2 + hstep, voffB);
            PG8_WAIT_V(6); PG8_BAR; PG8_MMA(1, 1, At, B1); PG8_BAR;
            PG8_LDB(B0, 1, 0); PG8_SCHED; PG8_LDA(At, 1, 0); PG8_STAGE(PG8_SA(0, 1), a2 + hstep, voffA);
            PG8_WAIT_L(8); PG8_BAR; PG8_WAIT_L(0); PG8_MMA(0, 0, At, B0); PG8_BAR; PG8_SCHED;
            PG8_LDB(B1, 1, 1); PG8_STAGE(PG8_SB(1, 0), b3, voffB);
            PG8_BAR; PG8_WAIT_L(0); PG8_MMA(0, 1, At, B1); PG8_BAR;
            PG8_LDA(At, 1, 1); PG8_STAGE(PG8_SA(1, 0), a3, voffA);
            PG8_BAR; PG8_WAIT_L(0); PG8_MMA(1, 0, At, B0); PG8_BAR; PG8_SCHED;
            PG8_STAGE(PG8_SB(1, 1), b3 + hstep, voffB);
            PG8_WAIT_V(6); PG8_BAR; PG8_MMA(1, 1, At, B1); PG8_BAR;
            }
        }
        if constexpr (ALIGN_EPI) { if (wr == 0) PG8_BAR; }
        if constexpr (!Epi::AFTER_DRAIN) { E(acc, cur, wr, wc, fr, fq); S.done(cur); }
        if (!has_next) break;
        zz_ = (f32x4){0.f, 0.f, 0.f, 0.f}; asm volatile("" : "+v"(zz_));
#pragma unroll
        for (int a = 0; a < 2; ++a)
#pragma unroll
            for (int b = 0; b < 2; ++b)
#pragma unroll
                for (int m = 0; m < 4; ++m)
#pragma unroll
                    for (int n = 0; n < 2; ++n) acc[a][b][m][n] = zz_;
        cur = nxt; cA = nA; cB = nB; ++ui;
        if constexpr (ALIGN_EPI) { if (wr == 1) PG8_BAR; }
    }
    PG8_WAIT_V(0);
    if constexpr (!ALIGN_EPI) { if (wr == 0) PG8_BAR; }
    PG8_BAR;
    if constexpr (Epi::AFTER_DRAIN) { E.fused(acc, cur, wr, wc, fr, fq, lds, wid, lane); S.done(cur); }
#undef PG8_SA
#undef PG8_SB
#undef PG8_STAGE
#undef PG8_LDA
#undef PG8_LDB
#undef PG8_MMA
#undef PG8_WAIT_V
#undef PG8_WAIT_L
#undef PG8_BAR
#undef PG8_SCHED
}
}

#define LAS __attribute__((address_space(3)))
typedef unsigned short bf16;
typedef float f32x4 __attribute__((ext_vector_type(4)));
typedef unsigned v4u __attribute__((ext_vector_type(4)));
typedef unsigned v2u __attribute__((ext_vector_type(2)));
using pg8::cvt_pk_bf16; using pg8::bflo; using pg8::bfhi;

constexpr int NWAVES = 8, NTHREADS = 512;
constexpr int D = 1024, NTOK = 49152, TG = 16384, NGROUPS = 3;
constexpr int ATTW = 4608, DNW = 3072, NPA = 8960  , NIN_T = 11008, DFF = 2816, NUP = 5632;
constexpr float EPS = 1e-6f;

constexpr size_t MiB = 1u << 20;
constexpr size_t WS_CTL = 0, CTL_BYTES = 1 * MiB;
constexpr size_t CTL_SSQ2 = 256 * 1024, CTL_SSQ3 = 512 * 1024;
constexpr size_t WS_WIN = 1 * MiB, WS_WUP = 23 * MiB, WS_WDOWN = 34 * MiB, WS_WOUT = 40 * MiB, WS_WA = 42 * MiB, WS_WB = 43 * MiB;
constexpr size_t WS_ROPE = 45 * MiB, WS_RSTD1 = 46 * MiB, WS_XB = 48 * MiB  , WS_ARENA = 80 * MiB, WS_END = 512 * MiB;
constexpr size_t AR_ATT = 0, AR_DNQ = 144 * MiB, AR_Z = 240 * MiB, AR_SMALL = 272 * MiB, AR_AO = 274 * MiB, AR_PO = 290 * MiB, AR_LSE = 338 * MiB, AR_MIX = 290 * MiB;
constexpr size_t AR_FRAG = 0, AR_VACC = 96 * MiB, AR_TI = 340 * MiB, AR_VEC = 404 * MiB;
constexpr size_t AR_OF = 144 * MiB, AR_OB = 176 * MiB, AR_DNOUT = 208 * MiB;
constexpr size_t AR_G = 0, AR_YA = 64 * MiB;
constexpr size_t AR_UP = 0, AR_ACT = 176 * MiB;
static_assert(WS_ARENA + AR_VEC + 8 * MiB <= WS_END, "ws map");

struct Args { const float* in[19]; float* out; unsigned char* ws; int lo, hi; };

__device__ __forceinline__ float wave_sum(float v) {
#pragma unroll
    for (int o = 1; o < 64; o <<= 1) v += __shfl_xor(v, o);
    return v;
}
__device__ __forceinline__ float bf2f(bf16 u) { return __uint_as_float((unsigned)u << 16); }
__device__ __forceinline__ float siluf_(float x) { return x / (1.0f + __expf(-x)); }

__device__ __forceinline__ void p0_transpose_item(const float* W, int ldw, int col_off, int K, int ncols, const float* gain, bf16* WT, int row_off, LAS float* scr, int item, int lane) {
    const int nblk = ncols / 32, kb = item / nblk, nb = item % nblk, k0 = 64 * kb, n0 = 32 * nb;
#pragma unroll 8
    for (int i = 0; i < 32; ++i) { const int kk = 2 * i + (lane >> 5); float w = W[(size_t)(k0 + kk) * ldw + col_off + n0 + (lane & 31)]; if (gain) w *= gain[k0 + kk]; scr[kk * 33 + (lane & 31)] = w; }
    asm volatile("s_waitcnt lgkmcnt(0)" ::: "memory");
    const int c = lane & 7;
#pragma unroll
    for (int j = 0; j < 4; ++j) { const int n = (lane >> 3) + 8 * j; const LAS float* s = scr + (8 * c) * 33 + n;
        v4u o; o.x = cvt_pk_bf16(s[0 * 33], s[1 * 33]); o.y = cvt_pk_bf16(s[2 * 33], s[3 * 33]); o.z = cvt_pk_bf16(s[4 * 33], s[5 * 33]); o.w = cvt_pk_bf16(s[6 * 33], s[7 * 33]);
        *(v4u*)(WT + (size_t)(row_off + n0 + n) * K + k0 + 8 * c) = o; }
    asm volatile("s_waitcnt lgkmcnt(0)" ::: "memory");
}

struct Ptrs {
    const float *x_p, *x_s, *norm_mix_g, *w_in, *conv_w, *a_log_f, *a_log_b, *dt_f, *dt_b, *out_norm_g, *w_a, *w_b, *w_out, *norm_ffn_g, *w_up, *ffn_conv_w, *ffn_conv_b, *w_down, *norm_final_g;
    float* out; unsigned char* ws;
};
__device__ __forceinline__ const float* x_row(const Ptrs& P, int tok) { return tok < 32768 ? P.x_p + (size_t)tok * D : P.x_s + (size_t)(tok - 32768) * D; }

__device__ __forceinline__ void phase_xb(const Ptrs& P, int g, int gw, int NGW, int lane) {
    bf16* XB = (bf16*)(P.ws + WS_XB); float* rstd1 = (float*)(P.ws + WS_RSTD1);
    for (int m = gw; m < TG; m += NGW) {
        const f32x4* xr = (const f32x4*)x_row(P, g * TG + m) + lane; f32x4 v[4]; float s = 0.f;
#pragma unroll
        for (int j = 0; j < 4; ++j) { v[j] = xr[64 * j]; s += (v[j].x * v[j].x + v[j].y * v[j].y) + (v[j].z * v[j].z + v[j].w * v[j].w); }
        s = wave_sum(s);
        if (lane == 0) rstd1[g * TG + m] = rsqrtf(s * (1.0f / 1024.0f) + EPS);
        unsigned long long* o8 = (unsigned long long*)(XB + (size_t)m * D) + lane;
#pragma unroll
        for (int j = 0; j < 4; ++j) o8[64 * j] = (unsigned long long)cvt_pk_bf16(v[j].x, v[j].y) | ((unsigned long long)cvt_pk_bf16(v[j].z, v[j].w) << 32);
    }
}
__device__ __forceinline__ void phase_prologue(const Ptrs& P, unsigned char* lds, int bid, int G, int tid) {
    const int lane = tid & 63, wave = tid >> 6;
    LAS float* scr = (LAS float*)((LAS unsigned char*)lds + wave * 16384);
    const int gw = bid * NWAVES + wave, NGW = G * NWAVES;
    bf16* Win = (bf16*)(P.ws + WS_WIN); bf16* Wup = (bf16*)(P.ws + WS_WUP); bf16* Wdn = (bf16*)(P.ws + WS_WDOWN); bf16* Wout = (bf16*)(P.ws + WS_WOUT); bf16* Wa = (bf16*)(P.ws + WS_WA); bf16* Wb = (bf16*)(P.ws + WS_WB);
    constexpr int I1 = 16 * 273, I2 = 16 * 64, I3 = 8 * 32, I4 = 16 * 32, I5 = 16 * 32, I6 = 16 * 176, I7 = 44 * 32;
    constexpr int NIT = I1 + I2 + I3 + I4 + I5 + I6 + I7;
    for (int it = gw; it < NIT; it += NGW) {
        int r = it;
        if (r < I1) { p0_transpose_item(P.w_in, 10784, 0, 1024, 8736, P.norm_mix_g, Win, 0, scr, r, lane); continue; } r -= I1;
        if (r < I2) { p0_transpose_item(P.w_in, 10784, 8736, 1024, 2048, P.norm_mix_g, Win, 8960, scr, r, lane); continue; } r -= I2;
        if (r < I3) { p0_transpose_item(P.w_a, 1024, 0, 512, 1024, nullptr, Wa, 0, scr, r, lane); continue; } r -= I3;
        if (r < I4) { p0_transpose_item(P.w_b, 1024, 0, 1024, 1024, nullptr, Wb, 0, scr, r, lane); continue; } r -= I4;
        if (r < I5) { p0_transpose_item(P.w_out, 1024, 0, 1024, 1024, nullptr, Wout, 0, scr, r, lane); continue; } r -= I5;
        if (r < I6) { p0_transpose_item(P.w_up, 5632, 0, 1024, 5632, P.norm_ffn_g, Wup, 0, scr, r, lane); continue; } r -= I6;
        p0_transpose_item(P.w_down, 1024, 0, 2816, 1024, nullptr, Wdn, 0, scr, r, lane);
    }
    const int gt = bid * NTHREADS + tid, NGT = G * NTHREADS;
    for (int i = gt; i < 28672; i += NGT) ((v4u*)(Win + (size_t)8736 * 1024))[i] = (v4u){0u, 0u, 0u, 0u};
    float* ropeC = (float*)(P.ws + WS_ROPE); float* ropeS = ropeC + 4096 * 8;
    for (int i = gt; i < 4096 * 8; i += NGT) { const int pos = i >> 3, j = i & 7;
        const float invt[8] = {1.0f, 0.19392274f, 0.03760603f, 0.0072926646f, 0.0014142136f, 0.0002742482f, 5.3182957e-05f, 1.0313385e-05f};
        const float inv = invt[j]; const float ang = (float)pos * inv;
        const float c_hi = 0.15915494f, c_lo = 6.4206382e-09f;
        const float kq = rintf(ang * c_hi); float r = fmaf(ang, c_hi, -kq); r = fmaf(ang, c_lo, r);
        ropeC[i] = __builtin_amdgcn_cosf(r); ropeS[i] = __builtin_amdgcn_sinf(r); }
    phase_xb(P, 0, gw, NGW, lane);
}

__device__ __forceinline__ void load8bf(const bf16* p, float* o) { const v4u w = *(const v4u*)p; o[0] = bflo(w.x); o[1] = bfhi(w.x); o[2] = bflo(w.y); o[3] = bfhi(w.y); o[4] = bflo(w.z); o[5] = bfhi(w.z); o[6] = bflo(w.w); o[7] = bfhi(w.w); }
typedef short bf16x8_t __attribute__((ext_vector_type(8)));
typedef float f32x16 __attribute__((ext_vector_type(16)));
typedef short s16x4_t __attribute__((ext_vector_type(4)));
__device__ __forceinline__ void phase_attn(const bf16* ATT, bf16* PO, float* LSE, int S, unsigned char* lds_, int bid, int G, int tid) {
    LAS unsigned char* lds = (LAS unsigned char*)lds_;
    const int lane = tid & 63, w = __builtin_amdgcn_readfirstlane(tid >> 6), ql = lane & 31, h2 = lane >> 5;
    const int NU = S >> 8, nunits = (TG / S) * 24 * NU;
    constexpr int KOFF = 0, VOFF = 49152;
    for (int u = bid; u < nunits; u += G) {
        const int idx = u % NU, bh = u / NU, h = bh % 24, b = bh / 24; const int gi = h >> 3, dil = (gi == 0) ? 1 : (gi == 1) ? 4 : 16, L = S / dil;
        const int seq0 = b * S;
        const bool two = (L < 256);
        const int r0 = two ? 2 * idx : idx % dil, p0 = two ? 0 : (idx / dil) * 256, sbase = two ? 0 : p0 - 64, nrows = two ? 256 : 384;
        { const int ri = lane >> 3, c = lane & 7;
          for (int pc = w; pc < nrows / 8; pc += NWAVES) { const int row = pc * 8 + ri; int cls, pos;
              if (two) { cls = r0 + (row >> 7); pos = row & 127; } else { cls = r0; pos = sbase + row; pos = pos < 0 ? 0 : (pos >= L ? L - 1 : pos); }
              const bf16* src = ATT + (size_t)(seq0 + cls + dil * pos) * ATTW + h * 64;
              __builtin_amdgcn_global_load_lds((const unsigned*)(src + 1536 + ((c ^ ri) << 3)), (LAS unsigned*)(lds + KOFF + pc * 1024), 16, 0, 0);
              __builtin_amdgcn_global_load_lds((const unsigned*)(src + 3072 + ((c ^ (((ri >> 1) & 1) << 2)) << 3)), (LAS unsigned*)(lds + VOFF + pc * 1024), 16, 0, 0); } }
        const int cls = two ? r0 + (w >> 2) : r0; const int qp0 = two ? 32 * (w & 3) : p0 + 32 * w;
        const int tokq = seq0 + cls + dil * (qp0 + ql);
        bf16x8_t qf[4];
#pragma unroll
        for (int s4 = 0; s4 < 4; ++s4) qf[s4] = *(const bf16x8_t*)(ATT + (size_t)tokq * ATTW + h * 64 + 16 * s4 + 8 * h2);
        const int lrow0 = (two ? (w >> 2) * 128 : 0) + qp0 - 64 - sbase;
        __syncthreads();
        f32x16 St[5]; float mx = -1e30f;
#pragma unroll
        for (int t = 0; t < 5; ++t) { const int kp0 = qp0 - 64 + 32 * t; const bool ok = (kp0 >= 0) && (kp0 < L);
            if (ok) { const int R = lrow0 + 32 * t + ql; f32x16 a = {};
#pragma unroll
                for (int s4 = 0; s4 < 4; ++s4) { const bf16x8_t kf = *(const LAS bf16x8_t*)(lds + KOFF + R * 128 + (((2 * s4 + h2) ^ (R & 7)) << 4)); a = __builtin_amdgcn_mfma_f32_32x32x16_bf16(kf, qf[s4], a, 0, 0, 0); }
#pragma unroll
                for (int rg = 0; rg < 16; ++rg) { const int row = (rg & 3) + 8 * (rg >> 2) + 4 * h2; if ((t == 0 && row < ql) || (t == 4 && row > ql)) a[rg] = -1e30f; mx = fmaxf(mx, a[rg]); }
                St[t] = a; }
            else { St[t] = (f32x16){}; } }
        mx = fmaxf(mx, __shfl_xor(mx, 32));
        float lsum = 0.f; f32x16 O0 = {}, O1 = {};
#pragma unroll
        for (int t = 0; t < 5; ++t) { const int kp0 = qp0 - 64 + 32 * t; const bool ok = (kp0 >= 0) && (kp0 < L);
            if (ok) { f32x16 p = St[t];
#pragma unroll
                for (int rg = 0; rg < 16; ++rg) { p[rg] = __builtin_amdgcn_exp2f(p[rg] - mx); lsum += p[rg]; }
#pragma unroll
                for (int s2 = 0; s2 < 2; ++s2) { v4u pk; pk.x = cvt_pk_bf16(p[8 * s2], p[8 * s2 + 1]); pk.y = cvt_pk_bf16(p[8 * s2 + 2], p[8 * s2 + 3]); pk.z = cvt_pk_bf16(p[8 * s2 + 4], p[8 * s2 + 5]); pk.w = cvt_pk_bf16(p[8 * s2 + 6], p[8 * s2 + 7]);
                    const bf16x8_t pb = __builtin_bit_cast(bf16x8_t, pk);
#pragma unroll
                    for (int dt = 0; dt < 2; ++dt) { const int g16 = (lane >> 4) & 1, qq = (lane & 15) >> 2, pp = lane & 3;
                        const int k0 = lrow0 + 32 * t + 16 * s2 + 4 * h2 + qq, k1 = k0 + 8;
                        const int a0 = VOFF + k0 * 128 + (((dt ^ ((k0 >> 1) & 1)) << 6) | (g16 << 5) | (pp << 3)), a1 = VOFF + k1 * 128 + (((dt ^ ((k1 >> 1) & 1)) << 6) | (g16 << 5) | (pp << 3));
                        const s16x4_t lo = __builtin_bit_cast(s16x4_t, __builtin_amdgcn_ds_read_tr16_b64_v4i16((LAS s16x4_t*)(lds + a0))), hi = __builtin_bit_cast(s16x4_t, __builtin_amdgcn_ds_read_tr16_b64_v4i16((LAS s16x4_t*)(lds + a1)));
                        const bf16x8_t vf = (bf16x8_t){lo[0], lo[1], lo[2], lo[3], hi[0], hi[1], hi[2], hi[3]};
                        if (dt == 0) O0 = __builtin_amdgcn_mfma_f32_32x32x16_bf16(vf, pb, O0, 0, 0, 0); else O1 = __builtin_amdgcn_mfma_f32_32x32x16_bf16(vf, pb, O1, 0, 0, 0); } } } }
        lsum += __shfl_xor(lsum, 32);
        const float il = 1.0f / lsum;
        bf16* po = PO + ((size_t)tokq * 24 + h) * 64;
#pragma unroll
        for (int g4 = 0; g4 < 4; ++g4) { v2u w0, w1; w0.x = cvt_pk_bf16(O0[4 * g4] * il, O0[4 * g4 + 1] * il); w0.y = cvt_pk_bf16(O0[4 * g4 + 2] * il, O0[4 * g4 + 3] * il); w1.x = cvt_pk_bf16(O1[4 * g4] * il, O1[4 * g4 + 1] * il); w1.y = cvt_pk_bf16(O1[4 * g4 + 2] * il, O1[4 * g4 + 3] * il);
            *(v2u*)(po + 8 * g4 + 4 * h2) = w0; *(v2u*)(po + 32 + 8 * g4 + 4 * h2) = w1; }
        if (h2 == 0) LSE[(size_t)tokq * 24 + h] = mx + __builtin_amdgcn_logf(lsum);
        __syncthreads();
    }
}
__device__ __forceinline__ void phase_attn_combine(const bf16* PO, const float* LSE, bf16* AO, int gt, int NGT) {
    for (int item = gt; item < TG * 64; item += NGT) { const int tok = item >> 6, hg = (item >> 3) & 7, c = item & 7;
        const float l0 = LSE[(size_t)tok * 24 + hg], l1 = LSE[(size_t)tok * 24 + 8 + hg], l2 = LSE[(size_t)tok * 24 + 16 + hg]; const float m = fmaxf(l0, fmaxf(l1, l2));
        float w0 = __builtin_amdgcn_exp2f(l0 - m), w1 = __builtin_amdgcn_exp2f(l1 - m), w2 = __builtin_amdgcn_exp2f(l2 - m); const float inv = 1.0f / (w0 + w1 + w2); w0 *= inv; w1 *= inv; w2 *= inv;
        float a[8], b8[8], c8[8]; load8bf(PO + ((size_t)tok * 24 + hg) * 64 + c * 8, a); load8bf(PO + ((size_t)tok * 24 + 8 + hg) * 64 + c * 8, b8); load8bf(PO + ((size_t)tok * 24 + 16 + hg) * 64 + c * 8, c8);
#pragma unroll
        for (int e = 0; e < 8; ++e) a[e] = w0 * a[e] + w1 * b8[e] + w2 * c8[e];
        v4u o; o.x = cvt_pk_bf16(a[0], a[1]); o.y = cvt_pk_bf16(a[2], a[3]); o.z = cvt_pk_bf16(a[4], a[5]); o.w = cvt_pk_bf16(a[6], a[7]);
        *(v4u*)(AO + (size_t)tok * 512 + hg * 64 + c * 8) = o; }
}

constexpr int DN_FRAG_U = 49152  , DN_TI_UD = 16384  , DN_VEC_UD = 512  ;
__device__ __forceinline__ int pi_q(int q, int j) { return (j < 4) ? (4 * q + j) : (16 + 4 * q + (j - 4)); }
__device__ __forceinline__ float dpp_xor1(float x) { return __int_as_float(__builtin_amdgcn_mov_dpp(__float_as_int(x), 0xB1, 0xF, 0xF, true)); }
__device__ __forceinline__ float dpp_xor2(float x) { return __int_as_float(__builtin_amdgcn_mov_dpp(__float_as_int(x), 0x4E, 0xF, 0xF, true)); }

__device__ __forceinline__ void phase_dna(const Ptrs& P, const bf16* DNQ, const float* SMALL, unsigned char* FRAG, bf16* VACC, unsigned char* TI, float* VEC, int S, unsigned char* lds_, int bid, int G, int tid) {
    LAS unsigned char* lds = (LAS unsigned char*)lds_;
    const int lane = tid & 63, w = __builtin_amdgcn_readfirstlane(tid >> 6), c16 = lane & 15, q4 = lane >> 4;
    constexpr int RM = 0, FB = 49152, MM = 81920, LP = 0, TM = 81920, GV = 114688;
    LAS bf16* rm = (LAS bf16*)(lds + RM); LAS float* mm = (LAS float*)(lds + MM); LAS float* lp = (LAS float*)(lds + LP); LAS float* tm = (LAS float*)(lds + TM); LAS float* gv = (LAS float*)(lds + GV);
    for (int ui = bid; ui < (TG / 64) * 8; ui += G) {
        const int n = ui >> 3, h = ui & 7; const int tok0 = n * 64, pos0 = tok0 & (S - 1);
        { int cur_part = -1; float w0[5], w1[5];
          for (int it = w * 24; it < w * 24 + 24; ++it) { const int part = it >> 6, t = it & 63; const int ch = part * 1024 + h * 128 + 2 * lane;
              if (part != cur_part) { cur_part = part;
#pragma unroll
                  for (int i = 0; i < 5; ++i) { w0[i] = P.conv_w[i * DNW + ch]; w1[i] = P.conv_w[i * DNW + ch + 1]; } }
              float a0 = 0.f, a1 = 0.f;
#pragma unroll
              for (int i = 0; i < 5; ++i) { const int p2 = pos0 + t + i - 2; if (p2 >= 0 && p2 < S) { const unsigned x = *(const unsigned*)(DNQ + (size_t)(tok0 + t + i - 2) * DNW + ch); a0 += bflo(x) * w0[i]; a1 += bfhi(x) * w1[i]; } }
              a0 = siluf_(a0); a1 = siluf_(a1);
              if (part < 2) { const float ss = wave_sum(a0 * a0 + a1 * a1); float sc = rsqrtf(ss + EPS); if (part == 0) sc *= 0.08838834764831845f; a0 *= sc; a1 *= sc; }
              *(LAS unsigned*)(rm + part * 8192 + t * 128 + 2 * lane) = cvt_pk_bf16(a0, a1); } }
        __syncthreads();
        unsigned char* fr_u = FRAG + (size_t)ui * DN_FRAG_U;
#pragma unroll
        for (int i = 0; i < 4; ++i) { const int fidx = 4 * w + i, isQ = fidx >> 4, ff = fidx & 15, mt = ff >> 2, ks = ff & 3; const int row = 16 * mt + c16;
            const LAS bf16* src = rm + (isQ ? 0 : 8192) + row * 128 + 32 * ks + 4 * q4;
            const v2u lo = *(const LAS v2u*)src, hi = *(const LAS v2u*)(src + 16); const v4u val = {lo.x, lo.y, hi.x, hi.y};
            *(v4u*)(fr_u + (isQ * 16 + ff) * 1024 + lane * 16) = val; *(LAS v4u*)(lds + FB + (isQ * 16 + ff) * 1024 + lane * 16) = val; }
#pragma unroll
        for (int i = 0; i < 2; ++i) { const int f = 2 * w + i, mt8 = f >> 1, ks = f & 1; const int dim = 16 * mt8 + c16; unsigned short e[8];
#pragma unroll
            for (int j = 0; j < 8; ++j) e[j] = rm[8192 + (32 * ks + pi_q(q4, j)) * 128 + dim];
            const v4u val = {(unsigned)e[0] | ((unsigned)e[1] << 16), (unsigned)e[2] | ((unsigned)e[3] << 16), (unsigned)e[4] | ((unsigned)e[5] << 16), (unsigned)e[6] | ((unsigned)e[7] << 16)};
            *(v4u*)(fr_u + (32 + f) * 1024 + lane * 16) = val; }
        { unsigned short e[16];
#pragma unroll
          for (int mt = 0; mt < 4; ++mt)
#pragma unroll
              for (int r = 0; r < 4; ++r) e[mt * 4 + r] = rm[16384 + (16 * mt + 4 * q4 + r) * 128 + 16 * w + c16];
          v4u a = {(unsigned)e[0] | ((unsigned)e[1] << 16), (unsigned)e[2] | ((unsigned)e[3] << 16), (unsigned)e[4] | ((unsigned)e[5] << 16), (unsigned)e[6] | ((unsigned)e[7] << 16)};
          v4u b = {(unsigned)e[8] | ((unsigned)e[9] << 16), (unsigned)e[10] | ((unsigned)e[11] << 16), (unsigned)e[12] | ((unsigned)e[13] << 16), (unsigned)e[14] | ((unsigned)e[15] << 16)};
          v4u* dst = (v4u*)(VACC + (((size_t)ui * 8 + w) * 64 + lane) * 16); dst[0] = a; dst[1] = b; }
        if (w < 2) { const int dir = w; const float* sm = SMALL + (size_t)(tok0 + lane) * 32;
            const float beta = 1.0f / (1.0f + __expf(-sm[dir * 8 + h])); const float al = dir ? P.a_log_b[h] : P.a_log_f[h], db = dir ? P.dt_b[h] : P.dt_f[h];
            const float xx = sm[16 + dir * 8 + h] + db; const float sp = (xx > 20.f) ? xx : __logf(1.0f + __expf(xx)); const float gg = -__expf(al) * sp;
            float gc = gg;
#pragma unroll
            for (int o = 1; o < 64; o <<= 1) { const float tt = dir ? __shfl_down(gc, o) : __shfl_up(gc, o); const bool okk = dir ? (lane + o < 64) : (lane >= o); if (okk) gc += tt; }
            const float glast = __shfl(gc, dir ? 0 : 63);
            gv[dir * 128 + lane] = gc; gv[dir * 128 + 64 + lane] = beta;
            float* vec = VEC + ((size_t)ui * 2 + dir) * DN_VEC_UD; const float eg = __expf(gc);
            vec[lane] = beta; vec[64 + lane] = beta * eg; vec[128 + lane] = eg; vec[192 + lane] = __expf(glast - gc); if (lane == 0) vec[256] = __expf(glast); }
        __syncthreads();
#pragma unroll
        for (int i = 0; i < 4; ++i) { const int t4 = 4 * w + i, isQK = t4 >> 4, tt = t4 & 15, mt = tt >> 2, nt = tt & 3; pg8::f32x4 acc = {0.f, 0.f, 0.f, 0.f};
#pragma unroll
            for (int ks = 0; ks < 4; ++ks) { const bf16x8_t a = *(const LAS bf16x8_t*)(lds + FB + (isQK * 16 + mt * 4 + ks) * 1024 + lane * 16), b = *(const LAS bf16x8_t*)(lds + FB + (nt * 4 + ks) * 1024 + lane * 16);
                acc = __builtin_amdgcn_mfma_f32_16x16x32_bf16(a, b, acc, 0, 0, 0); }
#pragma unroll
            for (int r = 0; r < 4; ++r) mm[isQK * 4096 + (16 * mt + 4 * q4 + r) * 64 + 16 * nt + c16] = acc[r]; }
        __syncthreads();
        unsigned char* ti_u = TI + (size_t)ui * 2 * DN_TI_UD;
#pragma unroll
        for (int k2 = 0; k2 < 2; ++k2) { const int task = tid + 512 * k2, dir = task >> 9, f = (task >> 6) & 7, mt = f >> 1, ks = f & 1; const int i = 16 * mt + c16; const float gci = gv[dir * 128 + i]; float e[8];
#pragma unroll
            for (int j8 = 0; j8 < 8; ++j8) { const int j = 32 * ks + pi_q(q4, j8); const bool incl = dir ? (i <= j) : (i >= j);
#ifdef PROBE_NOMM
 e[j8] = incl ? 0.01f : 0.f; }
#else
 e[j8] = incl ? mm[4096 + i * 64 + j] * __expf(gci - gv[dir * 128 + j]) : 0.f; }
#endif

            const v4u val = {cvt_pk_bf16(e[0], e[1]), cvt_pk_bf16(e[2], e[3]), cvt_pk_bf16(e[4], e[5]), cvt_pk_bf16(e[6], e[7])};
            *(v4u*)(ti_u + dir * DN_TI_UD + (8 + f) * 1024 + lane * 16) = val; }
        f32x4 lpv[4];
#pragma unroll
        for (int k4 = 0; k4 < 4; ++k4) { const int vi = tid + 512 * k4, dir = vi >> 10, ip = (vi >> 4) & 63, p = (vi >> 2) & 3, jj4 = vi & 3; const int i = dir ? 63 - ip : ip; const float gci = gv[dir * 128 + i], bi = gv[dir * 128 + 64 + i];
#pragma unroll
            for (int e = 0; e < 4; ++e) { const int jp = 16 * jj4 + 4 * e + p; const int j = dir ? 63 - jp : jp; lpv[k4][e] = (jp < ip) ? bi * mm[i * 64 + j] * __expf(gci - gv[dir * 128 + j]) : 0.f; } }
        __syncthreads();
#pragma unroll
        for (int k4 = 0; k4 < 4; ++k4) { const int vi = tid + 512 * k4; *(LAS f32x4*)(lp + vi * 4) = lpv[k4]; }
        __syncthreads();
        { const int dir = w >> 2, cc = (w & 3) * 16 + (lane >> 2), p = lane & 3; float t[16];
#pragma unroll
          for (int jj = 0; jj < 16; ++jj) t[jj] = 0.f;
#pragma unroll
          for (int ip = 0; ip < 64; ++ip) { float part = 0.f;
#pragma unroll
              for (int jj4 = 0; jj4 < (ip + 15) / 16; ++jj4) { const f32x4 l4 = *(const LAS f32x4*)(lp + ((dir * 64 + ip) * 4 + p) * 16 + jj4 * 4);
#pragma unroll
                  for (int e = 0; e < 4; ++e) if (16 * jj4 + 4 * e < ip) part += l4[e] * t[4 * jj4 + e]; }
              part += dpp_xor1(part); part += dpp_xor2(part);
              const float val = ((cc == ip) ? 1.0f : 0.0f) - part; if (p == (ip & 3)) t[ip >> 2] = val; }
          __syncthreads();
#pragma unroll
          for (int jj = 0; jj < 16; ++jj) tm[(dir * 64 + 4 * jj + p) * 64 + cc] = t[jj]; }
        __syncthreads();
#pragma unroll
        for (int k2 = 0; k2 < 2; ++k2) { const int task = tid + 512 * k2, dir = task >> 9, f = (task >> 6) & 7, mt = f >> 1, ks = f & 1; const int i = 16 * mt + c16; float e[8];
#pragma unroll
            for (int j8 = 0; j8 < 8; ++j8) { const int j = 32 * ks + pi_q(q4, j8); e[j8] = dir ? tm[(64 + 63 - i) * 64 + 63 - j] : tm[i * 64 + j]; }
            const v4u val = {cvt_pk_bf16(e[0], e[1]), cvt_pk_bf16(e[2], e[3]), cvt_pk_bf16(e[4], e[5]), cvt_pk_bf16(e[6], e[7])};
            *(v4u*)(ti_u + dir * DN_TI_UD + f * 1024 + lane * 16) = val; }
        __syncthreads();
    }
}

__device__ __forceinline__ bf16x8_t pack_acc2(const pg8::f32x4& a, const pg8::f32x4& b) { const v4u v = {cvt_pk_bf16(a[0], a[1]), cvt_pk_bf16(a[2], a[3]), cvt_pk_bf16(b[0], b[1]), cvt_pk_bf16(b[2], b[3])}; return __builtin_bit_cast(bf16x8_t, v); }
__device__ __forceinline__ void phase_scan(const unsigned char* FRAG, const unsigned char* TI, const bf16* VACC, const float* VEC, bf16* OF, bf16* OB, int S, unsigned char* lds_, int bid, int G, int tid) {
    LAS unsigned char* lds = (LAS unsigned char*)lds_;
    const int lane = tid & 63, w = __builtin_amdgcn_readfirstlane(tid >> 6), c16 = lane & 15, q4 = lane >> 4;
    const int NCH = S >> 6, nchain = (TG / S) * 16;
    constexpr int BUFB = 65536;
    for (int chain = bid; chain < nchain; chain += G) {
        const int dir = chain & 1, h = (chain >> 1) & 7, b = chain >> 4;
        bf16* O = dir ? OB : OF;
        pg8::f32x4 Sacc[8];
#pragma unroll
        for (int T8 = 0; T8 < 8; ++T8) Sacc[T8] = (pg8::f32x4){0.f, 0.f, 0.f, 0.f};
#define DN_STAGE(bufoff, nn) do { const size_t ui_ = ((size_t)(b * NCH + (nn)) * 8 + h); \
            for (int pc = w; pc < 64; pc += NWAVES) { const unsigned char* src = (pc < 48) ? FRAG + ui_ * DN_FRAG_U + pc * 1024 : TI + (ui_ * 2 + dir) * DN_TI_UD + (pc - 48) * 1024; \
                __builtin_amdgcn_global_load_lds((const unsigned*)(src + lane * 16), (LAS unsigned*)(lds + (bufoff) + pc * 1024), 16, 0, 0); } } while (0)
        int n = dir ? NCH - 1 : 0;
        DN_STAGE(0, n);
        v4u vcur0, vcur1; { const v4u* vp = (const v4u*)(VACC + ((((size_t)(b * NCH + n) * 8 + h) * 8 + w) * 64 + lane) * 16); vcur0 = vp[0]; vcur1 = vp[1]; }
        __syncthreads();
        int buf = 0;
        for (int step = 0; step < NCH; ++step) {
            const int nn = dir ? n - 1 : n + 1; v4u vn0 = vcur0, vn1 = vcur1;
            if (step + 1 < NCH) { DN_STAGE((buf ^ 1) * BUFB, nn); const v4u* vp = (const v4u*)(VACC + ((((size_t)(b * NCH + nn) * 8 + h) * 8 + w) * 64 + lane) * 16); vn0 = vp[0]; vn1 = vp[1]; }
            const LAS unsigned char* B0 = lds + buf * BUFB; const float* vec = VEC + (((size_t)(b * NCH + n) * 8 + h) * 2 + dir) * DN_VEC_UD;
#define DN_A(off, fi) (*(const LAS bf16x8_t*)(B0 + (off) + (fi) * 1024 + lane * 16))
            bf16x8_t Sb[4];
#pragma unroll
            for (int ks = 0; ks < 4; ++ks) Sb[ks] = pack_acc2(Sacc[2 * ks], Sacc[2 * ks + 1]);
            pg8::f32x4 X1[4], X2[4];
#pragma unroll
            for (int mt = 0; mt < 4; ++mt) { X1[mt] = (pg8::f32x4){0.f, 0.f, 0.f, 0.f}; X2[mt] = X1[mt];
#pragma unroll
                for (int ks = 0; ks < 4; ++ks) { X1[mt] = __builtin_amdgcn_mfma_f32_16x16x32_bf16(DN_A(0, mt * 4 + ks), Sb[ks], X1[mt], 0, 0, 0); X2[mt] = __builtin_amdgcn_mfma_f32_16x16x32_bf16(DN_A(16384, mt * 4 + ks), Sb[ks], X2[mt], 0, 0, 0); } }
            const unsigned vw[8] = {vcur0.x, vcur0.y, vcur0.z, vcur0.w, vcur1.x, vcur1.y, vcur1.z, vcur1.w};
            pg8::f32x4 Y[4];
#pragma unroll
            for (int mt = 0; mt < 4; ++mt) { const pg8::f32x4 be = *(const pg8::f32x4*)(vec + 16 * mt + 4 * q4), aa = *(const pg8::f32x4*)(vec + 64 + 16 * mt + 4 * q4);
                const pg8::f32x4 vv = {bflo(vw[2 * mt]), bfhi(vw[2 * mt]), bflo(vw[2 * mt + 1]), bfhi(vw[2 * mt + 1])}; Y[mt] = be * vv - aa * X1[mt]; }
            const bf16x8_t Yb0 = pack_acc2(Y[0], Y[1]), Yb1 = pack_acc2(Y[2], Y[3]);
            pg8::f32x4 vn[4];
#pragma unroll
#ifdef PROBE_NOT
            for (int mt = 0; mt < 4; ++mt) vn[mt] = Y[mt];
#else
            for (int mt = 0; mt < 4; ++mt) { vn[mt] = __builtin_amdgcn_mfma_f32_16x16x32_bf16(DN_A(49152, mt * 2), Yb0, (pg8::f32x4){0.f, 0.f, 0.f, 0.f}, 0, 0, 0); vn[mt] = __builtin_amdgcn_mfma_f32_16x16x32_bf16(DN_A(49152, mt * 2 + 1), Yb1, vn[mt], 0, 0, 0); }
#endif
            const bf16x8_t vb0 = pack_acc2(vn[0], vn[1]), vb1 = pack_acc2(vn[2], vn[3]);
            pg8::f32x4 dd[4];
#pragma unroll
            for (int mt = 0; mt < 4; ++mt) { const pg8::f32x4 eg = *(const pg8::f32x4*)(vec + 128 + 16 * mt + 4 * q4); dd[mt] = *(const pg8::f32x4*)(vec + 192 + 16 * mt + 4 * q4);
#ifdef PROBE_NOIT
                pg8::f32x4 o = eg * X2[mt] + vn[mt];
#else
                pg8::f32x4 o = eg * X2[mt]; o = __builtin_amdgcn_mfma_f32_16x16x32_bf16(DN_A(57344, mt * 2), vb0, o, 0, 0, 0); o = __builtin_amdgcn_mfma_f32_16x16x32_bf16(DN_A(57344, mt * 2 + 1), vb1, o, 0, 0, 0);
#endif
                bf16* op = O + ((size_t)(b * S + n * 64 + 16 * mt + 4 * q4)) * 1024 + h * 128 + 16 * w + c16;
#pragma unroll
                for (int r = 0; r < 4; ++r) op[(size_t)r * 1024] = (bf16)(cvt_pk_bf16(o[r], 0.f) & 0xffffu); }
            const bf16x8_t db0 = pack_acc2(dd[0] * vn[0], dd[1] * vn[1]), db1 = pack_acc2(dd[2] * vn[2], dd[3] * vn[3]);
            const float dec = vec[256];
#pragma unroll
            for (int T8 = 0; T8 < 8; ++T8) { pg8::f32x4 a = Sacc[T8] * dec; a = __builtin_amdgcn_mfma_f32_16x16x32_bf16(DN_A(32768, T8 * 2), db0, a, 0, 0, 0); a = __builtin_amdgcn_mfma_f32_16x16x32_bf16(DN_A(32768, T8 * 2 + 1), db1, a, 0, 0, 0); Sacc[T8] = a; }
            __syncthreads();
            buf ^= 1; n = nn; vcur0 = vn0; vcur1 = vn1;
        }
#undef DN_A
#undef DN_STAGE
    }
}

__device__ __forceinline__ void phase_combine(const Ptrs& P, const bf16* OF, const bf16* OB, const bf16* Z, bf16* DNOUT, int gw, int NGW, int lane) {
    for (int item = gw; item < TG * 8; item += NGW) { const size_t off = (size_t)item * 128 + lane * 2;
        const unsigned a = *(const unsigned*)(OF + off), b = *(const unsigned*)(OB + off), z = *(const unsigned*)(Z + off);
#ifdef PROBE_NODN
        const float o0 = 0.5f + 0.f * bflo(z), o1 = 0.25f;
#else
        const float o0 = bflo(a) + bflo(b), o1 = bfhi(a) + bfhi(b);
#endif
        const float ss = wave_sum(o0 * o0 + o1 * o1); const float rs = rsqrtf(ss * (1.0f / 128.0f) + EPS);
        const float y0 = o0 * rs * P.out_norm_g[lane * 2] * siluf_(bflo(z)), y1 = o1 * rs * P.out_norm_g[lane * 2 + 1] * siluf_(bfhi(z));
        *(unsigned*)(DNOUT + off) = cvt_pk_bf16(y0, y1); }
}

__device__ __forceinline__ float gelu_erf(float v) { const pg8::f32x2 r = pg8::gelu_pk((pg8::f32x2){v, v}); return r.x; }
__device__ __forceinline__ void phase_act_naive(const Ptrs& P, const bf16* UP, bf16* ACT, int S, int gt, int NGT) {
    for (int item = gt; item < TG * (DFF / 8); item += NGT) { const int tok = item / (DFF / 8), c = (item % (DFF / 8)) * 8; const int pos = tok % S;
        float a[8], vv[8];
#pragma unroll
        for (int e = 0; e < 8; ++e) a[e] = P.ffn_conv_b[c + e];
#pragma unroll
        for (int i = 0; i < 3; ++i) { const int p2 = pos + i - 1; if (p2 >= 0 && p2 < S) { float g[8]; load8bf(UP + (size_t)(tok + i - 1) * NUP + c, g);
#pragma unroll
                for (int e = 0; e < 8; ++e) a[e] += g[e] * P.ffn_conv_w[i * DFF + c + e]; } }
        load8bf(UP + (size_t)tok * NUP + DFF + c, vv);
#pragma unroll
        for (int e = 0; e < 8; ++e) a[e] = gelu_erf(a[e]) * vv[e];
        v4u w; w.x = cvt_pk_bf16(a[0], a[1]); w.y = cvt_pk_bf16(a[2], a[3]); w.z = cvt_pk_bf16(a[4], a[5]); w.w = cvt_pk_bf16(a[6], a[7]);
        *(v4u*)(ACT + (size_t)tok * DFF + c) = w; }
}

__device__ __forceinline__ void phase_final(const Ptrs& P, const float* ssq3, int gw, int NGW, int lane) {
    for (int m = gw; m < NTOK; m += NGW) { const float rs = rsqrtf(ssq3[m] * (1.0f / 1024.0f) + EPS); f32x4* xr = (f32x4*)(P.out + (size_t)m * D) + lane; const f32x4* gr = (const f32x4*)P.norm_final_g + lane;
#pragma unroll
        for (int j = 0; j < 4; ++j) { f32x4 y = xr[64 * j] * rs * gr[64 * j];
#ifdef PROBE_NANFIX
            for (int e = 0; e < 4; ++e) if (!(fabsf(y[e]) < 1e30f)) y[e] = 0.f;
#endif
            xr[64 * j] = y; } }
}

#define EN(k) (ONLYK < 0 || ONLYK == (k))
constexpr int LDS_BYTES = 147456;
constexpr int STEPS_PER_GROUP = 12, NSTEPS = 1 + NGROUPS * STEPS_PER_GROUP + 1;

#define LDP(i) ((const float*)ap->in[i])
#define MKP() Ptrs P; P.x_p = LDP(0); P.x_s = LDP(1); P.norm_mix_g = LDP(2); P.w_in = LDP(3); P.conv_w = LDP(4); P.a_log_f = LDP(5); P.a_log_b = LDP(6); P.dt_f = LDP(7); P.dt_b = LDP(8); \
        P.out_norm_g = LDP(9); P.w_a = LDP(10); P.w_b = LDP(11); P.w_out = LDP(12); P.norm_ffn_g = LDP(13); P.w_up = LDP(14); P.ffn_conv_w = LDP(15); P.ffn_conv_b = LDP(16); P.w_down = LDP(17); P.norm_final_g = LDP(18); \
        P.out = ap->out; P.ws = ap->ws;
#define WSP ((unsigned char*)ap->ws)
#define ARP (WSP + WS_ARENA)
#define Win ((bf16*)(WSP + WS_WIN))
#define Wup ((bf16*)(WSP + WS_WUP))
#define Wdn ((bf16*)(WSP + WS_WDOWN))
#define Wout ((bf16*)(WSP + WS_WOUT))
#define Wa ((bf16*)(WSP + WS_WA))
#define Wb ((bf16*)(WSP + WS_WB))
#define ropeC ((const float*)(WSP + WS_ROPE))
#define ropeS (ropeC + 4096 * 8)
#define ssq2 ((float*)(WSP + WS_CTL + CTL_SSQ2))
#define ssq3 ((float*)(WSP + WS_CTL + CTL_SSQ3))
#define XBg ((bf16*)(WSP + WS_XB))
#define rstd1 ((const float*)(WSP + WS_RSTD1) + t0)
#define ATT ((bf16*)(ARP + AR_ATT))
#define DNQ ((bf16*)(ARP + AR_DNQ))
#define Z ((bf16*)(ARP + AR_Z))
#define SMALL ((float*)(ARP + AR_SMALL))
#define AO ((bf16*)(ARP + AR_AO))
#define MIX ((bf16*)(ARP + AR_MIX))
#define PO ((bf16*)(ARP + AR_PO))
#define LSE2 ((float*)(ARP + AR_LSE))
#define FRAGP ((unsigned char*)(ARP + AR_FRAG))
#define VACCP ((bf16*)(ARP + AR_VACC))
#define TIP ((unsigned char*)(ARP + AR_TI))
#define VECP ((float*)(ARP + AR_VEC))
#define OF ((bf16*)(ARP + AR_OF))
#define OB ((bf16*)(ARP + AR_OB))
#define DNOUT ((bf16*)(ARP + AR_DNOUT))
#define Gt ((bf16*)(ARP + AR_G))
#define YA ((float*)(ARP + AR_YA))
#define UP ((bf16*)(ARP + AR_UP))
#define ACT ((bf16*)(ARP + AR_ACT))
#define OUTg ((float*)ap->out + (size_t)t0 * D)
#define STEP_PRE() int tid = wave_u * 64 + (int)__builtin_amdgcn_mbcnt_hi(~0u, __builtin_amdgcn_mbcnt_lo(~0u, 0u)), bid = blockIdx.x; typedef const __attribute__((address_space(4))) Args* kargp_t; kargp_t ap = (kargp_t)__builtin_amdgcn_kernarg_segment_ptr(); asm volatile("" : "+v"(tid), "+s"(bid), "+s"(ap)); \
        const int lane = tid & 63, wave = tid >> 6, gw = bid * NWAVES + wave, gt = bid * NTHREADS + tid; (void)lane; (void)wave; (void)gw; (void)gt;
template <int ONLYK, int STEP> __device__ __forceinline__ void run_step(unsigned char* lds, int G, int NGW, int NGT, int wave_u) {
    STEP_PRE();
    constexpr int g = (STEP - 1) / STEPS_PER_GROUP, k = (STEP - 1) % STEPS_PER_GROUP; constexpr int t0 = g * TG; constexpr int S = (g < 2) ? 2048 : 4096;
    if constexpr (STEP == 0) {
        if constexpr (EN(100)) { MKP(); phase_prologue(P, lds, bid, G, tid); }
    } else if constexpr (STEP == NSTEPS - 1) {
        if constexpr (EN(101)) { MKP(); phase_final(P, ssq3, gw, NGW, lane); }
    } else {
            if constexpr (k == 0) {
if constexpr (EN(0)) {
                pg8::Gemm gm{XBg, Win, TG, NPA, D}; pg8::StaticOrder So; So.init(TG, NPA, G, bid); pg8::EpiProjA E{ATT, DNQ, Z, SMALL, rstd1, ropeC, ropeS, S - 1};
                pg8::gemm_phase<pg8::EpiProjA, pg8::StaticOrder, true, true>((LAS unsigned char*)lds, gm, So, E, tid);
}
            } else if constexpr (k == 1) {
if constexpr (EN(1)) {
                phase_attn(ATT, PO, LSE2, S, lds, bid, G, tid);
}
            } else if constexpr (k == 2) {
if constexpr (EN(2)) {
                phase_attn_combine(PO, LSE2, AO, gt, NGT); MKP(); phase_dna(P, DNQ, SMALL, FRAGP, VACCP, TIP, VECP, S, lds, bid, G, tid);
}
            } else if constexpr (k == 3) {
if constexpr (EN(3)) {
                phase_scan(FRAGP, TIP, VACCP, VECP, OF, OB, S, lds, bid, G, tid);
}
            } else if constexpr (k == 4) {
if constexpr (EN(4)) {
                MKP(); phase_combine(P, OF, OB, Z, DNOUT, gw, NGW, lane);
}
            } else if constexpr (k == 5) {
if constexpr (EN(5)) {
                pg8::Gemm gm{XBg, Win + (size_t)NPA * D, TG, 2048, D}; pg8::StaticOrder So; So.init(TG, 2048, G, bid); pg8::EpiGates E{Gt, rstd1};
                pg8::gemm_phase<pg8::EpiGates, pg8::StaticOrder, true, true>((LAS unsigned char*)lds, gm, So, E, tid);
}
            } else if constexpr (k == 6) {
if constexpr (EN(6)) {
                pg8::Gemm gm{AO, Wa, TG, D, 512}; pg8::StaticOrder So; So.init(TG, D, G, bid); pg8::EpiF32 E{YA, D};
                pg8::gemm_phase<pg8::EpiF32, pg8::StaticOrder, true, true>((LAS unsigned char*)lds, gm, So, E, tid);
}
            } else if constexpr (k == 7) {
if constexpr (EN(7)) {
                pg8::Gemm gm{DNOUT, Wb, TG, D, D}; pg8::StaticOrder So; So.init(TG, D, G, bid); pg8::EpiMix E{Gt, YA, MIX};
                pg8::gemm_phase<pg8::EpiMix, pg8::StaticOrder, true, true>((LAS unsigned char*)lds, gm, So, E, tid);
}
            } else if constexpr (k == 8) {
if constexpr (EN(8)) {
                pg8::Gemm gm{MIX, Wout, TG, D, D}; pg8::StaticOrder So; So.init(TG, D, G, bid);
                const float* RES = (g < 2) ? LDP(0) + (size_t)t0 * D : LDP(1); pg8::EpiRes E{RES, OUTg, XBg, ssq2 + t0};
                pg8::gemm_phase<pg8::EpiRes, pg8::StaticOrder, true, true>((LAS unsigned char*)lds, gm, So, E, tid);
}
            } else if constexpr (k == 9) {
if constexpr (EN(9)) {
                pg8::Gemm gm{XBg, Wup, TG, NUP, D}; pg8::StaticOrder So; So.init(TG, NUP, G, bid); pg8::EpiUp E{UP, ssq2 + t0};
                pg8::gemm_phase<pg8::EpiUp, pg8::StaticOrder, true, true>((LAS unsigned char*)lds, gm, So, E, tid);
}
            } else if constexpr (k == 10) {
if constexpr (EN(10)) {
                MKP(); phase_act_naive(P, UP, ACT, S, gt, NGT); if constexpr (g + 1 < NGROUPS) phase_xb(P, g + 1, gw, NGW, lane);
}
            } else {
if constexpr (EN(11)) {
                pg8::Gemm gm{ACT, Wdn, TG, D, DFF}; pg8::StaticOrder So; So.init(TG, D, G, bid); pg8::EpiRes E{OUTg, OUTg, nullptr, ssq3 + t0};
                pg8::gemm_phase<pg8::EpiRes, pg8::StaticOrder, true, true>((LAS unsigned char*)lds, gm, So, E, tid);
}
            }
    }
}
template <int ONLYK, int STEP> __device__ __forceinline__ void run_steps(unsigned char* lds, cg::grid_group& grid, int lo, int hi, int G, int NGW, int NGT, int wave_u) {
    if constexpr (STEP < NSTEPS) {
        if (lo <= STEP && STEP < hi) { run_step<ONLYK, STEP>(lds, G, NGW, NGT, wave_u); if (STEP + 1 < hi) grid.sync(); }
        run_steps<ONLYK, STEP + 1>(lds, grid, lo, hi, G, NGW, NGT, wave_u);
    }
}
template <int ONLYK> __global__ void __launch_bounds__(NTHREADS, 2) fwd(Args args) {
    extern __shared__ __attribute__((aligned(16))) unsigned char lds[];
    const int G = gridDim.x, NGW = G * NWAVES, NGT = G * NTHREADS;
    cg::grid_group grid = cg::this_grid();
    const int wave_u = __builtin_amdgcn_readfirstlane((int)threadIdx.x >> 6);
    run_steps<ONLYK, 0>(lds, grid, args.lo, args.hi, G, NGW, NGT, wave_u);
}

#ifndef ONE_LAUNCH
#define ONE_LAUNCH 1
#endif
#if !ONE_LAUNCH
template <int KK> static void launch_kind(int grid, hipStream_t stream, Args a) { hipLaunchKernelGGL(fwd<KK>, dim3(grid), dim3(NTHREADS), LDS_BYTES, stream, a); }
template <int KK> static bool set_lds() { return hipFuncSetAttribute((const void*)fwd<KK>, hipFuncAttributeMaxDynamicSharedMemorySize, LDS_BYTES) == hipSuccess; }
#endif
extern "C" void kernel_launch(void* const* d_in, const int* in_sizes, int n_in, void* d_out, int out_size, void* d_ws, size_t ws_size, hipStream_t stream) {
    static int grid = 0;
    if (grid == 0) {
        if (n_in != 19 || ws_size < WS_END) { fprintf(stderr, "kernel_launch: unexpected n_in %d / ws_size %zu (need %zu)\n", n_in, ws_size, (size_t)WS_END); grid = -1; return; }
        int dev = 0, cus = 0; (void)hipGetDevice(&dev); (void)hipDeviceGetAttribute(&cus, hipDeviceAttributeMultiprocessorCount, dev);
#if ONE_LAUNCH
        if (hipFuncSetAttribute((const void*)fwd<-1>, hipFuncAttributeMaxDynamicSharedMemorySize, LDS_BYTES) != hipSuccess) { fprintf(stderr, "kernel_launch: hipFuncSetAttribute failed\n"); grid = -1; return; }
        int per_cu = 0;
        if (hipOccupancyMaxActiveBlocksPerMultiprocessor(&per_cu, (const void*)fwd<-1>, NTHREADS, LDS_BYTES) != hipSuccess || per_cu < 1) { fprintf(stderr, "kernel_launch: occupancy query failed / %d blocks per CU\n", per_cu); grid = -1; return; }
        grid = cus;
#else
        bool ok = set_lds<0>() && set_lds<1>() && set_lds<2>() && set_lds<3>() && set_lds<4>() && set_lds<5>() && set_lds<6>() && set_lds<7>() && set_lds<8>() && set_lds<9>() && set_lds<10>() && set_lds<11>() && set_lds<100>() && set_lds<101>();
        if (!ok) { fprintf(stderr, "kernel_launch: hipFuncSetAttribute failed\n"); grid = -1; return; }
        grid = cus > 0 ? cus : 256;
#endif
    }
    if (grid < 0) return;
    (void)hipMemsetAsync((char*)d_ws + WS_CTL, 0, CTL_BYTES, stream);
    Args a{};
    for (int i = 0; i < 19; ++i) a.in[i] = (const float*)d_in[i];
    a.out = (float*)d_out; a.ws = (unsigned char*)d_ws;
#if ONE_LAUNCH
    a.lo = 0; a.hi = NSTEPS; void* kargs[] = {&a};
    hipError_t e = hipLaunchCooperativeKernel((const void*)fwd<-1>, dim3(grid), dim3(NTHREADS), kargs, LDS_BYTES, stream);
    if (e != hipSuccess) fprintf(stderr, "cooperative launch failed: %s (grid %d)\n", hipGetErrorString(e), grid);
#else
    for (int s = 0; s < NSTEPS; ++s) { a.lo = s; a.hi = s + 1;
        if (s == 0) launch_kind<100>(grid, stream, a); else if (s == NSTEPS - 1) launch_kind<101>(grid, stream, a);
        else switch ((s - 1) % STEPS_PER_GROUP) {
            case 0: launch_kind<0>(grid, stream, a); break; case 1: launch_kind<1>(grid, stream, a); break; case 2: launch_kind<2>(grid, stream, a); break; case 3: launch_kind<3>(grid, stream, a); break;
            case 4: launch_kind<4>(grid, stream, a); break; case 5: launch_kind<5>(grid, stream, a); break; case 6: launch_kind<6>(grid, stream, a); break; case 7: launch_kind<7>(grid, stream, a); break;
            case 8: launch_kind<8>(grid, stream, a); break; case 9: launch_kind<9>(grid, stream, a); break; case 10: launch_kind<10>(grid, stream, a); break; default: launch_kind<11>(grid, stream, a); break; }
    }
#endif
}
```

```cpp
#include <hip/hip_runtime.h>
#include <hip/hip_cooperative_groups.h>
#include <cstdio>
#include <cstdint>
namespace cg = cooperative_groups;
namespace pg8 {
#define PG8_LAS __attribute__((address_space(3)))
typedef unsigned short bf16_t;
typedef short bf16x8 __attribute__((ext_vector_type(8)));
typedef float f32x4 __attribute__((ext_vector_type(4)));
typedef unsigned u32x4 __attribute__((ext_vector_type(4)));
constexpr int BM = 256, BK = 64, HALF = 128, HTB = HALF * BK * 2  , STAGE_BYTES = 8 * HTB, NXCD = 8, WGM = 8;

__host__ __device__ __forceinline__ int lds_byte(int r, int c) { const int st = (r >> 4) * 2 + (c >> 5), rr = r & 15, cc = c & 31, ob = rr * 64 + cc * 2; return st * 1024 + (ob ^ (((ob >> 9) & 1) << 5)); }
__host__ __device__ __forceinline__ void stage_rc(int b, int& R, int& C) { const int st = b / 1024, sb = b % 1024, swz = sb ^ (((sb >> 9) & 1) << 5); R = (st >> 1) * 16 + swz / 64; C = (st & 1) * 32 + (swz % 64) / 2; }
__host__ __device__ __forceinline__ int perm32(int rho) { const int n = rho >> 4, i = rho & 15; return 8 * (i >> 2) + 4 * n + (i & 3); }

struct Unit { int pm, pn; };
struct Gemm { const bf16_t* A; const bf16_t* Bt; int M, N, K; };

struct StaticOrder {
    int nM, nN, nwg, G, c;
    __host__ __device__ void init(int M, int N, int G_, int c_) { nM = M / BM; nN = N / BM; nwg = nM * nN; G = G_; c = c_; }
    __host__ __device__ bool next(int i, Unit& u) const {
        const long L = (long)i * G + c; if (L >= nwg) return false;
        int wgid = (int)L; { const int q = nwg / NXCD, r = nwg % NXCD, xcd = wgid % NXCD, off = wgid / NXCD; wgid = (xcd < r ? xcd * (q + 1) : r * (q + 1) + (xcd - r) * q) + off; }
        const int nig = WGM * nN, gid = wgid / nig, fm = gid * WGM, gsz = (nM - fm) < WGM ? (nM - fm) : WGM;
        u.pm = fm + ((wgid % nig) % gsz); u.pn = (wgid % nig) / gsz; return true;
    }
    __device__ __forceinline__ void a_ready(const Unit&) const {}
    __device__ __forceinline__ void done(const Unit&) const {}
};

typedef float f32x2_cv __attribute__((ext_vector_type(2))); typedef __bf16 bf16x2_cv __attribute__((ext_vector_type(2)));
__device__ __forceinline__ unsigned cvt_pk_bf16(float lo, float hi) { const f32x2_cv v = {lo, hi}; const bf16x2_cv b = __builtin_convertvector(v, bf16x2_cv); return __builtin_bit_cast(unsigned, b); }
typedef float f32x2 __attribute__((ext_vector_type(2)));
typedef unsigned u32x2 __attribute__((ext_vector_type(2)));
__device__ __forceinline__ float bflo(unsigned w) { return __uint_as_float(w << 16); }
__device__ __forceinline__ float bfhi(unsigned w) { return __uint_as_float(w & 0xffff0000u); }
__device__ __forceinline__ float sigmoidf_(float x) { return 1.0f / (1.0f + __expf(-x)); }
constexpr float RMS_EPS = 1e-6f;
__device__ __forceinline__ f32x2 gelu_pk(f32x2 v) {
    const f32x2 av = __builtin_elementwise_abs(v), d = av * 0.2316418882f + 1.0f;
    f32x2 t; t.x = __builtin_amdgcn_rcpf(d.x); t.y = __builtin_amdgcn_rcpf(d.y);
    f32x2 q = t * 0.5307027145f + (-0.7265760135f); q = q * t + 0.7107068705f; q = q * t + (-0.142248368f); q = q * t + 0.127414796f; q = q * t;
    const f32x2 s = (v * v) * (-0.72134752044f);
    f32x2 e; e.x = __builtin_amdgcn_exp2f(s.x); e.y = __builtin_amdgcn_exp2f(s.y);
    const f32x2 m = v * (q * e), r = v - m;
    f32x2 o; o.x = v.x < 0.f ? m.x : r.x; o.y = v.y < 0.f ? m.y : r.y; return o;
}

struct EpiProjA {
    static constexpr bool PERM = true, AFTER_DRAIN = false;
    bf16_t* ATT; bf16_t* DNQ; bf16_t* Z; float* SMALL; const float* rstd; const float* ropeC; const float* ropeS; int smask;
    __device__ __forceinline__ void operator()(const f32x4 (&acc)[2][2][4][2], const Unit& u, int wr, int wc, int fr, int fq) const {
        const int row0 = u.pm * BM + wr * 64 + fr; const int pn = u.pn;
        bf16_t* base; int ldc, colt;
        if (pn < 18) { base = ATT; ldc = 4608; colt = pn * 256; } else if (pn < 30) { base = DNQ; ldc = 3072; colt = (pn - 18) * 256; } else { base = Z; ldc = 1024; colt = (pn - 30) * 256; }
        const int col0 = colt + wc * 32 + 8 * fq;
        const bool do_rope = (pn < 12) && ((wc & 1) == 0);
        const float qs = (pn < 6) ? 0.18033688011112042f : 1.0f;
#pragma unroll
        for (int ai = 0; ai < 2; ++ai)
#pragma unroll
            for (int m = 0; m < 4; ++m) { const int r = row0 + ai * HALF + m * 16; const float rs = rstd[r];
                f32x4 c0 = {1.f, 1.f, 1.f, 1.f}, c1 = c0, s0 = {0.f, 0.f, 0.f, 0.f}, s1 = s0;
                if (do_rope) { const int pos = r & smask; c0 = *(const f32x4*)(ropeC + pos * 8); c1 = *(const f32x4*)(ropeC + pos * 8 + 4); s0 = *(const f32x4*)(ropeS + pos * 8); s1 = *(const f32x4*)(ropeS + pos * 8 + 4);
                    if (fq == 0) { s0 = -s0; s1 = -s1; } if (fq >= 2) { c0 = (f32x4){1.f, 1.f, 1.f, 1.f}; c1 = c0; s0 = (f32x4){0.f, 0.f, 0.f, 0.f}; s1 = s0; } }
#pragma unroll
                for (int bj = 0; bj < 2; ++bj) { f32x4 v0 = acc[ai][bj][m][0] * rs, v1 = acc[ai][bj][m][1] * rs;
                    if (do_rope) { f32x4 p0, p1;
#pragma unroll
                        for (int e = 0; e < 4; ++e) { p0[e] = __shfl_xor(v0[e], 16); p1[e] = __shfl_xor(v1[e], 16); }
                        v0 = v0 * c0 + p0 * s0; v1 = v1 * c1 + p1 * s1; }
                    v0 = v0 * qs; v1 = v1 * qs;
                    if (pn < 34) { u32x4 w; w.x = cvt_pk_bf16(v0[0], v0[1]); w.y = cvt_pk_bf16(v0[2], v0[3]); w.z = cvt_pk_bf16(v1[0], v1[1]); w.w = cvt_pk_bf16(v1[2], v1[3]);
                        *(u32x4*)(base + (size_t)r * ldc + col0 + bj * HALF) = w; }
                    else if (bj == 0 && wc == 0) { float* sp = SMALL + (size_t)r * 32 + 8 * fq; *(f32x4*)sp = v0; *(f32x4*)(sp + 4) = v1; } } }
    }
};
struct EpiGates {
    static constexpr bool PERM = true, AFTER_DRAIN = false;
    bf16_t* G; const float* rstd;
    __device__ __forceinline__ void operator()(const f32x4 (&acc)[2][2][4][2], const Unit& u, int wr, int wc, int fr, int fq) const {
        const int row0 = u.pm * BM + wr * 64 + fr; const int col0 = u.pn * BM + wc * 32 + 8 * fq;
#pragma unroll
        for (int ai = 0; ai < 2; ++ai)
#pragma unroll
            for (int m = 0; m < 4; ++m) { const int r = row0 + ai * HALF + m * 16; const float rs = rstd[r];
#pragma unroll
                for (int bj = 0; bj < 2; ++bj) { const f32x4 v0 = acc[ai][bj][m][0] * rs, v1 = acc[ai][bj][m][1] * rs;
                    u32x4 w; w.x = cvt_pk_bf16(sigmoidf_(v0[0]), sigmoidf_(v0[1])); w.y = cvt_pk_bf16(sigmoidf_(v0[2]), sigmoidf_(v0[3])); w.z = cvt_pk_bf16(sigmoidf_(v1[0]), sigmoidf_(v1[1])); w.w = cvt_pk_bf16(sigmoidf_(v1[2]), sigmoidf_(v1[3]));
                    *(u32x4*)(G + (size_t)r * 2048 + col0 + bj * HALF) = w; } }
    }
};
struct EpiF32 {
    static constexpr bool PERM = false, AFTER_DRAIN = false;
    float* C; int ldc;
    __device__ __forceinline__ void operator()(const f32x4 (&acc)[2][2][4][2], const Unit& u, int wr, int wc, int fr, int fq) const {
        const int row0 = u.pm * BM + wr * 64 + fr, col0 = u.pn * BM + wc * 32 + 4 * fq;
#pragma unroll
        for (int ai = 0; ai < 2; ++ai)
#pragma unroll
            for (int m = 0; m < 4; ++m) { float* rowp = C + (size_t)(row0 + ai * HALF + m * 16) * ldc + col0;
#pragma unroll
                for (int bj = 0; bj < 2; ++bj)
#pragma unroll
                    for (int n = 0; n < 2; ++n) *(f32x4*)(rowp + bj * HALF + n * 16) = acc[ai][bj][m][n]; }
    }
};
struct EpiMix {
    static constexpr bool PERM = true, AFTER_DRAIN = false;
    const bf16_t* G; const float* YA; bf16_t* MIX;
    __device__ __forceinline__ void operator()(const f32x4 (&acc)[2][2][4][2], const Unit& u, int wr, int wc, int fr, int fq) const {
        const int row0 = u.pm * BM + wr * 64 + fr; const int col0 = u.pn * BM + wc * 32 + 8 * fq;
#pragma unroll
        for (int ai = 0; ai < 2; ++ai)
#pragma unroll
            for (int m = 0; m < 4; ++m) { const int r = row0 + ai * HALF + m * 16;
#pragma unroll
                for (int bj = 0; bj < 2; ++bj) { const int c = col0 + bj * HALF;
                    const u32x4 ga = *(const u32x4*)(G + (size_t)r * 2048 + c), gb = *(const u32x4*)(G + (size_t)r * 2048 + 1024 + c);
                    const f32x4 y0 = *(const f32x4*)(YA + (size_t)r * 1024 + c), y1 = *(const f32x4*)(YA + (size_t)r * 1024 + c + 4);
                    const f32x4 a0 = acc[ai][bj][m][0], a1 = acc[ai][bj][m][1];
                    u32x4 w;
                    w.x = cvt_pk_bf16(bflo(ga.x) * y0[0] + bflo(gb.x) * a0[0], bfhi(ga.x) * y0[1] + bfhi(gb.x) * a0[1]);
                    w.y = cvt_pk_bf16(bflo(ga.y) * y0[2] + bflo(gb.y) * a0[2], bfhi(ga.y) * y0[3] + bfhi(gb.y) * a0[3]);
                    w.z = cvt_pk_bf16(bflo(ga.z) * y1[0] + bflo(gb.z) * a1[0], bfhi(ga.z) * y1[1] + bfhi(gb.z) * a1[1]);
                    w.w = cvt_pk_bf16(bflo(ga.w) * y1[2] + bflo(gb.w) * a1[2], bfhi(ga.w) * y1[3] + bfhi(gb.w) * a1[3]);
                    *(u32x4*)(MIX + (size_t)r * 1024 + c) = w; } }
    }
};
struct EpiRes {
    static constexpr bool PERM = false, AFTER_DRAIN = false;
    const float* RES; float* OUT; bf16_t* XB; float* ssq;
    __device__ __forceinline__ void operator()(const f32x4 (&acc)[2][2][4][2], const Unit& u, int wr, int wc, int fr, int fq) const {
        const int row0 = u.pm * BM + wr * 64 + fr, col0 = u.pn * BM + wc * 32 + 4 * fq;
#pragma unroll
        for (int ai = 0; ai < 2; ++ai)
#pragma unroll
            for (int m = 0; m < 4; ++m) { const int r = row0 + ai * HALF + m * 16; const size_t off = (size_t)r * 1024 + col0; float s = 0.f;
#pragma unroll
                for (int bj = 0; bj < 2; ++bj)
#pragma unroll
                    for (int n = 0; n < 2; ++n) { const size_t o2 = off + bj * HALF + n * 16; const f32x4 v = *(const f32x4*)(RES + o2) + acc[ai][bj][m][n];
                        *(f32x4*)(OUT + o2) = v; s += (v[0] * v[0] + v[1] * v[1]) + (v[2] * v[2] + v[3] * v[3]);
                        if (XB) { u32x2 w; w.x = cvt_pk_bf16(v[0], v[1]); w.y = cvt_pk_bf16(v[2], v[3]); *(u32x2*)(XB + o2) = w; } }
                s += __shfl_xor(s, 16); s += __shfl_xor(s, 32);
                if (fq == 0) atomicAdd(ssq + r, s); }
    }
};
struct EpiUp {
    static constexpr bool PERM = true, AFTER_DRAIN = false;
    bf16_t* UP; const float* ssq;
    __device__ __forceinline__ void operator()(const f32x4 (&acc)[2][2][4][2], const Unit& u, int wr, int wc, int fr, int fq) const {
        const int row0 = u.pm * BM + wr * 64 + fr; const int col0 = u.pn * BM + wc * 32 + 8 * fq;
#pragma unroll
        for (int ai = 0; ai < 2; ++ai)
#pragma unroll
            for (int m = 0; m < 4; ++m) { const int r = row0 + ai * HALF + m * 16; const float rs = rsqrtf(ssq[r] * (1.0f / 1024.0f) + RMS_EPS);
#pragma unroll
                for (int bj = 0; bj < 2; ++bj) { const f32x4 v0 = acc[ai][bj][m][0] * rs, v1 = acc[ai][bj][m][1] * rs;
                    u32x4 w; w.x = cvt_pk_bf16(v0[0], v0[1]); w.y = cvt_pk_bf16(v0[2], v0[3]); w.z = cvt_pk_bf16(v1[0], v1[1]); w.w = cvt_pk_bf16(v1[2], v1[3]);
                    *(u32x4*)(UP + (size_t)r * 5632 + col0 + bj * HALF) = w; } }
    }
};
template <class Epi, class Sched, bool ALIGN_EPI = false, bool SP2 = false>
__device__ __forceinline__ void gemm_phase(PG8_LAS unsigned char* lds, const Gemm g, const Sched& S, const Epi& E, int tid_) {
    asm volatile("" : "+v"(tid_)); const int tid = tid_, wid = __builtin_amdgcn_readfirstlane(tid >> 6), lane = tid & 63, wr = wid >> 2, wc = wid & 3, fr = lane & 15, fq = lane >> 4;
    const int K = g.K, nt = K / BK;
    unsigned voffA[2], voffB[2];
#pragma unroll
    for (int i = 0; i < 2; ++i) { int R, C; stage_rc(tid * 16 + i * 8192, R, C); const int Rb = Epi::PERM ? ((R & ~31) + perm32(R & 31)) : R;
        voffA[i] = (unsigned)(R * K + C) * 2u; voffB[i] = (unsigned)(Rb * K + C) * 2u; }
    const size_t kstep = (size_t)(BK * 2);
    const size_t hstep = (size_t)HALF * K * 2;
    const size_t tstep = 2 * hstep;
    const unsigned ldsw = (unsigned)wid * 1024u;
    const int aoff = lds_byte(wr * 64 + fr, fq * 8), boff = lds_byte(wc * 32 + fr, fq * 8);
#define PG8_SA(b, h) (((b) * 2 + (h)) * HTB)
#define PG8_SB(b, h) ((4 + (b) * 2 + (h)) * HTB)
#define PG8_STAGE(bufoff, gbase, voff) do { _Pragma("unroll") for (int _i = 0; _i < 2; ++_i) \
        __builtin_amdgcn_global_load_lds((const unsigned*)((const char*)(gbase) + (voff)[_i]), (PG8_LAS unsigned*)(lds + (bufoff) + ldsw + _i * 8192), 16, 0, 0); } while (0)
#define PG8_LDA(dst, b, h) do { _Pragma("unroll") for (int m = 0; m < 4; ++m) _Pragma("unroll") for (int k = 0; k < 2; ++k) dst[m][k] = *(const PG8_LAS bf16x8*)(lds + PG8_SA(b, h) + aoff + m * 2048 + k * 1024); } while (0)
#define PG8_LDB(dst, b, h) do { _Pragma("unroll") for (int n = 0; n < 2; ++n) _Pragma("unroll") for (int k = 0; k < 2; ++k) dst[n][k] = *(const PG8_LAS bf16x8*)(lds + PG8_SB(b, h) + boff + n * 2048 + k * 1024); } while (0)
#define PG8_MMA(ai, bj, At, Bt) do { __builtin_amdgcn_s_setprio(1); _Pragma("unroll") for (int m = 0; m < 4; ++m) _Pragma("unroll") for (int n = 0; n < 2; ++n) _Pragma("unroll") for (int k = 0; k < 2; ++k) \
        acc[ai][bj][m][n] = __builtin_amdgcn_mfma_f32_16x16x32_bf16(Bt[n][k], At[m][k], acc[ai][bj][m][n], 0, 0, 0); __builtin_amdgcn_s_setprio(0); } while (0)
#define PG8_WAIT_V(n) asm volatile("s_waitcnt vmcnt(" #n ")" ::: "memory")
#define PG8_WAIT_L(n) asm volatile("s_waitcnt lgkmcnt(" #n ")" ::: "memory")
#define PG8_BAR __builtin_amdgcn_s_barrier()
#define PG8_SCHED __builtin_amdgcn_sched_barrier(0)
    Unit cur, nxt; int ui = 0;
    if (!S.next(0, cur)) return;
    f32x4 acc[2][2][4][2];
    f32x4 zz_ = (f32x4){0.f, 0.f, 0.f, 0.f}; asm volatile("" : "+v"(zz_));
#pragma unroll
    for (int a = 0; a < 2; ++a)
#pragma unroll
        for (int b = 0; b < 2; ++b)
#pragma unroll
            for (int m = 0; m < 4; ++m)
#pragma unroll
                for (int n = 0; n < 2; ++n) acc[a][b][m][n] = zz_;
    bf16x8 At[4][2], B0[2][2], B1[2][2];
    const char* cA = (const char*)g.A + (size_t)cur.pm * tstep; const char* cB = (const char*)g.Bt + (size_t)cur.pn * tstep;
    S.a_ready(cur);
    if constexpr (SP2) {
        PG8_STAGE(PG8_SB(0, 0), cB, voffB); PG8_STAGE(PG8_SB(0, 1), cB + hstep, voffB); PG8_STAGE(PG8_SA(0, 0), cA, voffA); PG8_STAGE(PG8_SA(0, 1), cA + hstep, voffA);
        if (wr == 1) PG8_BAR;
        PG8_WAIT_V(2); PG8_BAR;
        PG8_STAGE(PG8_SB(1, 0), cB + kstep, voffB); PG8_STAGE(PG8_SA(1, 0), cA + kstep, voffA); PG8_STAGE(PG8_SB(1, 1), cB + hstep + kstep, voffB);
        PG8_WAIT_V(6); PG8_BAR;
    } else {
        PG8_STAGE(PG8_SB(0, 0), cB, voffB); PG8_STAGE(PG8_SA(0, 0), cA, voffA); PG8_STAGE(PG8_SB(0, 1), cB + hstep, voffB); PG8_STAGE(PG8_SA(0, 1), cA + hstep, voffA);
        if (wr == 1) PG8_BAR;
        PG8_WAIT_V(4); PG8_BAR;
        PG8_STAGE(PG8_SB(1, 0), cB + kstep, voffB); PG8_STAGE(PG8_SA(1, 0), cA + kstep, voffA); PG8_STAGE(PG8_SB(1, 1), cB + hstep + kstep, voffB);
        PG8_WAIT_V(6); PG8_BAR;
    }
    for (;;) {
        const bool has_next = S.next(ui + 1, nxt);
        const char* nA = has_next ? (const char*)g.A + (size_t)nxt.pm * tstep : cA; const char* nB = has_next ? (const char*)g.Bt + (size_t)nxt.pn * tstep : cB;
        for (int t = 0; t < nt; t += 2) {
            const bool last = (t == nt - 2);
            const char* a1 = cA + (size_t)(t + 1) * kstep;
            const char* a2 = last ? nA : cA + (size_t)(t + 2) * kstep; const char* b2 = last ? nB : cB + (size_t)(t + 2) * kstep;
            const char* a3 = a2 + kstep; const char* b3 = b2 + kstep;
            if (last && has_next) S.a_ready(nxt);
            if constexpr (SP2) {
            PG8_LDB(B0, 0, 0); PG8_LDB(B1, 0, 1); PG8_SCHED; PG8_LDA(At, 0, 0); PG8_STAGE(PG8_SA(1, 1), a1 + hstep, voffA);
            PG8_WAIT_V(8); PG8_WAIT_L(0); PG8_BAR; PG8_MMA(0, 0, At, B0); PG8_MMA(0, 1, At, B1); PG8_BAR; PG8_SCHED;
            PG8_LDA(At, 0, 1); PG8_STAGE(PG8_SB(0, 0), b2, voffB); PG8_STAGE(PG8_SB(0, 1), b2 + hstep, voffB); PG8_STAGE(PG8_SA(0, 0), a2, voffA);
            PG8_WAIT_V(8); PG8_WAIT_L(0); PG8_BAR; PG8_MMA(1, 0, At, B0); PG8_MMA(1, 1, At, B1); PG8_BAR; PG8_SCHED;
            PG8_LDB(B0, 1, 0); PG8_LDB(B1, 1, 1); PG8_SCHED; PG8_LDA(At, 1, 0); PG8_STAGE(PG8_SA(0, 1), a2 + hstep, voffA);
            PG8_WAIT_V(8); PG8_WAIT_L(0); PG8_BAR; PG8_MMA(0, 0, At, B0); PG8_MMA(0, 1, At, B1); PG8_BAR; PG8_SCHED;
            PG8_LDA(At, 1, 1); PG8_STAGE(PG8_SB(1, 0), b3, voffB); PG8_STAGE(PG8_SB(1, 1), b3 + hstep, voffB); PG8_STAGE(PG8_SA(1, 0), a3, voffA);
            PG8_WAIT_V(8); PG8_WAIT_L(0); PG8_BAR; PG8_MMA(1, 0, At, B0); PG8_MMA(1, 1, At, B1); PG8_BAR; PG8_SCHED;
            } else {
            PG8_LDB(B0, 0, 0); PG8_SCHED; PG8_LDA(At, 0, 0); PG8_STAGE(PG8_SA(1, 1), a1 + hstep, voffA);
            PG8_WAIT_L(8); PG8_BAR; PG8_WAIT_L(0); PG8_MMA(0, 0, At, B0); PG8_BAR; PG8_SCHED;
            PG8_LDB(B1, 0, 1); PG8_STAGE(PG8_SB(0, 0), b2, voffB);
            PG8_BAR; PG8_WAIT_L(0); PG8_MMA(0, 1, At, B1); PG8_BAR;
            PG8_LDA(At, 0, 1); PG8_STAGE(PG8_SA(0, 0), a2, voffA);
            PG8_BAR; PG8_WAIT_L(0); PG8_MMA(1, 0, At, B0); PG8_BAR; PG8_SCHED;
            PG8_STAGE(PG8_SB(0, 1), b2 + hstep, voffB);
            PG8_WAIT_V(6); PG8_BAR; PG8_MMA(1, 1, At, B1); PG8_BAR;
            PG8_LDB(B0, 1, 0); PG8_SCHED; PG8_LDA(At, 1, 0); PG8_STAGE(PG8_SA(0, 1), a2 + hstep, voffA);
            PG8_WAIT_L(8); PG8_BAR; PG8_WAIT_L(0); PG8_MMA(0, 0, At, B0); PG8_BAR; PG8_SCHED;
            PG8_LDB(B1, 1, 1); PG8_STAGE(PG8_SB(1, 0), b3, voffB);
            PG8_BAR; PG8_WAIT_L(0); PG8_MMA(0, 1, At, B1); PG8_BAR;
            PG8_LDA(At, 1, 1); PG8_STAGE(PG8_SA(1, 0), a3, voffA);
            PG8_BAR; PG8_WAIT_L(0); PG8_MMA(1, 0, At, B0); PG8_BAR; PG8_SCHED;
            PG8_STAGE(PG8_SB(1, 1), b3 + hstep, voffB);
            PG8_WAIT_V(6); PG8_BAR; PG8_MMA(1, 1, At, B1); PG8_BAR;
            }
        }
        if constexpr (ALIGN_EPI) { if (wr == 0) PG8_BAR; }
        if constexpr (!Epi::AFTER_DRAIN) { E(acc, cur, wr, wc, fr, fq); S.done(cur); }
        if (!has_next) break;
        zz_ = (f32x4){0.f, 0.f, 0.f, 0.f}; asm volatile("" : "+v"(zz_));
#pragma unroll
        for (int a = 0; a < 2; ++a)
#pragma unroll
            for (int b = 0; b < 2; ++b)
#pragma unroll
                for (int m = 0; m < 4; ++m)
#pragma unroll
                    for (int n = 0; n < 2; ++n) acc[a][b][m][n] = zz_;
        cur = nxt; cA = nA; cB = nB; ++ui;
        if constexpr (ALIGN_EPI) { if (wr == 1) PG8_BAR; }
    }
    PG8_WAIT_V(0);
    if constexpr (!ALIGN_EPI) { if (wr == 0) PG8_BAR; }
    PG8_BAR;
    if constexpr (Epi::AFTER_DRAIN) { E.fused(acc, cur, wr, wc, fr, fq, lds, wid, lane); S.done(cur); }
#undef PG8_SA
#undef PG8_SB
#undef PG8_STAGE
#undef PG8_LDA
#undef PG8_LDB
#undef PG8_MMA
#undef PG8_WAIT_V
#undef PG8_WAIT_L
#undef PG8_BAR
#undef PG8_SCHED
}
}

#define LAS __attribute__((address_space(3)))
typedef unsigned short bf16;
typedef float f32x4 __attribute__((ext_vector_type(4)));
typedef unsigned v4u __attribute__((ext_vector_type(4)));
typedef unsigned v2u __attribute__((ext_vector_type(2)));
using pg8::cvt_pk_bf16; using pg8::bflo; using pg8::bfhi;

constexpr int NWAVES = 8, NTHREADS = 512;
constexpr int D = 1024, NTOK = 49152, TG = 16384, NGROUPS = 3;
constexpr int ATTW = 4608, DNW = 3072, NPA = 8960  , NIN_T = 11008, DFF = 2816, NUP = 5632;
constexpr float EPS = 1e-6f;

constexpr size_t MiB = 1u << 20;
constexpr size_t WS_CTL = 0, CTL_BYTES = 1 * MiB;
constexpr size_t CTL_SSQ2 = 256 * 1024, CTL_SSQ3 = 512 * 1024;
constexpr size_t WS_WIN = 1 * MiB, WS_WUP = 23 * MiB, WS_WDOWN = 34 * MiB, WS_WOUT = 40 * MiB, WS_WA = 42 * MiB, WS_WB = 43 * MiB;
constexpr size_t WS_ROPE = 45 * MiB, WS_RSTD1 = 46 * MiB, WS_XB = 48 * MiB  , WS_ARENA = 80 * MiB, WS_END = 512 * MiB;
constexpr size_t AR_ATT = 0, AR_DNQ = 144 * MiB, AR_Z = 240 * MiB, AR_SMALL = 272 * MiB, AR_AO = 274 * MiB, AR_PO = 290 * MiB, AR_LSE = 338 * MiB, AR_MIX = 290 * MiB;
constexpr size_t AR_FRAG = 0, AR_VACC = 96 * MiB, AR_TI = 340 * MiB, AR_VEC = 404 * MiB;
constexpr size_t AR_OF = 144 * MiB, AR_OB = 176 * MiB, AR_DNOUT = 208 * MiB;
constexpr size_t AR_G = 0, AR_YA = 64 * MiB;
constexpr size_t AR_UP = 0, AR_ACT = 176 * MiB;
static_assert(WS_ARENA + AR_VEC + 8 * MiB <= WS_END, "ws map");

struct Args { const float* in[19]; float* out; unsigned char* ws; int lo, hi; };

__device__ __forceinline__ float wave_sum(float v) {
#pragma unroll
    for (int o = 1; o < 64; o <<= 1) v += __shfl_xor(v, o);
    return v;
}
__device__ __forceinline__ float bf2f(bf16 u) { return __uint_as_float((unsigned)u << 16); }
__device__ __forceinline__ float siluf_(float x) { return x / (1.0f + __expf(-x)); }

__device__ __forceinline__ void p0_transpose_item(const float* W, int ldw, int col_off, int K, int ncols, const float* gain, bf16* WT, int row_off, LAS float* scr, int item, int lane) {
    const int nblk = ncols / 32, kb = item / nblk, nb = item % nblk, k0 = 64 * kb, n0 = 32 * nb;
#pragma unroll 8
    for (int i = 0; i < 32; ++i) { const int kk = 2 * i + (lane >> 5); float w = W[(size_t)(k0 + kk) * ldw + col_off + n0 + (lane & 31)]; if (gain) w *= gain[k0 + kk]; scr[kk * 33 + (lane & 31)] = w; }
    asm volatile("s_waitcnt lgkmcnt(0)" ::: "memory");
    const int c = lane & 7;
#pragma unroll
    for (int j = 0; j < 4; ++j) { const int n = (lane >> 3) + 8 * j; const LAS float* s = scr + (8 * c) * 33 + n;
        v4u o; o.x = cvt_pk_bf16(s[0 * 33], s[1 * 33]); o.y = cvt_pk_bf16(s[2 * 33], s[3 * 33]); o.z = cvt_pk_bf16(s[4 * 33], s[5 * 33]); o.w = cvt_pk_bf16(s[6 * 33], s[7 * 33]);
        *(v4u*)(WT + (size_t)(row_off + n0 + n) * K + k0 + 8 * c) = o; }
    asm volatile("s_waitcnt lgkmcnt(0)" ::: "memory");
}

struct Ptrs {
    const float *x_p, *x_s, *norm_mix_g, *w_in, *conv_w, *a_log_f, *a_log_b, *dt_f, *dt_b, *out_norm_g, *w_a, *w_b, *w_out, *norm_ffn_g, *w_up, *ffn_conv_w, *ffn_conv_b, *w_down, *norm_final_g;
    float* out; unsigned char* ws;
};
__device__ __forceinline__ const float* x_row(const Ptrs& P, int tok) { return tok < 32768 ? P.x_p + (size_t)tok * D : P.x_s + (size_t)(tok - 32768) * D; }

__device__ __forceinline__ void phase_xb(const Ptrs& P, int g, int gw, int NGW, int lane) {
    bf16* XB = (bf16*)(P.ws + WS_XB); float* rstd1 = (float*)(P.ws + WS_RSTD1);
    for (int m = gw; m < TG; m += NGW) {
        const f32x4* xr = (const f32x4*)x_row(P, g * TG + m) + lane; f32x4 v[4]; float s = 0.f;
#pragma unroll
        for (int j = 0; j < 4; ++j) { v[j] = xr[64 * j]; s += (v[j].x * v[j].x + v[j].y * v[j].y) + (v[j].z * v[j].z + v[j].w * v[j].w); }
        s = wave_sum(s);
        if (lane == 0) rstd1[g * TG + m] = rsqrtf(s * (1.0f / 1024.0f) + EPS);
        unsigned long long* o8 = (unsigned long long*)(XB + (size_t)m * D) + lane;
#pragma unroll
        for (int j = 0; j < 4; ++j) o8[64 * j] = (unsigned long long)cvt_pk_bf16(v[j].x, v[j].y) | ((unsigned long long)cvt_pk_bf16(v[j].z, v[j].w) << 32);
    }
}
__device__ __forceinline__ void phase_prologue(const Ptrs& P, unsigned char* lds, int bid, int G, int tid) {
    const int lane = tid & 63, wave = tid >> 6;
    LAS float* scr = (LAS float*)((LAS unsigned char*)lds + wave * 16384);
    const int gw = bid * NWAVES + wave, NGW = G * NWAVES;
    bf16* Win = (bf16*)(P.ws + WS_WIN); bf16* Wup = (bf16*)(P.ws + WS_WUP); bf16* Wdn = (bf16*)(P.ws + WS_WDOWN); bf16* Wout = (bf16*)(P.ws + WS_WOUT); bf16* Wa = (bf16*)(P.ws + WS_WA); bf16* Wb = (bf16*)(P.ws + WS_WB);
    constexpr int I1 = 16 * 273, I2 = 16 * 64, I3 = 8 * 32, I4 = 16 * 32, I5 = 16 * 32, I6 = 16 * 176, I7 = 44 * 32;
    constexpr int NIT = I1 + I2 + I3 + I4 + I5 + I6 + I7;
    for (int it = gw; it < NIT; it += NGW) {
        int r = it;
        if (r < I1) { p0_transpose_item(P.w_in, 10784, 0, 1024, 8736, P.norm_mix_g, Win, 0, scr, r, lane); continue; } r -= I1;
        if (r < I2) { p0_transpose_item(P.w_in, 10784, 8736, 1024, 2048, P.norm_mix_g, Win, 8960, scr, r, lane); continue; } r -= I2;
        if (r < I3) { p0_transpose_item(P.w_a, 1024, 0, 512, 1024, nullptr, Wa, 0, scr, r, lane); continue; } r -= I3;
        if (r < I4) { p0_transpose_item(P.w_b, 1024, 0, 1024, 1024, nullptr, Wb, 0, scr, r, lane); continue; } r -= I4;
        if (r < I5) { p0_transpose_item(P.w_out, 1024, 0, 1024, 1024, nullptr, Wout, 0, scr, r, lane); continue; } r -= I5;
        if (r < I6) { p0_transpose_item(P.w_up, 5632, 0, 1024, 5632, P.norm_ffn_g, Wup, 0, scr, r, lane); continue; } r -= I6;
        p0_transpose_item(P.w_down, 1024, 0, 2816, 1024, nullptr, Wdn, 0, scr, r, lane);
    }
    const int gt = bid * NTHREADS + tid, NGT = G * NTHREADS;
    for (int i = gt; i < 28672; i += NGT) ((v4u*)(Win + (size_t)8736 * 1024))[i] = (v4u){0u, 0u, 0u, 0u};
    float* ropeC = (float*)(P.ws + WS_ROPE); float* ropeS = ropeC + 4096 * 8;
    for (int i = gt; i < 4096 * 8; i += NGT) { const int pos = i >> 3, j = i & 7;
        const float invt[8] = {1.0f, 0.19392274f, 0.03760603f, 0.0072926646f, 0.0014142136f, 0.0002742482f, 5.3182957e-05f, 1.0313385e-05f};
        const float inv = invt[j]; const float ang = (float)pos * inv;
        const float c_hi = 0.15915494f, c_lo = 6.4206382e-09f;
        const float kq = rintf(ang * c_hi); float r = fmaf(ang, c_hi, -kq); r = fmaf(ang, c_lo, r);
        ropeC[i] = __builtin_amdgcn_cosf(r); ropeS[i] = __builtin_amdgcn_sinf(r); }
    phase_xb(P, 0, gw, NGW, lane);
}

__device__ __forceinline__ void load8bf(const bf16* p, float* o) { const v4u w = *(const v4u*)p; o[0] = bflo(w.x); o[1] = bfhi(w.x); o[2] = bflo(w.y); o[3] = bfhi(w.y); o[4] = bflo(w.z); o[5] = bfhi(w.z); o[6] = bflo(w.w); o[7] = bfhi(w.w); }
typedef short bf16x8_t __attribute__((ext_vector_type(8)));
typedef float f32x16 __attribute__((ext_vector_type(16)));
typedef short s16x4_t __attribute__((ext_vector_type(4)));
__device__ __forceinline__ void phase_attn(const bf16* ATT, bf16* PO, float* LSE, int S, unsigned char* lds_, int bid, int G, int tid) {
    LAS unsigned char* lds = (LAS unsigned char*)lds_;
    const int lane = tid & 63, w = __builtin_amdgcn_readfirstlane(tid >> 6), ql = lane & 31, h2 = lane >> 5;
    const int NU = S >> 8, nunits = (TG / S) * 24 * NU;
    constexpr int KOFF = 0, VOFF = 49152;
    for (int u = bid; u < nunits; u += G) {
        const int idx = u % NU, bh = u / NU, h = bh % 24, b = bh / 24; const int gi = h >> 3, dil = (gi == 0) ? 1 : (gi == 1) ? 4 : 16, L = S / dil;
        const int seq0 = b * S;
        const bool two = (L < 256);
        const int r0 = two ? 2 * idx : idx % dil, p0 = two ? 0 : (idx / dil) * 256, sbase = two ? 0 : p0 - 64, nrows = two ? 256 : 384;
        { const int ri = lane >> 3, c = lane & 7;
          for (int pc = w; pc < nrows / 8; pc += NWAVES) { const int row = pc * 8 + ri; int cls, pos;
              if (two) { cls = r0 + (row >> 7); pos = row & 127; } else { cls = r0; pos = sbase + row; pos = pos < 0 ? 0 : (pos >= L ? L - 1 : pos); }
              const bf16* src = ATT + (size_t)(seq0 + cls + dil * pos) * ATTW + h * 64;
              __builtin_amdgcn_global_load_lds((const unsigned*)(src + 1536 + ((c ^ ri) << 3)), (LAS unsigned*)(lds + KOFF + pc * 1024), 16, 0, 0);
              __builtin_amdgcn_global_load_lds((const unsigned*)(src + 3072 + ((c ^ (((ri >> 1) & 1) << 2)) << 3)), (LAS unsigned*)(lds + VOFF + pc * 1024), 16, 0, 0); } }
        const int cls = two ? r0 + (w >> 2) : r0; const int qp0 = two ? 32 * (w & 3) : p0 + 32 * w;
        const int tokq = seq0 + cls + dil * (qp0 + ql);
        bf16x8_t qf[4];
#pragma unroll
        for (int s4 = 0; s4 < 4; ++s4) qf[s4] = *(const bf16x8_t*)(ATT + (size_t)tokq * ATTW + h * 64 + 16 * s4 + 8 * h2);
        const int lrow0 = (two ? (w >> 2) * 128 : 0) + qp0 - 64 - sbase;
        __syncthreads();
        f32x16 St[5]; float mx = -1e30f;
#pragma unroll
        for (int t = 0; t < 5; ++t) { const int kp0 = qp0 - 64 + 32 * t; const bool ok = (kp0 >= 0) && (kp0 < L);
            if (ok) { const int R = lrow0 + 32 * t + ql; f32x16 a = {};
#pragma unroll
                for (int s4 = 0; s4 < 4; ++s4) { const bf16x8_t kf = *(const LAS bf16x8_t*)(lds + KOFF + R * 128 + (((2 * s4 + h2) ^ (R & 7)) << 4)); a = __builtin_amdgcn_mfma_f32_32x32x16_bf16(kf, qf[s4], a, 0, 0, 0); }
#pragma unroll
                for (int rg = 0; rg < 16; ++rg) { const int row = (rg & 3) + 8 * (rg >> 2) + 4 * h2; if ((t == 0 && row < ql) || (t == 4 && row > ql)) a[rg] = -1e30f; mx = fmaxf(mx, a[rg]); }
                St[t] = a; }
            else { St[t] = (f32x16){}; } }
        mx = fmaxf(mx, __shfl_xor(mx, 32));
        float lsum = 0.f; f32x16 O0 = {}, O1 = {};
#pragma unroll
        for (int t = 0; t < 5; ++t) { const int kp0 = qp0 - 64 + 32 * t; const bool ok = (kp0 >= 0) && (kp0 < L);
            if (ok) { f32x16 p = St[t];
#pragma unroll
                for (int rg = 0; rg < 16; ++rg) { p[rg] = __builtin_amdgcn_exp2f(p[rg] - mx); lsum += p[rg]; }
#pragma unroll
                for (int s2 = 0; s2 < 2; ++s2) { v4u pk; pk.x = cvt_pk_bf16(p[8 * s2], p[8 * s2 + 1]); pk.y = cvt_pk_bf16(p[8 * s2 + 2], p[8 * s2 + 3]); pk.z = cvt_pk_bf16(p[8 * s2 + 4], p[8 * s2 + 5]); pk.w = cvt_pk_bf16(p[8 * s2 + 6], p[8 * s2 + 7]);
                    const bf16x8_t pb = __builtin_bit_cast(bf16x8_t, pk);
#pragma unroll
                    for (int dt = 0; dt < 2; ++dt) { const int g16 = (lane >> 4) & 1, qq = (lane & 15) >> 2, pp = lane & 3;
                        const int k0 = lrow0 + 32 * t + 16 * s2 + 4 * h2 + qq, k1 = k0 + 8;
                        const int a0 = VOFF + k0 * 128 + (((dt ^ ((k0 >> 1) & 1)) << 6) | (g16 << 5) | (pp << 3)), a1 = VOFF + k1 * 128 + (((dt ^ ((k1 >> 1) & 1)) << 6) | (g16 << 5) | (pp << 3));
                        const s16x4_t lo = __builtin_bit_cast(s16x4_t, __builtin_amdgcn_ds_read_tr16_b64_v4i16((LAS s16x4_t*)(lds + a0))), hi = __builtin_bit_cast(s16x4_t, __builtin_amdgcn_ds_read_tr16_b64_v4i16((LAS s16x4_t*)(lds + a1)));
                        const bf16x8_t vf = (bf16x8_t){lo[0], lo[1], lo[2], lo[3], hi[0], hi[1], hi[2], hi[3]};
                        if (dt == 0) O0 = __builtin_amdgcn_mfma_f32_32x32x16_bf16(vf, pb, O0, 0, 0, 0); else O1 = __builtin_amdgcn_mfma_f32_32x32x16_bf16(vf, pb, O1, 0, 0, 0); } } } }
        lsum += __shfl_xor(lsum, 32);
        const float il = 1.0f / lsum;
        bf16* po = PO + ((size_t)tokq * 24 + h) * 64;
#pragma unroll
        for (int g4 = 0; g4 < 4; ++g4) { v2u w0, w1; w0.x = cvt_pk_bf16(O0[4 * g4] * il, O0[4 * g4 + 1] * il); w0.y = cvt_pk_bf16(O0[4 * g4 + 2] * il, O0[4 * g4 + 3] * il); w1.x = cvt_pk_bf16(O1[4 * g4] * il, O1[4 * g4 + 1] * il); w1.y = cvt_pk_bf16(O1[4 * g4 + 2] * il, O1[4 * g4 + 3] * il);
            *(v2u*)(po + 8 * g4 + 4 * h2) = w0; *(v2u*)(po + 32 + 8 * g4 + 4 * h2) = w1; }
        if (h2 == 0) LSE[(size_t)tokq * 24 + h] = mx + __builtin_amdgcn_logf(lsum);
        __syncthreads();
    }
}
__device__ __forceinline__ void phase_attn_combine(const bf16* PO, const float* LSE, bf16* AO, int gt, int NGT) {
    for (int item = gt; item < TG * 64; item += NGT) { const int tok = item >> 6, hg = (item >> 3) & 7, c = item & 7;
        const float l0 = LSE[(size_t)tok * 24 + hg], l1 = LSE[(size_t)tok * 24 + 8 + hg], l2 = LSE[(size_t)tok * 24 + 16 + hg]; const float m = fmaxf(l0, fmaxf(l1, l2));
        float w0 = __builtin_amdgcn_exp2f(l0 - m), w1 = __builtin_amdgcn_exp2f(l1 - m), w2 = __builtin_amdgcn_exp2f(l2 - m); const float inv = 1.0f / (w0 + w1 + w2); w0 *= inv; w1 *= inv; w2 *= inv;
        float a[8], b8[8], c8[8]; load8bf(PO + ((size_t)tok * 24 + hg) * 64 + c * 8, a); load8bf(PO + ((size_t)tok * 24 + 8 + hg) * 64 + c * 8, b8); load8bf(PO + ((size_t)tok * 24 + 16 + hg) * 64 + c * 8, c8);
#pragma unroll
        for (int e = 0; e < 8; ++e) a[e] = w0 * a[e] + w1 * b8[e] + w2 * c8[e];
        v4u o; o.x = cvt_pk_bf16(a[0], a[1]); o.y = cvt_pk_bf16(a[2], a[3]); o.z = cvt_pk_bf16(a[4], a[5]); o.w = cvt_pk_bf16(a[6], a[7]);
        *(v4u*)(AO + (size_t)tok * 512 + hg * 64 + c * 8) = o; }
}

constexpr int DN_FRAG_U = 49152  , DN_TI_UD = 16384  , DN_VEC_UD = 512  ;
__device__ __forceinline__ int pi_q(int q, int j) { return (j < 4) ? (4 * q + j) : (16 + 4 * q + (j - 4)); }
__device__ __forceinline__ float dpp_xor1(float x) { return __int_as_float(__builtin_amdgcn_mov_dpp(__float_as_int(x), 0xB1, 0xF, 0xF, true)); }
__device__ __forceinline__ float dpp_xor2(float x) { return __int_as_float(__builtin_amdgcn_mov_dpp(__float_as_int(x), 0x4E, 0xF, 0xF, true)); }

__device__ __forceinline__ void phase_dna(const Ptrs& P, const bf16* DNQ, const float* SMALL, unsigned char* FRAG, bf16* VACC, unsigned char* TI, float* VEC, int S, unsigned char* lds_, int bid, int G, int tid) {
    LAS unsigned char* lds = (LAS unsigned char*)lds_;
    const int lane = tid & 63, w = __builtin_amdgcn_readfirstlane(tid >> 6), c16 = lane & 15, q4 = lane >> 4;
    constexpr int RM = 0, FB = 49152, MM = 81920, LP = 0, TM = 81920, GV = 114688;
    LAS bf16* rm = (LAS bf16*)(lds + RM); LAS float* mm = (LAS float*)(lds + MM); LAS float* lp = (LAS float*)(lds + LP); LAS float* tm = (LAS float*)(lds + TM); LAS float* gv = (LAS float*)(lds + GV);
    for (int ui = bid; ui < (TG / 64) * 8; ui += G) {
        const int n = ui >> 3, h = ui & 7; const int tok0 = n * 64, pos0 = tok0 & (S - 1);
        { int cur_part = -1; float w0[5], w1[5];
          for (int it = w * 24; it < w * 24 + 24; ++it) { const int part = it >> 6, t = it & 63; const int ch = part * 1024 + h * 128 + 2 * lane;
              if (part != cur_part) { cur_part = part;
#pragma unroll
                  for (int i = 0; i < 5; ++i) { w0[i] = P.conv_w[i * DNW + ch]; w1[i] = P.conv_w[i * DNW + ch + 1]; } }
              float a0 = 0.f, a1 = 0.f;
#pragma unroll
              for (int i = 0; i < 5; ++i) { const int p2 = pos0 + t + i - 2; if (p2 >= 0 && p2 < S) { const unsigned x = *(const unsigned*)(DNQ + (size_t)(tok0 + t + i - 2) * DNW + ch); a0 += bflo(x) * w0[i]; a1 += bfhi(x) * w1[i]; } }
              a0 = siluf_(a0); a1 = siluf_(a1);
              if (part < 2) { const float ss = wave_sum(a0 * a0 + a1 * a1); float sc = rsqrtf(ss + EPS); if (part == 0) sc *= 0.08838834764831845f; a0 *= sc; a1 *= sc; }
              *(LAS unsigned*)(rm + part * 8192 + t * 128 + 2 * lane) = cvt_pk_bf16(a0, a1); } }
        __syncthreads();
        unsigned char* fr_u = FRAG + (size_t)ui * DN_FRAG_U;
#pragma unroll
        for (int i = 0; i < 4; ++i) { const int fidx = 4 * w + i, isQ = fidx >> 4, ff = fidx & 15, mt = ff >> 2, ks = ff & 3; const int row = 16 * mt + c16;
            const LAS bf16* src = rm + (isQ ? 0 : 8192) + row * 128 + 32 * ks + 4 * q4;
            const v2u lo = *(const LAS v2u*)src, hi = *(const LAS v2u*)(src + 16); const v4u val = {lo.x, lo.y, hi.x, hi.y};
            *(v4u*)(fr_u + (isQ * 16 + ff) * 1024 + lane * 16) = val; *(LAS v4u*)(lds + FB + (isQ * 16 + ff) * 1024 + lane * 16) = val; }
#pragma unroll
        for (int i = 0; i < 2; ++i) { const int f = 2 * w + i, mt8 = f >> 1, ks = f & 1; const int dim = 16 * mt8 + c16; unsigned short e[8];
#pragma unroll
            for (int j = 0; j < 8; ++j) e[j] = rm[8192 + (32 * ks + pi_q(q4, j)) * 128 + dim];
            const v4u val = {(unsigned)e[0] | ((unsigned)e[1] << 16), (unsigned)e[2] | ((unsigned)e[3] << 16), (unsigned)e[4] | ((unsigned)e[5] << 16), (unsigned)e[6] | ((unsigned)e[7] << 16)};
            *(v4u*)(fr_u + (32 + f) * 1024 + lane * 16) = val; }
        { unsigned short e[16];
#pragma unroll
          for (int mt = 0; mt < 4; ++mt)
#pragma unroll
              for (int r = 0; r < 4; ++r) e[mt * 4 + r] = rm[16384 + (16 * mt + 4 * q4 + r) * 128 + 16 * w + c16];
          v4u a = {(unsigned)e[0] | ((unsigned)e[1] << 16), (unsigned)e[2] | ((unsigned)e[3] << 16), (unsigned)e[4] | ((unsigned)e[5] << 16), (unsigned)e[6] | ((unsigned)e[7] << 16)};
          v4u b = {(unsigned)e[8] | ((unsigned)e[9] << 16), (unsigned)e[10] | ((unsigned)e[11] << 16), (unsigned)e[12] | ((unsigned)e[13] << 16), (unsigned)e[14] | ((unsigned)e[15] << 16)};
          v4u* dst = (v4u*)(VACC + (((size_t)ui * 8 + w) * 64 + lane) * 16); dst[0] = a; dst[1] = b; }
        if (w < 2) { const int dir = w; const float* sm = SMALL + (size_t)(tok0 + lane) * 32;
            const float beta = 1.0f / (1.0f + __expf(-sm[dir * 8 + h])); const float al = dir ? P.a_log_b[h] : P.a_log_f[h], db = dir ? P.dt_b[h] : P.dt_f[h];
            const float xx = sm[16 + dir * 8 + h] + db; const float sp = (xx > 20.f) ? xx : __logf(1.0f + __expf(xx)); const float gg = -__expf(al) * sp;
            float gc = gg;
#pragma unroll
            for (int o = 1; o < 64; o <<= 1) { const float tt = dir ? __shfl_down(gc, o) : __shfl_up(gc, o); const bool okk = dir ? (lane + o < 64) : (lane >= o); if (okk) gc += tt; }
            const float glast = __shfl(gc, dir ? 0 : 63);
            gv[dir * 128 + lane] = gc; gv[dir * 128 + 64 + lane] = beta;
            float* vec = VEC + ((size_t)ui * 2 + dir) * DN_VEC_UD; const float eg = __expf(gc);
            vec[lane] = beta; vec[64 + lane] = beta * eg; vec[128 + lane] = eg; vec[192 + lane] = __expf(glast - gc); if (lane == 0) vec[256] = __expf(glast); }
        __syncthreads();
#pragma unroll
        for (int i = 0; i < 4; ++i) { const int t4 = 4 * w + i, isQK = t4 >> 4, tt = t4 & 15, mt = tt >> 2, nt = tt & 3; pg8::f32x4 acc = {0.f, 0.f, 0.f, 0.f};
#pragma unroll
            for (int ks = 0; ks < 4; ++ks) { const bf16x8_t a = *(const LAS bf16x8_t*)(lds + FB + (isQK * 16 + mt * 4 + ks) * 1024 + lane * 16), b = *(const LAS bf16x8_t*)(lds + FB + (nt * 4 + ks) * 1024 + lane * 16);
                acc = __builtin_amdgcn_mfma_f32_16x16x32_bf16(a, b, acc, 0, 0, 0); }
#pragma unroll
            for (int r = 0; r < 4; ++r) mm[isQK * 4096 + (16 * mt + 4 * q4 + r) * 64 + 16 * nt + c16] = acc[r]; }
        __syncthreads();
        unsigned char* ti_u = TI + (size_t)ui * 2 * DN_TI_UD;
#pragma unroll
        for (int k2 = 0; k2 < 2; ++k2) { const int task = tid + 512 * k2, dir = task >> 9, f = (task >> 6) & 7, mt = f >> 1, ks = f & 1; const int i = 16 * mt + c16; const float gci = gv[dir * 128 + i]; float e[8];
#pragma unroll
            for (int j8 = 0; j8 < 8; ++j8) { const int j = 32 * ks + pi_q(q4, j8); const bool incl = dir ? (i <= j) : (i >= j);
#ifdef PROBE_NOMM
 e[j8] = incl ? 0.01f : 0.f; }
#else
 e[j8] = incl ? mm[4096 + i * 64 + j] * __expf(gci - gv[dir * 128 + j]) : 0.f; }
#endif

            const v4u val = {cvt_pk_bf16(e[0], e[1]), cvt_pk_bf16(e[2], e[3]), cvt_pk_bf16(e[4], e[5]), cvt_pk_bf16(e[6], e[7])};
            *(v4u*)(ti_u + dir * DN_TI_UD + (8 + f) * 1024 + lane * 16) = val; }
        f32x4 lpv[4];
#pragma unroll
        for (int k4 = 0; k4 < 4; ++k4) { const int vi = tid + 512 * k4, dir = vi >> 10, ip = (vi >> 4) & 63, p = (vi >> 2) & 3, jj4 = vi & 3; const int i = dir ? 63 - ip : ip; const float gci = gv[dir * 128 + i], bi = gv[dir * 128 + 64 + i];
#pragma unroll
            for (int e = 0; e < 4; ++e) { const int jp = 16 * jj4 + 4 * e + p; const int j = dir ? 63 - jp : jp; lpv[k4][e] = (jp < ip) ? bi * mm[i * 64 + j] * __expf(gci - gv[dir * 128 + j]) : 0.f; } }
        __syncthreads();
#pragma unroll
        for (int k4 = 0; k4 < 4; ++k4) { const int vi = tid + 512 * k4; *(LAS f32x4*)(lp + vi * 4) = lpv[k4]; }
        __syncthreads();
        { const int dir = w >> 2, cc = (w & 3) * 16 + (lane >> 2), p = lane & 3; float t[16];
#pragma unroll
          for (int jj = 0; jj < 16; ++jj) t[jj] = 0.f;
#pragma unroll
          for (int ip = 0; ip < 64; ++ip) { float part = 0.f;
#pragma unroll
              for (int jj4 = 0; jj4 < (ip + 15) / 16; ++jj4) { const f32x4 l4 = *(const LAS f32x4*)(lp + ((dir * 64 + ip) * 4 + p) * 16 + jj4 * 4);
#pragma unroll
                  for (int e = 0; e < 4; ++e) if (16 * jj4 + 4 * e < ip) part += l4[e] * t[4 * jj4 + e]; }
              part += dpp_xor1(part); part += dpp_xor2(part);
              const float val = ((cc == ip) ? 1.0f : 0.0f) - part; if (p == (ip & 3)) t[ip >> 2] = val; }
          __syncthreads();
#pragma unroll
          for (int jj = 0; jj < 16; ++jj) tm[(dir * 64 + 4 * jj + p) * 64 + cc] = t[jj]; }
        __syncthreads();
#pragma unroll
        for (int k2 = 0; k2 < 2; ++k2) { const int task = tid + 512 * k2, dir = task >> 9, f = (task >> 6) & 7, mt = f >> 1, ks = f & 1; const int i = 16 * mt + c16; float e[8];
#pragma unroll
            for (int j8 = 0; j8 < 8; ++j8) { const int j = 32 * ks + pi_q(q4, j8); e[j8] = dir ? tm[(64 + 63 - i) * 64 + 63 - j] : tm[i * 64 + j]; }
            const v4u val = {cvt_pk_bf16(e[0], e[1]), cvt_pk_bf16(e[2], e[3]), cvt_pk_bf16(e[4], e[5]), cvt_pk_bf16(e[6], e[7])};
            *(v4u*)(ti_u + dir * DN_TI_UD + f * 1024 + lane * 16) = val; }
        __syncthreads();
    }
}

__device__ __forceinline__ bf16x8_t pack_acc2(const pg8::f32x4& a, const pg8::f32x4& b) { const v4u v = {cvt_pk_bf16(a[0], a[1]), cvt_pk_bf16(a[2], a[3]), cvt_pk_bf16(b[0], b[1]), cvt_pk_bf16(b[2], b[3])}; return __builtin_bit_cast(bf16x8_t, v); }
__device__ __forceinline__ void phase_scan(const unsigned char* FRAG, const unsigned char* TI, const bf16* VACC, const float* VEC, bf16* OF, bf16* OB, int S, unsigned char* lds_, int bid, int G, int tid) {
    LAS unsigned char* lds = (LAS unsigned char*)lds_;
    const int lane = tid & 63, w = __builtin_amdgcn_readfirstlane(tid >> 6), c16 = lane & 15, q4 = lane >> 4;
    const int NCH = S >> 6, nchain = (TG / S) * 16;
    constexpr int BUFB = 65536;
    for (int chain = bid; chain < nchain; chain += G) {
        const int dir = chain & 1, h = (chain >> 1) & 7, b = chain >> 4;
        bf16* O = dir ? OB : OF;
        pg8::f32x4 Sacc[8];
#pragma unroll
        for (int T8 = 0; T8 < 8; ++T8) Sacc[T8] = (pg8::f32x4){0.f, 0.f, 0.f, 0.f};
#define DN_STAGE(bufoff, nn) do { const size_t ui_ = ((size_t)(b * NCH + (nn)) * 8 + h); \
            for (int pc = w; pc < 64; pc += NWAVES) { const unsigned char* src = (pc < 48) ? FRAG + ui_ * DN_FRAG_U + pc * 1024 : TI + (ui_ * 2 + dir) * DN_TI_UD + (pc - 48) * 1024; \
                __builtin_amdgcn_global_load_lds((const unsigned*)(src + lane * 16), (LAS unsigned*)(lds + (bufoff) + pc * 1024), 16, 0, 0); } } while (0)
        int n = dir ? NCH - 1 : 0;
        DN_STAGE(0, n);
        v4u vcur0, vcur1; { const v4u* vp = (const v4u*)(VACC + ((((size_t)(b * NCH + n) * 8 + h) * 8 + w) * 64 + lane) * 16); vcur0 = vp[0]; vcur1 = vp[1]; }
        __syncthreads();
        int buf = 0;
        for (int step = 0; step < NCH; ++step) {
            const int nn = dir ? n - 1 : n + 1; v4u vn0 = vcur0, vn1 = vcur1;
            if (step + 1 < NCH) { DN_STAGE((buf ^ 1) * BUFB, nn); const v4u* vp = (const v4u*)(VACC + ((((size_t)(b * NCH + nn) * 8 + h) * 8 + w) * 64 + lane) * 16); vn0 = vp[0]; vn1 = vp[1]; }
            const LAS unsigned char* B0 = lds + buf * BUFB; const float* vec = VEC + (((size_t)(b * NCH + n) * 8 + h) * 2 + dir) * DN_VEC_UD;
#define DN_A(off, fi) (*(const LAS bf16x8_t*)(B0 + (off) + (fi) * 1024 + lane * 16))
            bf16x8_t Sb[4];
#pragma unroll
            for (int ks = 0; ks < 4; ++ks) Sb[ks] = pack_acc2(Sacc[2 * ks], Sacc[2 * ks + 1]);
            pg8::f32x4 X1[4], X2[4];
#pragma unroll
            for (int mt = 0; mt < 4; ++mt) { X1[mt] = (pg8::f32x4){0.f, 0.f, 0.f, 0.f}; X2[mt] = X1[mt];
#pragma unroll
                for (int ks = 0; ks < 4; ++ks) { X1[mt] = __builtin_amdgcn_mfma_f32_16x16x32_bf16(DN_A(0, mt * 4 + ks), Sb[ks], X1[mt], 0, 0, 0); X2[mt] = __builtin_amdgcn_mfma_f32_16x16x32_bf16(DN_A(16384, mt * 4 + ks), Sb[ks], X2[mt], 0, 0, 0); } }
            const unsigned vw[8] = {vcur0.x, vcur0.y, vcur0.z, vcur0.w, vcur1.x, vcur1.y, vcur1.z, vcur1.w};
            pg8::f32x4 Y[4];
#pragma unroll
            for (int mt = 0; mt < 4; ++mt) { const pg8::f32x4 be = *(const pg8::f32x4*)(vec + 16 * mt + 4 * q4), aa = *(const pg8::f32x4*)(vec + 64 + 16 * mt + 4 * q4);
                const pg8::f32x4 vv = {bflo(vw[2 * mt]), bfhi(vw[2 * mt]), bflo(vw[2 * mt + 1]), bfhi(vw[2 * mt + 1])}; Y[mt] = be * vv - aa * X1[mt]; }
            const bf16x8_t Yb0 = pack_acc2(Y[0], Y[1]), Yb1 = pack_acc2(Y[2], Y[3]);
            pg8::f32x4 vn[4];
#pragma unroll
#ifdef PROBE_NOT
            for (int mt = 0; mt < 4; ++mt) vn[mt] = Y[mt];
#else
            for (int mt = 0; mt < 4; ++mt) { vn[mt] = __builtin_amdgcn_mfma_f32_16x16x32_bf16(DN_A(49152, mt * 2), Yb0, (pg8::f32x4){0.f, 0.f, 0.f, 0.f}, 0, 0, 0); vn[mt] = __builtin_amdgcn_mfma_f32_16x16x32_bf16(DN_A(49152, mt * 2 + 1), Yb1, vn[mt], 0, 0, 0); }
#endif
            const bf16x8_t vb0 = pack_acc2(vn[0], vn[1]), vb1 = pack_acc2(vn[2], vn[3]);
            pg8::f32x4 dd[4];
#pragma unroll
            for (int mt = 0; mt < 4; ++mt) { const pg8::f32x4 eg = *(const pg8::f32x4*)(vec + 128 + 16 * mt + 4 * q4); dd[mt] = *(const pg8::f32x4*)(vec + 192 + 16 * mt + 4 * q4);
#ifdef PROBE_NOIT
                pg8::f32x4 o = eg * X2[mt] + vn[mt];
#else
                pg8::f32x4 o = eg * X2[mt]; o = __builtin_amdgcn_mfma_f32_16x16x32_bf16(DN_A(57344, mt * 2), vb0, o, 0, 0, 0); o = __builtin_amdgcn_mfma_f32_16x16x32_bf16(DN_A(57344, mt * 2 + 1), vb1, o, 0, 0, 0);
#endif
                bf16* op = O + ((size_t)(b * S + n * 64 + 16 * mt + 4 * q4)) * 1024 + h * 128 + 16 * w + c16;
#pragma unroll
                for (int r = 0; r < 4; ++r) op[(size_t)r * 1024] = (bf16)(cvt_pk_bf16(o[r], 0.f) & 0xffffu); }
            const bf16x8_t db0 = pack_acc2(dd[0] * vn[0], dd[1] * vn[1]), db1 = pack_acc2(dd[2] * vn[2], dd[3] * vn[3]);
            const float dec = vec[256];
#pragma unroll
            for (int T8 = 0; T8 < 8; ++T8) { pg8::f32x4 a = Sacc[T8] * dec; a = __builtin_amdgcn_mfma_f32_16x16x32_bf16(DN_A(32768, T8 * 2), db0, a, 0, 0, 0); a = __builtin_amdgcn_mfma_f32_16x16x32_bf16(DN_A(32768, T8 * 2 + 1), db1, a, 0, 0, 0); Sacc[T8] = a; }
            __syncthreads();
            buf ^= 1; n = nn; vcur0 = vn0; vcur1 = vn1;
        }
#undef DN_A
#undef DN_STAGE
    }
}

__device__ __forceinline__ void phase_combine(const Ptrs& P, const bf16* OF, const bf16* OB, const bf16* Z, bf16* DNOUT, int gw, int NGW, int lane) {
    for (int item = gw; item < TG * 8; item += NGW) { const size_t off = (size_t)item * 128 + lane * 2;
        const unsigned a = *(const unsigned*)(OF + off), b = *(const unsigned*)(OB + off), z = *(const unsigned*)(Z + off);
#ifdef PROBE_NODN
        const float o0 = 0.5f + 0.f * bflo(z), o1 = 0.25f;
#else
        const float o0 = bflo(a) + bflo(b), o1 = bfhi(a) + bfhi(b);
#endif
        const float ss = wave_sum(o0 * o0 + o1 * o1); const float rs = rsqrtf(ss * (1.0f / 128.0f) + EPS);
        const float y0 = o0 * rs * P.out_norm_g[lane * 2] * siluf_(bflo(z)), y1 = o1 * rs * P.out_norm_g[lane * 2 + 1] * siluf_(bfhi(z));
        *(unsigned*)(DNOUT + off) = cvt_pk_bf16(y0, y1); }
}

__device__ __forceinline__ float gelu_erf(float v) { const pg8::f32x2 r = pg8::gelu_pk((pg8::f32x2){v, v}); return r.x; }
__device__ __forceinline__ void phase_act_naive(const Ptrs& P, const bf16* UP, bf16* ACT, int S, int gt, int NGT) {
    for (int item = gt; item < TG * (DFF / 8); item += NGT) { const int tok = item / (DFF / 8), c = (item % (DFF / 8)) * 8; const int pos = tok % S;
        float a[8], vv[8];
#pragma unroll
        for (int e = 0; e < 8; ++e) a[e] = P.ffn_conv_b[c + e];
#pragma unroll
        for (int i = 0; i < 3; ++i) { const int p2 = pos + i - 1; if (p2 >= 0 && p2 < S) { float g[8]; load8bf(UP + (size_t)(tok + i - 1) * NUP + c, g);
#pragma unroll
                for (int e = 0; e < 8; ++e) a[e] += g[e] * P.ffn_conv_w[i * DFF + c + e]; } }
        load8bf(UP + (size_t)tok * NUP + DFF + c, vv);
#pragma unroll
        for (int e = 0; e < 8; ++e) a[e] = gelu_erf(a[e]) * vv[e];
        v4u w; w.x = cvt_pk_bf16(a[0], a[1]); w.y = cvt_pk_bf16(a[2], a[3]); w.z = cvt_pk_bf16(a[4], a[5]); w.w = cvt_pk_bf16(a[6], a[7]);
        *(v4u*)(ACT + (size_t)tok * DFF + c) = w; }
}

__device__ __forceinline__ void phase_final(const Ptrs& P, const float* ssq3, int gw, int NGW, int lane) {
    for (int m = gw; m < NTOK; m += NGW) { const float rs = rsqrtf(ssq3[m] * (1.0f / 1024.0f) + EPS); f32x4* xr = (f32x4*)(P.out + (size_t)m * D) + lane; const f32x4* gr = (const f32x4*)P.norm_final_g + lane;
#pragma unroll
        for (int j = 0; j < 4; ++j) { f32x4 y = xr[64 * j] * rs * gr[64 * j];
#ifdef PROBE_NANFIX
            for (int e = 0; e < 4; ++e) if (!(fabsf(y[e]) < 1e30f)) y[e] = 0.f;
#endif
            xr[64 * j] = y; } }
}

typedef __attribute__((address_space(1))) unsigned gu32;
#define RLX_AGENT __ATOMIC_RELAXED, __HIP_MEMORY_SCOPE_AGENT
#define XB_TMO      128
#define XB_XCNT(j)  (256  + 64 * (j))
#define XB_XSUB(j)  (1280 + 64 * (j))
#define XB_XGEN(j)  (2304 + 64 * (j))
#define XB_TOP      3328
#define XB_TOPGEN   3392
#define XCD_BAR_WORDS 3456
#define XB_SPIN_CAP (1u << 18)

__device__ __forceinline__ unsigned xb_ld(unsigned* p)              { return __hip_atomic_load(p, __ATOMIC_RELAXED, __HIP_MEMORY_SCOPE_AGENT); }
__device__ __forceinline__ unsigned xb_add(unsigned* p, unsigned v) { return __hip_atomic_fetch_add(p, v, __ATOMIC_RELAXED, __HIP_MEMORY_SCOPE_AGENT); }
__device__ __forceinline__ unsigned xb_xcc_id() { return (unsigned)__builtin_amdgcn_s_getreg((3 << 11) | 20) & 0xFu; }
#define XB_SPIN(cond, bar) do { unsigned _sp = 0; while (cond) { __builtin_amdgcn_s_sleep(1); \
    if ((++_sp & 255u) == 0u) { if (xb_ld(&(bar)[XB_TMO])) break; if (_sp > XB_SPIN_CAP) { atomicAdd(&(bar)[XB_TMO], 1u); break; } } } } while (0)

struct XcdBarrier {
    unsigned* bar; unsigned x;
    volatile LAS unsigned* st;
};

__device__ __forceinline__ XcdBarrier xcd_barrier_post(unsigned* bar, volatile LAS unsigned* st, int tid) {
    XcdBarrier b; b.bar = bar; b.x = xb_xcc_id(); b.st = st;
    if (tid == 0) (void)xb_add(&bar[XB_XCNT(b.x)], 1u);
    return b;
}
__device__ __forceinline__ void xcd_barrier_complete(unsigned* bar, unsigned x, unsigned& nloc, unsigned& nx) {
    const unsigned G = gridDim.x * gridDim.y * gridDim.z;
    unsigned sum, cnt, mine, sp = 0u;
    for (;;) {
        sum = 0u; cnt = 0u; mine = 0u;
#pragma unroll
        for (unsigned j = 0; j < 16; ++j) { const unsigned c = xb_ld(&bar[XB_XCNT(j)]); sum += c; cnt += (c > 0u) ? 1u : 0u; mine = (j == x) ? c : mine; }
        if (sum == G) break;
        __builtin_amdgcn_s_sleep(1);
        if ((++sp & 255u) == 0u) { if (xb_ld(&bar[XB_TMO])) break; if (sp > XB_SPIN_CAP) { atomicAdd(&bar[XB_TMO], 1u); break; } }
    }
    nloc = mine > 0u ? mine : 1u; nx = cnt > 0u ? cnt : 1u;
}

__device__ __forceinline__ void xcd_barrier(const XcdBarrier& b, int tid) {
    asm volatile("s_waitcnt vmcnt(0)" ::: "memory");
    __syncthreads();
    if (tid == 0) {
        unsigned* bar = b.bar;
        __builtin_amdgcn_s_waitcnt(0);
        unsigned nloc = b.st[0], nx = b.st[1];
        if (nloc == 0u) { xcd_barrier_complete(bar, b.x, nloc, nx); b.st[0] = nloc; b.st[1] = nx; }
        const unsigned old = xb_add(&bar[XB_XSUB(b.x)], 1u);
        const unsigned gen = old / nloc;
        if (old + 1u == (gen + 1u) * nloc) {
            __builtin_amdgcn_fence(__ATOMIC_RELEASE, "agent");
            asm volatile("s_waitcnt vmcnt(0)" ::: "memory");
            const unsigned og = xb_add(&bar[XB_TOP], 1u);
            const unsigned tg = og / nx;
            if (og + 1u == (tg + 1u) * nx) xb_add(&bar[XB_TOPGEN], 1u);
            else XB_SPIN(xb_ld(&bar[XB_TOPGEN]) == tg, bar);
            __builtin_amdgcn_fence(__ATOMIC_ACQUIRE, "agent");
            xb_add(&bar[XB_XGEN(b.x)], 1u);
            asm volatile("s_waitcnt vmcnt(0)" ::: "memory");
        } else {
            XB_SPIN(xb_ld(&bar[XB_XGEN(b.x)]) == gen, bar);
            __builtin_amdgcn_fence(__ATOMIC_ACQUIRE, "agent");
            asm volatile("s_waitcnt vmcnt(0)" ::: "memory");
        }
    }
    __syncthreads();
}

#define EN(k) (ONLYK < 0 || ONLYK == (k))
constexpr int LDS_BYTES = 147456;
constexpr int CW_BAR = 4096;
constexpr int STEPS_PER_GROUP = 12, NSTEPS = 1 + NGROUPS * STEPS_PER_GROUP + 1;

#define LDP(i) ((const float*)ap->in[i])
#define MKP() Ptrs P; P.x_p = LDP(0); P.x_s = LDP(1); P.norm_mix_g = LDP(2); P.w_in = LDP(3); P.conv_w = LDP(4); P.a_log_f = LDP(5); P.a_log_b = LDP(6); P.dt_f = LDP(7); P.dt_b = LDP(8); \
        P.out_norm_g = LDP(9); P.w_a = LDP(10); P.w_b = LDP(11); P.w_out = LDP(12); P.norm_ffn_g = LDP(13); P.w_up = LDP(14); P.ffn_conv_w = LDP(15); P.ffn_conv_b = LDP(16); P.w_down = LDP(17); P.norm_final_g = LDP(18); \
        P.out = ap->out; P.ws = ap->ws;
#define WSP ((unsigned char*)ap->ws)
#define ARP (WSP + WS_ARENA)
#define Win ((bf16*)(WSP + WS_WIN))
#define Wup ((bf16*)(WSP + WS_WUP))
#define Wdn ((bf16*)(WSP + WS_WDOWN))
#define Wout ((bf16*)(WSP + WS_WOUT))
#define Wa ((bf16*)(WSP + WS_WA))
#define Wb ((bf16*)(WSP + WS_WB))
#define ropeC ((const float*)(WSP + WS_ROPE))
#define ropeS (ropeC + 4096 * 8)
#define ssq2 ((float*)(WSP + WS_CTL + CTL_SSQ2))
#define ssq3 ((float*)(WSP + WS_CTL + CTL_SSQ3))
#define XBg ((bf16*)(WSP + WS_XB))
#define rstd1 ((const float*)(WSP + WS_RSTD1) + t0)
#define ATT ((bf16*)(ARP + AR_ATT))
#define DNQ ((bf16*)(ARP + AR_DNQ))
#define Z ((bf16*)(ARP + AR_Z))
#define SMALL ((float*)(ARP + AR_SMALL))
#define AO ((bf16*)(ARP + AR_AO))
#define MIX ((bf16*)(ARP + AR_MIX))
#define PO ((bf16*)(ARP + AR_PO))
#define LSE2 ((float*)(ARP + AR_LSE))
#define FRAGP ((unsigned char*)(ARP + AR_FRAG))
#define VACCP ((bf16*)(ARP + AR_VACC))
#define TIP ((unsigned char*)(ARP + AR_TI))
#define VECP ((float*)(ARP + AR_VEC))
#define OF ((bf16*)(ARP + AR_OF))
#define OB ((bf16*)(ARP + AR_OB))
#define DNOUT ((bf16*)(ARP + AR_DNOUT))
#define Gt ((bf16*)(ARP + AR_G))
#define YA ((float*)(ARP + AR_YA))
#define UP ((bf16*)(ARP + AR_UP))
#define ACT ((bf16*)(ARP + AR_ACT))
#define OUTg ((float*)ap->out + (size_t)t0 * D)
#define STEP_PRE() int tid = wave_u * 64 + (int)__builtin_amdgcn_mbcnt_hi(~0u, __builtin_amdgcn_mbcnt_lo(~0u, 0u)), bid = blockIdx.x; typedef const __attribute__((address_space(4))) Args* kargp_t; kargp_t ap = (kargp_t)__builtin_amdgcn_kernarg_segment_ptr(); asm volatile("" : "+v"(tid), "+s"(bid), "+s"(ap)); \
        const int lane = tid & 63, wave = tid >> 6, gw = bid * NWAVES + wave, gt = bid * NTHREADS + tid; (void)lane; (void)wave; (void)gw; (void)gt;
template <int ONLYK, int STEP> __device__ __forceinline__ void run_step(unsigned char* lds, int G, int NGW, int NGT, int wave_u) {
    STEP_PRE();
    constexpr int g = (STEP - 1) / STEPS_PER_GROUP, k = (STEP - 1) % STEPS_PER_GROUP; constexpr int t0 = g * TG; constexpr int S = (g < 2) ? 2048 : 4096;
    if constexpr (STEP == 0) {
        if constexpr (EN(100)) { MKP(); phase_prologue(P, lds, bid, G, tid); }
    } else if constexpr (STEP == NSTEPS - 1) {
        if constexpr (EN(101)) { MKP(); phase_final(P, ssq3, gw, NGW, lane); }
    } else {
            if constexpr (k == 0) {
if constexpr (EN(0)) {
                pg8::Gemm gm{XBg, Win, TG, NPA, D}; pg8::StaticOrder So; So.init(TG, NPA, G, bid); pg8::EpiProjA E{ATT, DNQ, Z, SMALL, rstd1, ropeC, ropeS, S - 1};
                pg8::gemm_phase<pg8::EpiProjA, pg8::StaticOrder, true, true>((LAS unsigned char*)lds, gm, So, E, tid);
}
            } else if constexpr (k == 1) {
if constexpr (EN(1)) {
                phase_attn(ATT, PO, LSE2, S, lds, bid, G, tid);
#if defined(DUP_PHASE) && DUP_PHASE == 1
 phase_attn(ATT, PO, LSE2, S, lds, bid, G, tid);
#endif
}
            } else if constexpr (k == 2) {
if constexpr (EN(2)) {
                phase_attn_combine(PO, LSE2, AO, gt, NGT); MKP(); phase_dna(P, DNQ, SMALL, FRAGP, VACCP, TIP, VECP, S, lds, bid, G, tid);
#if defined(DUP_PHASE) && DUP_PHASE == 2
 phase_dna(P, DNQ, SMALL, FRAGP, VACCP, TIP, VECP, S, lds, bid, G, tid);
#endif
}
            } else if constexpr (k == 3) {
if constexpr (EN(3)) {
                phase_scan(FRAGP, TIP, VACCP, VECP, OF, OB, S, lds, bid, G, tid);
#if defined(DUP_PHASE) && DUP_PHASE == 3
 phase_scan(FRAGP, TIP, VACCP, VECP, OF, OB, S, lds, bid, G, tid);
#endif
}
            } else if constexpr (k == 4) {
if constexpr (EN(4)) {
                MKP(); phase_combine(P, OF, OB, Z, DNOUT, gw, NGW, lane);
}
            } else if constexpr (k == 5) {
if constexpr (EN(5)) {
                pg8::Gemm gm{XBg, Win + (size_t)NPA * D, TG, 2048, D}; pg8::StaticOrder So; So.init(TG, 2048, G, bid); pg8::EpiGates E{Gt, rstd1};
                pg8::gemm_phase<pg8::EpiGates, pg8::StaticOrder, true, true>((LAS unsigned char*)lds, gm, So, E, tid);
}
            } else if constexpr (k == 6) {
if constexpr (EN(6)) {
                pg8::Gemm gm{AO, Wa, TG, D, 512}; pg8::StaticOrder So; So.init(TG, D, G, bid); pg8::EpiF32 E{YA, D};
                pg8::gemm_phase<pg8::EpiF32, pg8::StaticOrder, true, true>((LAS unsigned char*)lds, gm, So, E, tid);
}
            } else if constexpr (k == 7) {
if constexpr (EN(7)) {
                pg8::Gemm gm{DNOUT, Wb, TG, D, D}; pg8::StaticOrder So; So.init(TG, D, G, bid); pg8::EpiMix E{Gt, YA, MIX};
                pg8::gemm_phase<pg8::EpiMix, pg8::StaticOrder, true, true>((LAS unsigned char*)lds, gm, So, E, tid);
}
            } else if constexpr (k == 8) {
if constexpr (EN(8)) {
                pg8::Gemm gm{MIX, Wout, TG, D, D}; pg8::StaticOrder So; So.init(TG, D, G, bid);
                const float* RES = (g < 2) ? LDP(0) + (size_t)t0 * D : LDP(1); pg8::EpiRes E{RES, OUTg, XBg, ssq2 + t0};
                pg8::gemm_phase<pg8::EpiRes, pg8::StaticOrder, true, true>((LAS unsigned char*)lds, gm, So, E, tid);
}
            } else if constexpr (k == 9) {
if constexpr (EN(9)) {
                pg8::Gemm gm{XBg, Wup, TG, NUP, D}; pg8::StaticOrder So; So.init(TG, NUP, G, bid); pg8::EpiUp E{UP, ssq2 + t0};
                pg8::gemm_phase<pg8::EpiUp, pg8::StaticOrder, true, true>((LAS unsigned char*)lds, gm, So, E, tid);
}
            } else if constexpr (k == 10) {
if constexpr (EN(10)) {
                MKP(); phase_act_naive(P, UP, ACT, S, gt, NGT);
#if defined(DUP_PHASE) && DUP_PHASE == 4
 phase_act_naive(P, UP, ACT, S, gt, NGT);
#endif
 if constexpr (g + 1 < NGROUPS) phase_xb(P, g + 1, gw, NGW, lane);
}
            } else {
if constexpr (EN(11)) {
                pg8::Gemm gm{ACT, Wdn, TG, D, DFF}; pg8::StaticOrder So; So.init(TG, D, G, bid); pg8::EpiRes E{OUTg, OUTg, nullptr, ssq3 + t0};
                pg8::gemm_phase<pg8::EpiRes, pg8::StaticOrder, true, true>((LAS unsigned char*)lds, gm, So, E, tid);
}
            }
    }
}
template <int ONLYK, int STEP> __device__ __forceinline__ void run_steps(unsigned char* lds, cg::grid_group& grid, const XcdBarrier& xb, int lo, int hi, int G, int NGW, int NGT, int wave_u) {
    if constexpr (STEP < NSTEPS) {
        if (lo <= STEP && STEP < hi) { run_step<ONLYK, STEP>(lds, G, NGW, NGT, wave_u);
            if (STEP + 1 < hi) {
#if defined(DUP_PHASE) && DUP_PHASE == 5
                grid.sync();
#endif
                if constexpr (STEP == 0) grid.sync();
                else { const int tid = wave_u * 64 + (int)__builtin_amdgcn_mbcnt_hi(~0u, __builtin_amdgcn_mbcnt_lo(~0u, 0u)); xcd_barrier(xb, tid); } } }
        run_steps<ONLYK, STEP + 1>(lds, grid, xb, lo, hi, G, NGW, NGT, wave_u);
    }
}
template <int ONLYK> __global__ void __launch_bounds__(NTHREADS, 2) fwd(Args args) {
    extern __shared__ __attribute__((aligned(16))) unsigned char lds[];
    const int G = gridDim.x, NGW = G * NWAVES, NGT = G * NTHREADS;
    cg::grid_group grid = cg::this_grid();
    const int wave_u = __builtin_amdgcn_readfirstlane((int)threadIdx.x >> 6);
    volatile LAS unsigned* st = (volatile LAS unsigned*)((LAS unsigned char*)lds + LDS_BYTES - 16);
    if (threadIdx.x < 4) st[threadIdx.x] = 0u;
    __syncthreads();
    const XcdBarrier xb = xcd_barrier_post((unsigned*)(args.ws + WS_CTL) + CW_BAR, st, (int)threadIdx.x);
    run_steps<ONLYK, 0>(lds, grid, xb, args.lo, args.hi, G, NGW, NGT, wave_u);
}

#ifndef ONE_LAUNCH
#define ONE_LAUNCH 1
#endif
#if !ONE_LAUNCH
template <int KK> static void launch_kind(int grid, hipStream_t stream, Args a) { hipLaunchKernelGGL(fwd<KK>, dim3(grid), dim3(NTHREADS), LDS_BYTES, stream, a); }
template <int KK> static bool set_lds() { return hipFuncSetAttribute((const void*)fwd<KK>, hipFuncAttributeMaxDynamicSharedMemorySize, LDS_BYTES) == hipSuccess; }
#endif
extern "C" void kernel_launch(void* const* d_in, const int* in_sizes, int n_in, void* d_out, int out_size, void* d_ws, size_t ws_size, hipStream_t stream) {
    static int grid = 0;
    if (grid == 0) {
        if (n_in != 19 || ws_size < WS_END) { fprintf(stderr, "kernel_launch: unexpected n_in %d / ws_size %zu (need %zu)\n", n_in, ws_size, (size_t)WS_END); grid = -1; return; }
        int dev = 0, cus = 0; (void)hipGetDevice(&dev); (void)hipDeviceGetAttribute(&cus, hipDeviceAttributeMultiprocessorCount, dev);
#if ONE_LAUNCH
        if (hipFuncSetAttribute((const void*)fwd<-1>, hipFuncAttributeMaxDynamicSharedMemorySize, LDS_BYTES) != hipSuccess) { fprintf(stderr, "kernel_launch: hipFuncSetAttribute failed\n"); grid = -1; return; }
        int per_cu = 0;
        if (hipOccupancyMaxActiveBlocksPerMultiprocessor(&per_cu, (const void*)fwd<-1>, NTHREADS, LDS_BYTES) != hipSuccess || per_cu < 1) { fprintf(stderr, "kernel_launch: occupancy query failed / %d blocks per CU\n", per_cu); grid = -1; return; }
        grid = cus;
#else
        bool ok = set_lds<0>() && set_lds<1>() && set_lds<2>() && set_lds<3>() && set_lds<4>() && set_lds<5>() && set_lds<6>() && set_lds<7>() && set_lds<8>() && set_lds<9>() && set_lds<10>() && set_lds<11>() && set_lds<100>() && set_lds<101>();
        if (!ok) { fprintf(stderr, "kernel_launch: hipFuncSetAttribute failed\n"); grid = -1; return; }
        grid = cus > 0 ? cus : 256;
#endif
    }
    if (grid < 0) return;
    (void)hipMemsetAsync((char*)d_ws + WS_CTL, 0, CTL_BYTES, stream);
    Args a{};
    for (int i = 0; i < 19; ++i) a.in[i] = (const float*)d_in[i];
    a.out = (float*)d_out; a.ws = (unsigned char*)d_ws;
#if ONE_LAUNCH
    a.lo = 0; a.hi = NSTEPS; void* kargs[] = {&a};
    hipError_t e = hipLaunchCooperativeKernel((const void*)fwd<-1>, dim3(grid), dim3(NTHREADS), kargs, LDS_BYTES, stream);
    if (e != hipSuccess) fprintf(stderr, "cooperative launch failed: %s (grid %d)\n", hipGetErrorString(e), grid);
#else
    for (int s = 0; s < NSTEPS; ++s) { a.lo = s; a.hi = s + 1;
        if (s == 0) launch_kind<100>(grid, stream, a); else if (s == NSTEPS - 1) launch_kind<101>(grid, stream, a);
        else switch ((s - 1) % STEPS_PER_GROUP) {
            case 0: launch_kind<0>(grid, stream, a); break; case 1: launch_kind<1>(grid, stream, a); break; case 2: launch_kind<2>(grid, stream, a); break; case 3: launch_kind<3>(grid, stream, a); break;
            case 4: launch_kind<4>(grid, stream, a); break; case 5: launch_kind<5>(grid, stream, a); break; case 6: launch_kind<6>(grid, stream, a); break; case 7: launch_kind<7>(grid, stream, a); break;
            case 8: launch_kind<8>(grid, stream, a); break; case 9: launch_kind<9>(grid, stream, a); break; case 10: launch_kind<10>(grid, stream, a); break; default: launch_kind<11>(grid, stream, a); break; }
    }
#endif
}
```

```cpp
#include <hip/hip_runtime.h>
#include <hip/hip_cooperative_groups.h>
#include <cstdio>
#include <cstdint>
namespace cg = cooperative_groups;
namespace pg8 {
#define PG8_LAS __attribute__((address_space(3)))
typedef unsigned short bf16_t;
typedef short bf16x8 __attribute__((ext_vector_type(8)));
typedef float f32x4 __attribute__((ext_vector_type(4)));
typedef unsigned u32x4 __attribute__((ext_vector_type(4)));
constexpr int BM = 256, BK = 64, HALF = 128, HTB = HALF * BK * 2  , STAGE_BYTES = 8 * HTB, NXCD = 8, WGM = 8;

__host__ __device__ __forceinline__ int lds_byte(int r, int c) { const int st = (r >> 4) * 2 + (c >> 5), rr = r & 15, cc = c & 31, ob = rr * 64 + cc * 2; return st * 1024 + (ob ^ (((ob >> 9) & 1) << 5)); }
__host__ __device__ __forceinline__ void stage_rc(int b, int& R, int& C) { const int st = b / 1024, sb = b % 1024, swz = sb ^ (((sb >> 9) & 1) << 5); R = (st >> 1) * 16 + swz / 64; C = (st & 1) * 32 + (swz % 64) / 2; }
__host__ __device__ __forceinline__ int perm32(int rho) { const int n = rho >> 4, i = rho & 15; return 8 * (i >> 2) + 4 * n + (i & 3); }

struct Unit { int pm, pn; };
struct Gemm { const bf16_t* A; const bf16_t* Bt; int M, N, K; };

struct StaticOrder {
    int nM, nN, nwg, G, c;
    __host__ __device__ void init(int M, int N, int G_, int c_) { nM = M / BM; nN = N / BM; nwg = nM * nN; G = G_; c = c_; }
    __host__ __device__ bool next(int i, Unit& u) const {
        const long L = (long)i * G + c; if (L >= nwg) return false;
        int wgid = (int)L; { const int q = nwg / NXCD, r = nwg % NXCD, xcd = wgid % NXCD, off = wgid / NXCD; wgid = (xcd < r ? xcd * (q + 1) : r * (q + 1) + (xcd - r) * q) + off; }
        const int nig = WGM * nN, gid = wgid / nig, fm = gid * WGM, gsz = (nM - fm) < WGM ? (nM - fm) : WGM;
        u.pm = fm + ((wgid % nig) % gsz); u.pn = (wgid % nig) / gsz; return true;
    }
    __device__ __forceinline__ void a_ready(const Unit&) const {}
    __device__ __forceinline__ void done(const Unit&) const {}
};

typedef float f32x2_cv __attribute__((ext_vector_type(2))); typedef __bf16 bf16x2_cv __attribute__((ext_vector_type(2)));
__device__ __forceinline__ unsigned cvt_pk_bf16(float lo, float hi) { const f32x2_cv v = {lo, hi}; const bf16x2_cv b = __builtin_convertvector(v, bf16x2_cv); return __builtin_bit_cast(unsigned, b); }
typedef float f32x2 __attribute__((ext_vector_type(2)));
typedef unsigned u32x2 __attribute__((ext_vector_type(2)));
__device__ __forceinline__ float bflo(unsigned w) { return __uint_as_float(w << 16); }
__device__ __forceinline__ float bfhi(unsigned w) { return __uint_as_float(w & 0xffff0000u); }
__device__ __forceinline__ float sigmoidf_(float x) { return __builtin_amdgcn_rcpf(1.0f + __expf(-x)); }
constexpr float RMS_EPS = 1e-6f;
__device__ __forceinline__ f32x2 gelu_pk(f32x2 v) {
    const f32x2 av = __builtin_elementwise_abs(v), d = av * 0.2316418882f + 1.0f;
    f32x2 t; t.x = __builtin_amdgcn_rcpf(d.x); t.y = __builtin_amdgcn_rcpf(d.y);
    f32x2 q = t * 0.5307027145f + (-0.7265760135f); q = q * t + 0.7107068705f; q = q * t + (-0.142248368f); q = q * t + 0.127414796f; q = q * t;
    const f32x2 s = (v * v) * (-0.72134752044f);
    f32x2 e; e.x = __builtin_amdgcn_exp2f(s.x); e.y = __builtin_amdgcn_exp2f(s.y);
    const f32x2 m = v * (q * e), r = v - m;
    f32x2 o; o.x = v.x < 0.f ? m.x : r.x; o.y = v.y < 0.f ? m.y : r.y; return o;
}

struct EpiProjA {
    static constexpr bool PERM = true, AFTER_DRAIN = false;
    bf16_t* ATT; bf16_t* DNQ; bf16_t* Z; float* SMALL; const float* rstd; const float* ropeC; const float* ropeS; int smask;
    __device__ __forceinline__ void operator()(const f32x4 (&acc)[2][2][4][2], const Unit& u, int wr, int wc, int fr, int fq) const {
        const int row0 = u.pm * BM + wr * 64 + fr; const int pn = u.pn;
        bf16_t* base; int ldc, colt;
        if (pn < 18) { base = ATT; ldc = 4608; colt = pn * 256; } else if (pn < 30) { base = DNQ; ldc = 3072; colt = (pn - 18) * 256; } else { base = Z; ldc = 1024; colt = (pn - 30) * 256; }
        const int col0 = colt + wc * 32 + 8 * fq;
        const bool do_rope = (pn < 12) && ((wc & 1) == 0);
        const float qs = (pn < 6) ? 0.18033688011112042f : 1.0f;
#pragma unroll
        for (int ai = 0; ai < 2; ++ai)
#pragma unroll
            for (int m = 0; m < 4; ++m) { const int r = row0 + ai * HALF + m * 16; const float rs = rstd[r];
                f32x4 c0 = {1.f, 1.f, 1.f, 1.f}, c1 = c0, s0 = {0.f, 0.f, 0.f, 0.f}, s1 = s0;
                if (do_rope) { const int pos = r & smask; c0 = *(const f32x4*)(ropeC + pos * 8); c1 = *(const f32x4*)(ropeC + pos * 8 + 4); s0 = *(const f32x4*)(ropeS + pos * 8); s1 = *(const f32x4*)(ropeS + pos * 8 + 4);
                    if (fq == 0) { s0 = -s0; s1 = -s1; } if (fq >= 2) { c0 = (f32x4){1.f, 1.f, 1.f, 1.f}; c1 = c0; s0 = (f32x4){0.f, 0.f, 0.f, 0.f}; s1 = s0; } }
#pragma unroll
                for (int bj = 0; bj < 2; ++bj) { f32x4 v0 = acc[ai][bj][m][0] * rs, v1 = acc[ai][bj][m][1] * rs;
                    if (do_rope) { f32x4 p0, p1;
#pragma unroll
                        for (int e = 0; e < 4; ++e) { p0[e] = __shfl_xor(v0[e], 16); p1[e] = __shfl_xor(v1[e], 16); }
                        v0 = v0 * c0 + p0 * s0; v1 = v1 * c1 + p1 * s1; }
                    v0 = v0 * qs; v1 = v1 * qs;
                    if (pn < 34) { u32x4 w; w.x = cvt_pk_bf16(v0[0], v0[1]); w.y = cvt_pk_bf16(v0[2], v0[3]); w.z = cvt_pk_bf16(v1[0], v1[1]); w.w = cvt_pk_bf16(v1[2], v1[3]);
                        *(u32x4*)(base + (size_t)r * ldc + col0 + bj * HALF) = w; }
                    else if (bj == 0 && wc == 0) { float* sp = SMALL + (size_t)r * 32 + 8 * fq; *(f32x4*)sp = v0; *(f32x4*)(sp + 4) = v1; } } }
    }
};
struct EpiGates {
    static constexpr bool PERM = true, AFTER_DRAIN = false;
    bf16_t* G; const float* rstd;
    __device__ __forceinline__ void operator()(const f32x4 (&acc)[2][2][4][2], const Unit& u, int wr, int wc, int fr, int fq) const {
        const int row0 = u.pm * BM + wr * 64 + fr; const int col0 = u.pn * BM + wc * 32 + 8 * fq;
#pragma unroll
        for (int ai = 0; ai < 2; ++ai)
#pragma unroll
            for (int m = 0; m < 4; ++m) { const int r = row0 + ai * HALF + m * 16; const float rs = rstd[r];
#pragma unroll
                for (int bj = 0; bj < 2; ++bj) { const f32x4 v0 = acc[ai][bj][m][0] * rs, v1 = acc[ai][bj][m][1] * rs;
                    u32x4 w; w.x = cvt_pk_bf16(sigmoidf_(v0[0]), sigmoidf_(v0[1])); w.y = cvt_pk_bf16(sigmoidf_(v0[2]), sigmoidf_(v0[3])); w.z = cvt_pk_bf16(sigmoidf_(v1[0]), sigmoidf_(v1[1])); w.w = cvt_pk_bf16(sigmoidf_(v1[2]), sigmoidf_(v1[3]));
                    *(u32x4*)(G + (size_t)r * 2048 + col0 + bj * HALF) = w; } }
    }
};
struct EpiF32 {
    static constexpr bool PERM = false, AFTER_DRAIN = false;
    float* C; int ldc;
    __device__ __forceinline__ void operator()(const f32x4 (&acc)[2][2][4][2], const Unit& u, int wr, int wc, int fr, int fq) const {
        const int row0 = u.pm * BM + wr * 64 + fr, col0 = u.pn * BM + wc * 32 + 4 * fq;
#pragma unroll
        for (int ai = 0; ai < 2; ++ai)
#pragma unroll
            for (int m = 0; m < 4; ++m) { float* rowp = C + (size_t)(row0 + ai * HALF + m * 16) * ldc + col0;
#pragma unroll
                for (int bj = 0; bj < 2; ++bj)
#pragma unroll
                    for (int n = 0; n < 2; ++n) *(f32x4*)(rowp + bj * HALF + n * 16) = acc[ai][bj][m][n]; }
    }
};
struct EpiMix {
    static constexpr bool PERM = true, AFTER_DRAIN = false;
    const bf16_t* G; const float* YA; bf16_t* MIX;
    __device__ __forceinline__ void operator()(const f32x4 (&acc)[2][2][4][2], const Unit& u, int wr, int wc, int fr, int fq) const {
        const int row0 = u.pm * BM + wr * 64 + fr; const int col0 = u.pn * BM + wc * 32 + 8 * fq;
#pragma unroll
        for (int ai = 0; ai < 2; ++ai)
#pragma unroll
            for (int m = 0; m < 4; ++m) { const int r = row0 + ai * HALF + m * 16;
#pragma unroll
                for (int bj = 0; bj < 2; ++bj) { const int c = col0 + bj * HALF;
                    const u32x4 ga = *(const u32x4*)(G + (size_t)r * 2048 + c), gb = *(const u32x4*)(G + (size_t)r * 2048 + 1024 + c);
                    const f32x4 y0 = *(const f32x4*)(YA + (size_t)r * 1024 + c), y1 = *(const f32x4*)(YA + (size_t)r * 1024 + c + 4);
                    const f32x4 a0 = acc[ai][bj][m][0], a1 = acc[ai][bj][m][1];
                    u32x4 w;
                    w.x = cvt_pk_bf16(bflo(ga.x) * y0[0] + bflo(gb.x) * a0[0], bfhi(ga.x) * y0[1] + bfhi(gb.x) * a0[1]);
                    w.y = cvt_pk_bf16(bflo(ga.y) * y0[2] + bflo(gb.y) * a0[2], bfhi(ga.y) * y0[3] + bfhi(gb.y) * a0[3]);
                    w.z = cvt_pk_bf16(bflo(ga.z) * y1[0] + bflo(gb.z) * a1[0], bfhi(ga.z) * y1[1] + bfhi(gb.z) * a1[1]);
                    w.w = cvt_pk_bf16(bflo(ga.w) * y1[2] + bflo(gb.w) * a1[2], bfhi(ga.w) * y1[3] + bfhi(gb.w) * a1[3]);
                    *(u32x4*)(MIX + (size_t)r * 1024 + c) = w; } }
    }
};
struct EpiRes {
    static constexpr bool PERM = false, AFTER_DRAIN = false;
    const float* RES; float* OUT; bf16_t* XB; float* ssq;
    __device__ __forceinline__ void operator()(const f32x4 (&acc)[2][2][4][2], const Unit& u, int wr, int wc, int fr, int fq) const {
        const int row0 = u.pm * BM + wr * 64 + fr, col0 = u.pn * BM + wc * 32 + 4 * fq;
#pragma unroll
        for (int ai = 0; ai < 2; ++ai)
#pragma unroll
            for (int m = 0; m < 4; ++m) { const int r = row0 + ai * HALF + m * 16; const size_t off = (size_t)r * 1024 + col0; float s = 0.f;
#pragma unroll
                for (int bj = 0; bj < 2; ++bj)
#pragma unroll
                    for (int n = 0; n < 2; ++n) { const size_t o2 = off + bj * HALF + n * 16; const f32x4 v = *(const f32x4*)(RES + o2) + acc[ai][bj][m][n];
                        *(f32x4*)(OUT + o2) = v; s += (v[0] * v[0] + v[1] * v[1]) + (v[2] * v[2] + v[3] * v[3]);
                        if (XB) { u32x2 w; w.x = cvt_pk_bf16(v[0], v[1]); w.y = cvt_pk_bf16(v[2], v[3]); *(u32x2*)(XB + o2) = w; } }
                s += __shfl_xor(s, 16); s += __shfl_xor(s, 32);
                if (fq == 0) atomicAdd(ssq + r, s); }
    }
};
struct EpiUp {
    static constexpr bool PERM = true, AFTER_DRAIN = false;
    bf16_t* UP; const float* ssq;
    __device__ __forceinline__ void operator()(const f32x4 (&acc)[2][2][4][2], const Unit& u, int wr, int wc, int fr, int fq) const {
        const int row0 = u.pm * BM + wr * 64 + fr; const int col0 = u.pn * BM + wc * 32 + 8 * fq;
#pragma unroll
        for (int ai = 0; ai < 2; ++ai)
#pragma unroll
            for (int m = 0; m < 4; ++m) { const int r = row0 + ai * HALF + m * 16; const float rs = rsqrtf(ssq[r] * (1.0f / 1024.0f) + RMS_EPS);
#pragma unroll
                for (int bj = 0; bj < 2; ++bj) { const f32x4 v0 = acc[ai][bj][m][0] * rs, v1 = acc[ai][bj][m][1] * rs;
                    u32x4 w; w.x = cvt_pk_bf16(v0[0], v0[1]); w.y = cvt_pk_bf16(v0[2], v0[3]); w.z = cvt_pk_bf16(v1[0], v1[1]); w.w = cvt_pk_bf16(v1[2], v1[3]);
                    *(u32x4*)(UP + (size_t)r * 5632 + col0 + bj * HALF) = w; } }
    }
};
template <class Epi, class Sched, bool ALIGN_EPI = false, bool SP2 = false>
__device__ __forceinline__ void gemm_phase(PG8_LAS unsigned char* lds, const Gemm g, const Sched& S, const Epi& E, int tid_) {
    asm volatile("" : "+v"(tid_)); const int tid = tid_, wid = __builtin_amdgcn_readfirstlane(tid >> 6), lane = tid & 63, wr = wid >> 2, wc = wid & 3, fr = lane & 15, fq = lane >> 4;
    const int K = g.K, nt = K / BK;
    unsigned voffA[2], voffB[2];
#pragma unroll
    for (int i = 0; i < 2; ++i) { int R, C; stage_rc(tid * 16 + i * 8192, R, C); const int Rb = Epi::PERM ? ((R & ~31) + perm32(R & 31)) : R;
        voffA[i] = (unsigned)(R * K + C) * 2u; voffB[i] = (unsigned)(Rb * K + C) * 2u; }
    const size_t kstep = (size_t)(BK * 2);
    const size_t hstep = (size_t)HALF * K * 2;
    const size_t tstep = 2 * hstep;
    const unsigned ldsw = (unsigned)wid * 1024u;
    const int aoff = lds_byte(wr * 64 + fr, fq * 8), boff = lds_byte(wc * 32 + fr, fq * 8);
#define PG8_SA(b, h) (((b) * 2 + (h)) * HTB)
#define PG8_SB(b, h) ((4 + (b) * 2 + (h)) * HTB)
#define PG8_STAGE(bufoff, gbase, voff) do { _Pragma("unroll") for (int _i = 0; _i < 2; ++_i) \
        __builtin_amdgcn_global_load_lds((const unsigned*)((const char*)(gbase) + (voff)[_i]), (PG8_LAS unsigned*)(lds + (bufoff) + ldsw + _i * 8192), 16, 0, 0); } while (0)
#define PG8_LDA(dst, b, h) do { _Pragma("unroll") for (int m = 0; m < 4; ++m) _Pragma("unroll") for (int k = 0; k < 2; ++k) dst[m][k] = *(const PG8_LAS bf16x8*)(lds + PG8_SA(b, h) + aoff + m * 2048 + k * 1024); } while (0)
#define PG8_LDB(dst, b, h) do { _Pragma("unroll") for (int n = 0; n < 2; ++n) _Pragma("unroll") for (int k = 0; k < 2; ++k) dst[n][k] = *(const PG8_LAS bf16x8*)(lds + PG8_SB(b, h) + boff + n * 2048 + k * 1024); } while (0)
#define PG8_MMA(ai, bj, At, Bt) do { __builtin_amdgcn_s_setprio(1); _Pragma("unroll") for (int m = 0; m < 4; ++m) _Pragma("unroll") for (int n = 0; n < 2; ++n) _Pragma("unroll") for (int k = 0; k < 2; ++k) \
        acc[ai][bj][m][n] = __builtin_amdgcn_mfma_f32_16x16x32_bf16(Bt[n][k], At[m][k], acc[ai][bj][m][n], 0, 0, 0); __builtin_amdgcn_s_setprio(0); } while (0)
#define PG8_WAIT_V(n) asm volatile("s_waitcnt vmcnt(" #n ")" ::: "memory")
#define PG8_WAIT_L(n) asm volatile("s_waitcnt lgkmcnt(" #n ")" ::: "memory")
#define PG8_BAR __builtin_amdgcn_s_barrier()
#define PG8_SCHED __builtin_amdgcn_sched_barrier(0)
    Unit cur, nxt; int ui = 0;
    if (!S.next(0, cur)) return;
    f32x4 acc[2][2][4][2];
    f32x4 zz_ = (f32x4){0.f, 0.f, 0.f, 0.f}; asm volatile("" : "+v"(zz_));
#pragma unroll
    for (int a = 0; a < 2; ++a)
#pragma unroll
        for (int b = 0; b < 2; ++b)
#pragma unroll
            for (int m = 0; m < 4; ++m)
#pragma unroll
                for (int n = 0; n < 2; ++n) acc[a][b][m][n] = zz_;
    bf16x8 At[4][2], B0[2][2], B1[2][2];
    const char* cA = (const char*)g.A + (size_t)cur.pm * tstep; const char* cB = (const char*)g.Bt + (size_t)cur.pn * tstep;
    S.a_ready(cur);
    if constexpr (SP2) {
        PG8_STAGE(PG8_SB(0, 0), cB, voffB); PG8_STAGE(PG8_SB(0, 1), cB + hstep, voffB); PG8_STAGE(PG8_SA(0, 0), cA, voffA); PG8_STAGE(PG8_SA(0, 1), cA + hstep, voffA);
        if (wr == 1) PG8_BAR;
        PG8_WAIT_V(2); PG8_BAR;
        PG8_STAGE(PG8_SB(1, 0), cB + kstep, voffB); PG8_STAGE(PG8_SA(1, 0), cA + kstep, voffA); PG8_STAGE(PG8_SB(1, 1), cB + hstep + kstep, voffB);
        PG8_WAIT_V(6); PG8_BAR;
    } else {
        PG8_STAGE(PG8_SB(0, 0), cB, voffB); PG8_STAGE(PG8_SA(0, 0), cA, voffA); PG8_STAGE(PG8_SB(0, 1), cB + hstep, voffB); PG8_STAGE(PG8_SA(0, 1), cA + hstep, voffA);
        if (wr == 1) PG8_BAR;
        PG8_WAIT_V(4); PG8_BAR;
        PG8_STAGE(PG8_SB(1, 0), cB + kstep, voffB); PG8_STAGE(PG8_SA(1, 0), cA + kstep, voffA); PG8_STAGE(PG8_SB(1, 1), cB + hstep + kstep, voffB);
        PG8_WAIT_V(6); PG8_BAR;
    }
    for (;;) {
        const bool has_next = S.next(ui + 1, nxt);
        const char* nA = has_next ? (const char*)g.A + (size_t)nxt.pm * tstep : cA; const char* nB = has_next ? (const char*)g.Bt + (size_t)nxt.pn * tstep : cB;
        for (int t = 0; t < nt; t += 2) {
            const bool last = (t == nt - 2);
            const char* a1 = cA + (size_t)(t + 1) * kstep;
            const char* a2 = last ? nA : cA + (size_t)(t + 2) * kstep; const char* b2 = last ? nB : cB + (size_t)(t + 2) * kstep;
            const char* a3 = a2 + kstep; const char* b3 = b2 + kstep;
            if (last && has_next) S.a_ready(nxt);
            if constexpr (SP2) {
            PG8_LDB(B0, 0, 0); PG8_LDB(B1, 0, 1); PG8_SCHED; PG8_LDA(At, 0, 0); PG8_STAGE(PG8_SA(1, 1), a1 + hstep, voffA);
            PG8_WAIT_V(8); PG8_WAIT_L(0); PG8_BAR; PG8_MMA(0, 0, At, B0); PG8_MMA(0, 1, At, B1); PG8_BAR; PG8_SCHED;
            PG8_LDA(At, 0, 1); PG8_STAGE(PG8_SB(0, 0), b2, voffB); PG8_STAGE(PG8_SB(0, 1), b2 + hstep, voffB); PG8_STAGE(PG8_SA(0, 0), a2, voffA);
            PG8_WAIT_V(8); PG8_WAIT_L(0); PG8_BAR; PG8_MMA(1, 0, At, B0); PG8_MMA(1, 1, At, B1); PG8_BAR; PG8_SCHED;
            PG8_LDB(B0, 1, 0); PG8_LDB(B1, 1, 1); PG8_SCHED; PG8_LDA(At, 1, 0); PG8_STAGE(PG8_SA(0, 1), a2 + hstep, voffA);
            PG8_WAIT_V(8); PG8_WAIT_L(0); PG8_BAR; PG8_MMA(0, 0, At, B0); PG8_MMA(0, 1, At, B1); PG8_BAR; PG8_SCHED;
            PG8_LDA(At, 1, 1); PG8_STAGE(PG8_SB(1, 0), b3, voffB); PG8_STAGE(PG8_SB(1, 1), b3 + hstep, voffB); PG8_STAGE(PG8_SA(1, 0), a3, voffA);
            PG8_WAIT_V(8); PG8_WAIT_L(0); PG8_BAR; PG8_MMA(1, 0, At, B0); PG8_MMA(1, 1, At, B1); PG8_BAR; PG8_SCHED;
            } else {
            PG8_LDB(B0, 0, 0); PG8_SCHED; PG8_LDA(At, 0, 0); PG8_STAGE(PG8_SA(1, 1), a1 + hstep, voffA);
            PG8_WAIT_L(8); PG8_BAR; PG8_WAIT_L(0); PG8_MMA(0, 0, At, B0); PG8_BAR; PG8_SCHED;
            PG8_LDB(B1, 0, 1); PG8_STAGE(PG8_SB(0, 0), b2, voffB);
            PG8_BAR; PG8_WAIT_L(0); PG8_MMA(0, 1, At, B1); PG8_BAR;
            PG8_LDA(At, 0, 1); PG8_STAGE(PG8_SA(0, 0), a2, voffA);
            PG8_BAR; PG8_WAIT_L(0); PG8_MMA(1, 0, At, B0); PG8_BAR; PG8_SCHED;
            PG8_STAGE(PG8_SB(0, 1), b2 + hstep, voffB);
            PG8_WAIT_V(6); PG8_BAR; PG8_MMA(1, 1, At, B1); PG8_BAR;
            PG8_LDB(B0, 1, 0); PG8_SCHED; PG8_LDA(At, 1, 0); PG8_STAGE(PG8_SA(0, 1), a2 + hstep, voffA);
            PG8_WAIT_L(8); PG8_BAR; PG8_WAIT_L(0); PG8_MMA(0, 0, At, B0); PG8_BAR; PG8_SCHED;
            PG8_LDB(B1, 1, 1); PG8_STAGE(PG8_SB(1, 0), b3, voffB);
            PG8_BAR; PG8_WAIT_L(0); PG8_MMA(0, 1, At, B1); PG8_BAR;
            PG8_LDA(At, 1, 1); PG8_STAGE(PG8_SA(1, 0), a3, voffA);
            PG8_BAR; PG8_WAIT_L(0); PG8_MMA(1, 0, At, B0); PG8_BAR; PG8_SCHED;
            PG8_STAGE(PG8_SB(1, 1), b3 + hstep, voffB);
            PG8_WAIT_V(6); PG8_BAR; PG8_MMA(1, 1, At, B1); PG8_BAR;
            }
        }
        if constexpr (ALIGN_EPI) { if (wr == 0) PG8_BAR; }
        if constexpr (!Epi::AFTER_DRAIN) { E(acc, cur, wr, wc, fr, fq); S.done(cur); }
        if (!has_next) break;
        zz_ = (f32x4){0.f, 0.f, 0.f, 0.f}; asm volatile("" : "+v"(zz_));
#pragma unroll
        for (int a = 0; a < 2; ++a)
#pragma unroll
            for (int b = 0; b < 2; ++b)
#pragma unroll
                for (int m = 0; m < 4; ++m)
#pragma unroll
                    for (int n = 0; n < 2; ++n) acc[a][b][m][n] = zz_;
        cur = nxt; cA = nA; cB = nB; ++ui;
        if constexpr (ALIGN_EPI) { if (wr == 1) PG8_BAR; }
    }
    PG8_WAIT_V(0);
    if constexpr (!ALIGN_EPI) { if (wr == 0) PG8_BAR; }
    PG8_BAR;
    if constexpr (Epi::AFTER_DRAIN) { E.fused(acc, cur, wr, wc, fr, fq, lds, wid, lane); S.done(cur); }
#undef PG8_SA
#undef PG8_SB
#undef PG8_STAGE
#undef PG8_LDA
#undef PG8_LDB
#undef PG8_MMA
#undef PG8_WAIT_V
#undef PG8_WAIT_L
#undef PG8_BAR
#undef PG8_SCHED
}
}

#define LAS __attribute__((address_space(3)))
typedef unsigned short bf16;
typedef float f32x4 __attribute__((ext_vector_type(4)));
typedef unsigned v4u __attribute__((ext_vector_type(4)));
typedef unsigned v2u __attribute__((ext_vector_type(2)));
using pg8::cvt_pk_bf16; using pg8::bflo; using pg8::bfhi;

constexpr int NWAVES = 8, NTHREADS = 512;
constexpr int D = 1024, NTOK = 49152, TG = 16384, NGROUPS = 3;
constexpr int ATTW = 4608, DNW = 3072, NPA = 8960  , NIN_T = 11008, DFF = 2816, NUP = 5632;
constexpr float EPS = 1e-6f;

constexpr size_t MiB = 1u << 20;
constexpr size_t WS_CTL = 0, CTL_BYTES = 1 * MiB;
constexpr size_t CTL_SSQ2 = 256 * 1024, CTL_SSQ3 = 512 * 1024;
constexpr size_t WS_WIN = 1 * MiB, WS_WUP = 23 * MiB, WS_WDOWN = 34 * MiB, WS_WOUT = 40 * MiB, WS_WA = 42 * MiB, WS_WB = 43 * MiB;
constexpr size_t WS_ROPE = 45 * MiB, WS_RSTD1 = 46 * MiB, WS_XB = 48 * MiB  , WS_ARENA = 80 * MiB, WS_END = 512 * MiB;
constexpr size_t AR_ATT = 0, AR_DNQ = 144 * MiB, AR_Z = 240 * MiB, AR_SMALL = 272 * MiB, AR_AO = 274 * MiB, AR_PO = 290 * MiB, AR_LSE = 338 * MiB, AR_MIX = 290 * MiB;
constexpr size_t AR_FRAG = 0, AR_VACC = 96 * MiB, AR_TI = 340 * MiB, AR_VEC = 404 * MiB;
constexpr size_t AR_OF = 144 * MiB, AR_OB = 176 * MiB, AR_DNOUT = 208 * MiB;
constexpr size_t AR_G = 0, AR_YA = 64 * MiB;
constexpr size_t AR_UP = 0, AR_ACT = 176 * MiB;
static_assert(WS_ARENA + AR_VEC + 8 * MiB <= WS_END, "ws map");

struct Args { const float* in[19]; float* out; unsigned char* ws; int lo, hi; };

__device__ __forceinline__ float wave_sum(float v) {
#pragma unroll
    for (int o = 1; o < 64; o <<= 1) v += __shfl_xor(v, o);
    return v;
}
__device__ __forceinline__ float bf2f(bf16 u) { return __uint_as_float((unsigned)u << 16); }
__device__ __forceinline__ float siluf_(float x) { return x * __builtin_amdgcn_rcpf(1.0f + __expf(-x)); }

__device__ __forceinline__ void p0_transpose_item(const float* W, int ldw, int col_off, int K, int ncols, const float* gain, bf16* WT, int row_off, LAS float* scr, int item, int lane) {
    const int nblk = ncols / 32, kb = item / nblk, nb = item % nblk, k0 = 64 * kb, n0 = 32 * nb;
#pragma unroll 8
    for (int i = 0; i < 32; ++i) { const int kk = 2 * i + (lane >> 5); float w = W[(size_t)(k0 + kk) * ldw + col_off + n0 + (lane & 31)]; if (gain) w *= gain[k0 + kk]; scr[kk * 33 + (lane & 31)] = w; }
    asm volatile("s_waitcnt lgkmcnt(0)" ::: "memory");
    const int c = lane & 7;
#pragma unroll
    for (int j = 0; j < 4; ++j) { const int n = (lane >> 3) + 8 * j; const LAS float* s = scr + (8 * c) * 33 + n;
        v4u o; o.x = cvt_pk_bf16(s[0 * 33], s[1 * 33]); o.y = cvt_pk_bf16(s[2 * 33], s[3 * 33]); o.z = cvt_pk_bf16(s[4 * 33], s[5 * 33]); o.w = cvt_pk_bf16(s[6 * 33], s[7 * 33]);
        *(v4u*)(WT + (size_t)(row_off + n0 + n) * K + k0 + 8 * c) = o; }
    asm volatile("s_waitcnt lgkmcnt(0)" ::: "memory");
}

struct Ptrs {
    const float *x_p, *x_s, *norm_mix_g, *w_in, *conv_w, *a_log_f, *a_log_b, *dt_f, *dt_b, *out_norm_g, *w_a, *w_b, *w_out, *norm_ffn_g, *w_up, *ffn_conv_w, *ffn_conv_b, *w_down, *norm_final_g;
    float* out; unsigned char* ws;
};
__device__ __forceinline__ const float* x_row(const Ptrs& P, int tok) { return tok < 32768 ? P.x_p + (size_t)tok * D : P.x_s + (size_t)(tok - 32768) * D; }

__device__ __forceinline__ void phase_xb(const Ptrs& P, int g, int gw, int NGW, int lane) {
    bf16* XB = (bf16*)(P.ws + WS_XB); float* rstd1 = (float*)(P.ws + WS_RSTD1);
    for (int m = gw; m < TG; m += NGW) {
        const f32x4* xr = (const f32x4*)x_row(P, g * TG + m) + lane; f32x4 v[4]; float s = 0.f;
#pragma unroll
        for (int j = 0; j < 4; ++j) { v[j] = xr[64 * j]; s += (v[j].x * v[j].x + v[j].y * v[j].y) + (v[j].z * v[j].z + v[j].w * v[j].w); }
        s = wave_sum(s);
        if (lane == 0) rstd1[g * TG + m] = rsqrtf(s * (1.0f / 1024.0f) + EPS);
        unsigned long long* o8 = (unsigned long long*)(XB + (size_t)m * D) + lane;
#pragma unroll
        for (int j = 0; j < 4; ++j) o8[64 * j] = (unsigned long long)cvt_pk_bf16(v[j].x, v[j].y) | ((unsigned long long)cvt_pk_bf16(v[j].z, v[j].w) << 32);
    }
}
__device__ __forceinline__ void phase_prologue(const Ptrs& P, unsigned char* lds, int bid, int G, int tid) {
    const int lane = tid & 63, wave = tid >> 6;
    LAS float* scr = (LAS float*)((LAS unsigned char*)lds + wave * 16384);
    const int gw = bid * NWAVES + wave, NGW = G * NWAVES;
    bf16* Win = (bf16*)(P.ws + WS_WIN); bf16* Wup = (bf16*)(P.ws + WS_WUP); bf16* Wdn = (bf16*)(P.ws + WS_WDOWN); bf16* Wout = (bf16*)(P.ws + WS_WOUT); bf16* Wa = (bf16*)(P.ws + WS_WA); bf16* Wb = (bf16*)(P.ws + WS_WB);
    constexpr int I1 = 16 * 273, I2 = 16 * 64, I3 = 8 * 32, I4 = 16 * 32, I5 = 16 * 32, I6 = 16 * 176, I7 = 44 * 32;
    constexpr int NIT = I1 + I2 + I3 + I4 + I5 + I6 + I7;
    for (int it = gw; it < NIT; it += NGW) {
        int r = it;
        if (r < I1) { p0_transpose_item(P.w_in, 10784, 0, 1024, 8736, P.norm_mix_g, Win, 0, scr, r, lane); continue; } r -= I1;
        if (r < I2) { p0_transpose_item(P.w_in, 10784, 8736, 1024, 2048, P.norm_mix_g, Win, 8960, scr, r, lane); continue; } r -= I2;
        if (r < I3) { p0_transpose_item(P.w_a, 1024, 0, 512, 1024, nullptr, Wa, 0, scr, r, lane); continue; } r -= I3;
        if (r < I4) { p0_transpose_item(P.w_b, 1024, 0, 1024, 1024, nullptr, Wb, 0, scr, r, lane); continue; } r -= I4;
        if (r < I5) { p0_transpose_item(P.w_out, 1024, 0, 1024, 1024, nullptr, Wout, 0, scr, r, lane); continue; } r -= I5;
        if (r < I6) { p0_transpose_item(P.w_up, 5632, 0, 1024, 5632, P.norm_ffn_g, Wup, 0, scr, r, lane); continue; } r -= I6;
        p0_transpose_item(P.w_down, 1024, 0, 2816, 1024, nullptr, Wdn, 0, scr, r, lane);
    }
    const int gt = bid * NTHREADS + tid, NGT = G * NTHREADS;
    for (int i = gt; i < 28672; i += NGT) ((v4u*)(Win + (size_t)8736 * 1024))[i] = (v4u){0u, 0u, 0u, 0u};
    float* ropeC = (float*)(P.ws + WS_ROPE); float* ropeS = ropeC + 4096 * 8;
    for (int i = gt; i < 4096 * 8; i += NGT) { const int pos = i >> 3, j = i & 7;
        const float invt[8] = {1.0f, 0.19392274f, 0.03760603f, 0.0072926646f, 0.0014142136f, 0.0002742482f, 5.3182957e-05f, 1.0313385e-05f};
        const float inv = invt[j]; const float ang = (float)pos * inv;
        const float c_hi = 0.15915494f, c_lo = 6.4206382e-09f;
        const float kq = rintf(ang * c_hi); float r = fmaf(ang, c_hi, -kq); r = fmaf(ang, c_lo, r);
        ropeC[i] = __builtin_amdgcn_cosf(r); ropeS[i] = __builtin_amdgcn_sinf(r); }
    phase_xb(P, 0, gw, NGW, lane);
}

__device__ __forceinline__ void load8bf(const bf16* p, float* o) { const v4u w = *(const v4u*)p; o[0] = bflo(w.x); o[1] = bfhi(w.x); o[2] = bflo(w.y); o[3] = bfhi(w.y); o[4] = bflo(w.z); o[5] = bfhi(w.z); o[6] = bflo(w.w); o[7] = bfhi(w.w); }
typedef short bf16x8_t __attribute__((ext_vector_type(8)));
typedef float f32x16 __attribute__((ext_vector_type(16)));
typedef short s16x4_t __attribute__((ext_vector_type(4)));
__device__ __forceinline__ void phase_attn(const bf16* ATT, bf16* PO, float* LSE, int S, unsigned char* lds_, int bid, int G, int tid) {
    LAS unsigned char* lds = (LAS unsigned char*)lds_;
    const int lane = tid & 63, w = __builtin_amdgcn_readfirstlane(tid >> 6), ql = lane & 31, h2 = lane >> 5;
    const int NU = S >> 8, nunits = (TG / S) * 24 * NU;
    constexpr int KOFF = 0, VOFF = 49152;
    for (int u = bid; u < nunits; u += G) {
        const int idx = u % NU, bh = u / NU, h = bh % 24, b = bh / 24; const int gi = h >> 3, dil = (gi == 0) ? 1 : (gi == 1) ? 4 : 16, L = S / dil;
        const int seq0 = b * S;
        const bool two = (L < 256);
        const int r0 = two ? 2 * idx : idx % dil, p0 = two ? 0 : (idx / dil) * 256, sbase = two ? 0 : p0 - 64, nrows = two ? 256 : 384;
        { const int ri = lane >> 3, c = lane & 7;
          for (int pc = w; pc < nrows / 8; pc += NWAVES) { const int row = pc * 8 + ri; int cls, pos;
              if (two) { cls = r0 + (row >> 7); pos = row & 127; } else { cls = r0; pos = sbase + row; pos = pos < 0 ? 0 : (pos >= L ? L - 1 : pos); }
              const bf16* src = ATT + (size_t)(seq0 + cls + dil * pos) * ATTW + h * 64;
              __builtin_amdgcn_global_load_lds((const unsigned*)(src + 1536 + ((c ^ ri) << 3)), (LAS unsigned*)(lds + KOFF + pc * 1024), 16, 0, 0);
              __builtin_amdgcn_global_load_lds((const unsigned*)(src + 3072 + ((c ^ (((ri >> 1) & 1) << 2)) << 3)), (LAS unsigned*)(lds + VOFF + pc * 1024), 16, 0, 0); } }
        const int cls = two ? r0 + (w >> 2) : r0; const int qp0 = two ? 32 * (w & 3) : p0 + 32 * w;
        const int tokq = seq0 + cls + dil * (qp0 + ql);
        bf16x8_t qf[4];
#pragma unroll
        for (int s4 = 0; s4 < 4; ++s4) qf[s4] = *(const bf16x8_t*)(ATT + (size_t)tokq * ATTW + h * 64 + 16 * s4 + 8 * h2);
        const int lrow0 = (two ? (w >> 2) * 128 : 0) + qp0 - 64 - sbase;
        __syncthreads();
        f32x16 St[5]; float mx = -1e30f;
#pragma unroll
        for (int t = 0; t < 5; ++t) { const int kp0 = qp0 - 64 + 32 * t; const bool ok = (kp0 >= 0) && (kp0 < L);
            if (ok) { const int R = lrow0 + 32 * t + ql; f32x16 a = {};
#pragma unroll
                for (int s4 = 0; s4 < 4; ++s4) { const bf16x8_t kf = *(const LAS bf16x8_t*)(lds + KOFF + R * 128 + (((2 * s4 + h2) ^ (R & 7)) << 4)); a = __builtin_amdgcn_mfma_f32_32x32x16_bf16(kf, qf[s4], a, 0, 0, 0); }
#pragma unroll
                for (int rg = 0; rg < 16; ++rg) { const int row = (rg & 3) + 8 * (rg >> 2) + 4 * h2; if ((t == 0 && row < ql) || (t == 4 && row > ql)) a[rg] = -1e30f; mx = fmaxf(mx, a[rg]); }
                St[t] = a; }
            else { St[t] = (f32x16){}; } }
        mx = fmaxf(mx, __shfl_xor(mx, 32));
        float lsum = 0.f; f32x16 O0 = {}, O1 = {};
#pragma unroll
        for (int t = 0; t < 5; ++t) { const int kp0 = qp0 - 64 + 32 * t; const bool ok = (kp0 >= 0) && (kp0 < L);
            if (ok) { f32x16 p = St[t];
#pragma unroll
                for (int rg = 0; rg < 16; ++rg) { p[rg] = __builtin_amdgcn_exp2f(p[rg] - mx); lsum += p[rg]; }
#pragma unroll
                for (int s2 = 0; s2 < 2; ++s2) { v4u pk; pk.x = cvt_pk_bf16(p[8 * s2], p[8 * s2 + 1]); pk.y = cvt_pk_bf16(p[8 * s2 + 2], p[8 * s2 + 3]); pk.z = cvt_pk_bf16(p[8 * s2 + 4], p[8 * s2 + 5]); pk.w = cvt_pk_bf16(p[8 * s2 + 6], p[8 * s2 + 7]);
                    const bf16x8_t pb = __builtin_bit_cast(bf16x8_t, pk);
#pragma unroll
                    for (int dt = 0; dt < 2; ++dt) { const int g16 = (lane >> 4) & 1, qq = (lane & 15) >> 2, pp = lane & 3;
                        const int k0 = lrow0 + 32 * t + 16 * s2 + 4 * h2 + qq, k1 = k0 + 8;
                        const int a0 = VOFF + k0 * 128 + (((dt ^ ((k0 >> 1) & 1)) << 6) | (g16 << 5) | (pp << 3)), a1 = VOFF + k1 * 128 + (((dt ^ ((k1 >> 1) & 1)) << 6) | (g16 << 5) | (pp << 3));
                        const s16x4_t lo = __builtin_bit_cast(s16x4_t, __builtin_amdgcn_ds_read_tr16_b64_v4i16((LAS s16x4_t*)(lds + a0))), hi = __builtin_bit_cast(s16x4_t, __builtin_amdgcn_ds_read_tr16_b64_v4i16((LAS s16x4_t*)(lds + a1)));
                        const bf16x8_t vf = (bf16x8_t){lo[0], lo[1], lo[2], lo[3], hi[0], hi[1], hi[2], hi[3]};
                        if (dt == 0) O0 = __builtin_amdgcn_mfma_f32_32x32x16_bf16(vf, pb, O0, 0, 0, 0); else O1 = __builtin_amdgcn_mfma_f32_32x32x16_bf16(vf, pb, O1, 0, 0, 0); } } } }
        lsum += __shfl_xor(lsum, 32);
        const float il = 1.0f / lsum;
        bf16* po = PO + ((size_t)tokq * 24 + h) * 64;
#pragma unroll
        for (int g4 = 0; g4 < 4; ++g4) { v2u w0, w1; w0.x = cvt_pk_bf16(O0[4 * g4] * il, O0[4 * g4 + 1] * il); w0.y = cvt_pk_bf16(O0[4 * g4 + 2] * il, O0[4 * g4 + 3] * il); w1.x = cvt_pk_bf16(O1[4 * g4] * il, O1[4 * g4 + 1] * il); w1.y = cvt_pk_bf16(O1[4 * g4 + 2] * il, O1[4 * g4 + 3] * il);
            *(v2u*)(po + 8 * g4 + 4 * h2) = w0; *(v2u*)(po + 32 + 8 * g4 + 4 * h2) = w1; }
        if (h2 == 0) LSE[(size_t)tokq * 24 + h] = mx + __builtin_amdgcn_logf(lsum);
        __syncthreads();
    }
}
__device__ __forceinline__ void phase_attn_combine(const bf16* PO, const float* LSE, bf16* AO, int gt, int NGT) {
    for (int item = gt; item < TG * 64; item += NGT) { const int tok = item >> 6, hg = (item >> 3) & 7, c = item & 7;
        const float l0 = LSE[(size_t)tok * 24 + hg], l1 = LSE[(size_t)tok * 24 + 8 + hg], l2 = LSE[(size_t)tok * 24 + 16 + hg]; const float m = fmaxf(l0, fmaxf(l1, l2));
        float w0 = __builtin_amdgcn_exp2f(l0 - m), w1 = __builtin_amdgcn_exp2f(l1 - m), w2 = __builtin_amdgcn_exp2f(l2 - m); const float inv = 1.0f / (w0 + w1 + w2); w0 *= inv; w1 *= inv; w2 *= inv;
        float a[8], b8[8], c8[8]; load8bf(PO + ((size_t)tok * 24 + hg) * 64 + c * 8, a); load8bf(PO + ((size_t)tok * 24 + 8 + hg) * 64 + c * 8, b8); load8bf(PO + ((size_t)tok * 24 + 16 + hg) * 64 + c * 8, c8);
#pragma unroll
        for (int e = 0; e < 8; ++e) a[e] = w0 * a[e] + w1 * b8[e] + w2 * c8[e];
        v4u o; o.x = cvt_pk_bf16(a[0], a[1]); o.y = cvt_pk_bf16(a[2], a[3]); o.z = cvt_pk_bf16(a[4], a[5]); o.w = cvt_pk_bf16(a[6], a[7]);
        *(v4u*)(AO + (size_t)tok * 512 + hg * 64 + c * 8) = o; }
}

constexpr int DN_FRAG_U = 49152  , DN_TI_UD = 16384  , DN_VEC_UD = 512  ;
__device__ __forceinline__ int pi_q(int q, int j) { return (j < 4) ? (4 * q + j) : (16 + 4 * q + (j - 4)); }
__device__ __forceinline__ float dpp_xor1(float x) { return __int_as_float(__builtin_amdgcn_mov_dpp(__float_as_int(x), 0xB1, 0xF, 0xF, true)); }
__device__ __forceinline__ float dpp_xor2(float x) { return __int_as_float(__builtin_amdgcn_mov_dpp(__float_as_int(x), 0x4E, 0xF, 0xF, true)); }

__device__ __forceinline__ void phase_dna(const Ptrs& P, const bf16* DNQ, const float* SMALL, unsigned char* FRAG, bf16* VACC, unsigned char* TI, float* VEC, int S, unsigned char* lds_, int bid, int G, int tid) {
    LAS unsigned char* lds = (LAS unsigned char*)lds_;
    const int lane = tid & 63, w = __builtin_amdgcn_readfirstlane(tid >> 6), c16 = lane & 15, q4 = lane >> 4;
    constexpr int RAW = 0, RM = 52224, RMP = 132  , RMPART = 64 * RMP, MM = 102912, LP = RM, TM = MM, GV = 135680;
    LAS bf16* raw = (LAS bf16*)(lds + RAW); LAS bf16* rm = (LAS bf16*)(lds + RM); LAS float* mm = (LAS float*)(lds + MM); LAS float* lp = (LAS float*)(lds + LP); LAS float* tm = (LAS float*)(lds + TM); LAS float* gv = (LAS float*)(lds + GV);
    const int NU = (TG / 64) * 8;
#define DNA_STAGE(u_) do { const int n_ = (u_) >> 3, h_ = (u_) & 7; const int tok0_ = n_ * 64, pos0_ = tok0_ & (S - 1), seq0_ = tok0_ - pos0_; \
        for (int pc = w; pc < 51; pc += NWAVES) { const int part_ = pc / 17, rg_ = pc - part_ * 17; int p_ = pos0_ - 2 + 4 * rg_ + (lane >> 4); p_ = p_ < 0 ? 0 : (p_ >= S ? S - 1 : p_); \
            __builtin_amdgcn_global_load_lds((const unsigned*)(DNQ + (size_t)(seq0_ + p_) * DNW + part_ * 1024 + h_ * 128 + (lane & 15) * 8), (LAS unsigned*)(lds + RAW + pc * 1024), 16, 0, 0); } } while (0)
    if (bid < NU) DNA_STAGE(bid);
    for (int ui = bid; ui < NU; ui += G) {
        const int n = ui >> 3, h = ui & 7; const int tok0 = n * 64, pos0 = tok0 & (S - 1);
        __syncthreads();
#pragma unroll
        for (int i6 = 0; i6 < 6; ++i6) { const int it = w * 6 + i6, part = it >> 4, t = ((it & 15) << 2) + q4; const int ch = part * 1024 + h * 128 + 8 * c16;
            float a[8];
#pragma unroll
            for (int e = 0; e < 8; ++e) a[e] = 0.f;
#pragma unroll
            for (int i = 0; i < 5; ++i) { const int p2 = pos0 + t + i - 2; const v4u x = *(const LAS v4u*)(raw + (part * 68 + t + i) * 128 + 8 * c16);
                const f32x4 wa = *(const f32x4*)(P.conv_w + i * DNW + ch), wb = *(const f32x4*)(P.conv_w + i * DNW + ch + 4);
                if (p2 >= 0 && p2 < S) { a[0] += bflo(x.x) * wa[0]; a[1] += bfhi(x.x) * wa[1]; a[2] += bflo(x.y) * wa[2]; a[3] += bfhi(x.y) * wa[3]; a[4] += bflo(x.z) * wb[0]; a[5] += bfhi(x.z) * wb[1]; a[6] += bflo(x.w) * wb[2]; a[7] += bfhi(x.w) * wb[3]; } }
            float ss = 0.f;
#pragma unroll
            for (int e = 0; e < 8; ++e) { a[e] = a[e] * __builtin_amdgcn_rcpf(1.0f + __expf(-a[e])); ss += a[e] * a[e]; }
            if (part < 2) { ss += __int_as_float(__builtin_amdgcn_mov_dpp(__float_as_int(ss), 0xB1, 0xF, 0xF, true)); ss += __int_as_float(__builtin_amdgcn_mov_dpp(__float_as_int(ss), 0x4E, 0xF, 0xF, true));
                ss += __int_as_float(__builtin_amdgcn_mov_dpp(__float_as_int(ss), 0x124, 0xF, 0xF, true));
                ss += __int_as_float(__builtin_amdgcn_mov_dpp(__float_as_int(ss), 0x128, 0xF, 0xF, true));
                float sc = rsqrtf(ss + EPS); if (part == 0) sc *= 0.08838834764831845f;
#pragma unroll
                for (int e = 0; e < 8; ++e) a[e] *= sc; }
            const v4u o = {cvt_pk_bf16(a[0], a[1]), cvt_pk_bf16(a[2], a[3]), cvt_pk_bf16(a[4], a[5]), cvt_pk_bf16(a[6], a[7])};
            *(LAS v2u*)(rm + part * RMPART + t * RMP + 8 * c16) = (v2u){o.x, o.y}; *(LAS v2u*)(rm + part * RMPART + t * RMP + 8 * c16 + 4) = (v2u){o.z, o.w}; }
        __syncthreads();
        if (ui + G < NU) DNA_STAGE(ui + G);
        unsigned char* fr_u = FRAG + (size_t)ui * DN_FRAG_U;
#pragma unroll
        for (int i = 0; i < 4; ++i) { const int fidx = 4 * w + i, isQ = fidx >> 4, ff = fidx & 15, mt = ff >> 2, ks = ff & 3; const int row = 16 * mt + c16;
            const LAS bf16* src = rm + (isQ ? 0 : RMPART) + row * RMP + 32 * ks + 4 * q4;
            const v2u lo = *(const LAS v2u*)src, hi = *(const LAS v2u*)(src + 16); const v4u val = {lo.x, lo.y, hi.x, hi.y};
            *(v4u*)(fr_u + (isQ * 16 + ff) * 1024 + lane * 16) = val; }
#pragma unroll
        for (int i = 0; i < 2; ++i) { const int f = 2 * w + i, mt8 = f >> 1, ks = f & 1; const int dim = 16 * mt8 + c16; unsigned short e[8];
#pragma unroll
            for (int j = 0; j < 8; ++j) e[j] = rm[RMPART + (32 * ks + pi_q(q4, j)) * RMP + dim];
            const v4u val = {(unsigned)e[0] | ((unsigned)e[1] << 16), (unsigned)e[2] | ((unsigned)e[3] << 16), (unsigned)e[4] | ((unsigned)e[5] << 16), (unsigned)e[6] | ((unsigned)e[7] << 16)};
            *(v4u*)(fr_u + (32 + f) * 1024 + lane * 16) = val; }
        { unsigned short e[16];
#pragma unroll
          for (int mt = 0; mt < 4; ++mt)
#pragma unroll
              for (int r = 0; r < 4; ++r) e[mt * 4 + r] = rm[2 * RMPART + (16 * mt + 4 * q4 + r) * RMP + 16 * w + c16];
          v4u a = {(unsigned)e[0] | ((unsigned)e[1] << 16), (unsigned)e[2] | ((unsigned)e[3] << 16), (unsigned)e[4] | ((unsigned)e[5] << 16), (unsigned)e[6] | ((unsigned)e[7] << 16)};
          v4u b = {(unsigned)e[8] | ((unsigned)e[9] << 16), (unsigned)e[10] | ((unsigned)e[11] << 16), (unsigned)e[12] | ((unsigned)e[13] << 16), (unsigned)e[14] | ((unsigned)e[15] << 16)};
          v4u* dst = (v4u*)(VACC + (((size_t)ui * 8 + w) * 64 + lane) * 16); dst[0] = a; dst[1] = b; }
#pragma unroll
        for (int i = 0; i < 4; ++i) { const int t4 = 4 * w + i, isQK = t4 >> 4, tt = t4 & 15, mt = tt >> 2, nt = tt & 3; pg8::f32x4 acc = {0.f, 0.f, 0.f, 0.f};
#pragma unroll
            for (int ks = 0; ks < 4; ++ks) { const LAS bf16* sa = rm + (isQK ? 0 : RMPART) + (16 * mt + c16) * RMP + 32 * ks + 4 * q4; const LAS bf16* sb = rm + RMPART + (16 * nt + c16) * RMP + 32 * ks + 4 * q4;
                const v2u alo = *(const LAS v2u*)sa, ahi = *(const LAS v2u*)(sa + 16), blo = *(const LAS v2u*)sb, bhi = *(const LAS v2u*)(sb + 16);
                const v4u av = {alo.x, alo.y, ahi.x, ahi.y}, bv = {blo.x, blo.y, bhi.x, bhi.y};
                acc = __builtin_amdgcn_mfma_f32_16x16x32_bf16(__builtin_bit_cast(bf16x8_t, av), __builtin_bit_cast(bf16x8_t, bv), acc, 0, 0, 0); }
#pragma unroll
            for (int r = 0; r < 4; ++r) mm[isQK * 4096 + (16 * mt + 4 * q4 + r) * 64 + 16 * nt + c16] = acc[r]; }
        if (w < 2) { const int dir = w; const float* sm = SMALL + (size_t)(tok0 + lane) * 32;
            const float beta = __builtin_amdgcn_rcpf(1.0f + __expf(-sm[dir * 8 + h])); const float al = dir ? P.a_log_b[h] : P.a_log_f[h], db = dir ? P.dt_b[h] : P.dt_f[h];
            const float xx = sm[16 + dir * 8 + h] + db; const float sp = (xx > 20.f) ? xx : __logf(1.0f + __expf(xx)); const float gg = -__expf(al) * sp;
            float gc = gg;
#pragma unroll
            for (int o = 1; o < 64; o <<= 1) { const float tt = dir ? __shfl_down(gc, o) : __shfl_up(gc, o); const bool okk = dir ? (lane + o < 64) : (lane >= o); if (okk) gc += tt; }
            const float glast = __shfl(gc, dir ? 0 : 63);
            gv[dir * 128 + lane] = gc; gv[dir * 128 + 64 + lane] = beta;
            float* vec = VEC + ((size_t)ui * 2 + dir) * DN_VEC_UD; const float eg = __expf(gc);
            vec[lane] = beta; vec[64 + lane] = beta * eg; vec[128 + lane] = eg; vec[192 + lane] = __expf(glast - gc); }
        __syncthreads();
        unsigned char* ti_u = TI + (size_t)ui * 2 * DN_TI_UD;
#pragma unroll
        for (int k2 = 0; k2 < 2; ++k2) { const int task = tid + 512 * k2, dir = task >> 9, f = (task >> 6) & 7, mt = f >> 1, ks = f & 1; const int i = 16 * mt + c16; const float gci = gv[dir * 128 + i]; float e[8];
#pragma unroll
            for (int j8 = 0; j8 < 8; ++j8) { const int j = 32 * ks + pi_q(q4, j8); const bool incl = dir ? (i <= j) : (i >= j); e[j8] = incl ? mm[4096 + i * 64 + j] * __expf(gci - gv[dir * 128 + j]) : 0.f; }
            const v4u val = {cvt_pk_bf16(e[0], e[1]), cvt_pk_bf16(e[2], e[3]), cvt_pk_bf16(e[4], e[5]), cvt_pk_bf16(e[6], e[7])};
            *(v4u*)(ti_u + dir * DN_TI_UD + (8 + f) * 1024 + lane * 16) = val; }
        f32x4 lpv[4];
#pragma unroll
        for (int k4 = 0; k4 < 4; ++k4) { const int vi = tid + 512 * k4, dir = vi >> 10, ip = (vi >> 4) & 63, p = (vi >> 2) & 3, jj4 = vi & 3; const int i = dir ? 63 - ip : ip; const float gci = gv[dir * 128 + i], bi = gv[dir * 128 + 64 + i];
#pragma unroll
            for (int e = 0; e < 4; ++e) { const int jp = 16 * jj4 + 4 * e + p; const int j = dir ? 63 - jp : jp; lpv[k4][e] = (jp < ip) ? bi * mm[i * 64 + j] * __expf(gci - gv[dir * 128 + j]) : 0.f; } }
        __syncthreads();
#pragma unroll
        for (int k4 = 0; k4 < 4; ++k4) { const int vi = tid + 512 * k4; *(LAS f32x4*)(lp + vi * 4) = lpv[k4]; }
        __syncthreads();
        { const int dir = w >> 2, cc = (w & 3) * 16 + (lane >> 2), p = lane & 3; float t[16];
#pragma unroll
          for (int jj = 0; jj < 16; ++jj) t[jj] = 0.f;
#pragma unroll
          for (int ip = 0; ip < 64; ++ip) { float part = 0.f;
#pragma unroll
              for (int jj4 = 0; jj4 < (ip + 15) / 16; ++jj4) { const f32x4 l4 = *(const LAS f32x4*)(lp + ((dir * 64 + ip) * 4 + p) * 16 + jj4 * 4);
#pragma unroll
                  for (int e = 0; e < 4; ++e) if (16 * jj4 + 4 * e < ip) part += l4[e] * t[4 * jj4 + e]; }
              part += dpp_xor1(part); part += dpp_xor2(part);
              const float val = ((cc == ip) ? 1.0f : 0.0f) - part; if (p == (ip & 3)) t[ip >> 2] = val; }
#pragma unroll
          for (int jj = 0; jj < 16; ++jj) tm[(dir * 64 + 4 * jj + p) * 64 + cc] = t[jj]; }
        __syncthreads();
#pragma unroll
        for (int k2 = 0; k2 < 2; ++k2) { const int task = tid + 512 * k2, dir = task >> 9, f = (task >> 6) & 7, mt = f >> 1, ks = f & 1; const int i = 16 * mt + c16; float e[8];
#pragma unroll
            for (int j8 = 0; j8 < 8; ++j8) { const int j = 32 * ks + pi_q(q4, j8); e[j8] = dir ? tm[(64 + 63 - i) * 64 + 63 - j] : tm[i * 64 + j]; }
            const v4u val = {cvt_pk_bf16(e[0], e[1]), cvt_pk_bf16(e[2], e[3]), cvt_pk_bf16(e[4], e[5]), cvt_pk_bf16(e[6], e[7])};
            *(v4u*)(ti_u + dir * DN_TI_UD + f * 1024 + lane * 16) = val; }
    }
#undef DNA_STAGE
}

__device__ __forceinline__ bf16x8_t pack_acc2(const pg8::f32x4& a, const pg8::f32x4& b) { const v4u v = {cvt_pk_bf16(a[0], a[1]), cvt_pk_bf16(a[2], a[3]), cvt_pk_bf16(b[0], b[1]), cvt_pk_bf16(b[2], b[3])}; return __builtin_bit_cast(bf16x8_t, v); }
__device__ __forceinline__ void phase_scan(const unsigned char* FRAG, const unsigned char* TI, const bf16* VACC, const float* VEC, bf16* OF, bf16* OB, int S, unsigned char* lds_, int bid, int G, int tid) {
    LAS unsigned char* lds = (LAS unsigned char*)lds_;
    const int lane = tid & 63, w = __builtin_amdgcn_readfirstlane(tid >> 6), c16 = lane & 15, q4 = lane >> 4;
    const int NCH = S >> 6, nchain = (TG / S) * 16;
    constexpr int BUFB = 65536;
    for (int chain = bid; chain < nchain; chain += G) {
        const int dir = chain & 1, h = (chain >> 1) & 7, b = chain >> 4;
        bf16* O = dir ? OB : OF;
        pg8::f32x4 Sacc[8];
#pragma unroll
        for (int T8 = 0; T8 < 8; ++T8) Sacc[T8] = (pg8::f32x4){0.f, 0.f, 0.f, 0.f};
#define DN_STAGE(bufoff, nn) do { const size_t ui_ = ((size_t)(b * NCH + (nn)) * 8 + h); \
            for (int pc = w; pc < 64; pc += NWAVES) { const unsigned char* src = (pc < 48) ? FRAG + ui_ * DN_FRAG_U + pc * 1024 : TI + (ui_ * 2 + dir) * DN_TI_UD + (pc - 48) * 1024; \
                __builtin_amdgcn_global_load_lds((const unsigned*)(src + lane * 16), (LAS unsigned*)(lds + (bufoff) + pc * 1024), 16, 0, 0); } } while (0)
        int n = dir ? NCH - 1 : 0;
        DN_STAGE(0, n);
        v4u vcur0, vcur1; { const v4u* vp = (const v4u*)(VACC + ((((size_t)(b * NCH + n) * 8 + h) * 8 + w) * 64 + lane) * 16); vcur0 = vp[0]; vcur1 = vp[1]; }
        if (w == 0) { const v4u vv = *(const v4u*)(VEC + (((size_t)(b * NCH + n) * 8 + h) * 2 + dir) * DN_VEC_UD + lane * 4); *(LAS v4u*)(lds + 131072 + lane * 16) = vv; }
        __syncthreads();
        int buf = 0;
        for (int step = 0; step < NCH; ++step) {
            const int nn = dir ? n - 1 : n + 1; v4u vn0 = vcur0, vn1 = vcur1;
            v4u vecn = {0u, 0u, 0u, 0u};
            if (step + 1 < NCH) { DN_STAGE((buf ^ 1) * BUFB, nn); const v4u* vp = (const v4u*)(VACC + ((((size_t)(b * NCH + nn) * 8 + h) * 8 + w) * 64 + lane) * 16); vn0 = vp[0]; vn1 = vp[1];  if (w == 0) vecn = *(const v4u*)(VEC + (((size_t)(b * NCH + nn) * 8 + h) * 2 + dir) * DN_VEC_UD + lane * 4); }
            const LAS unsigned char* B0 = lds + buf * BUFB; const LAS float* vec = (const LAS float*)(lds + 131072 + buf * 1024);
#define DN_A(off, fi) (*(const LAS bf16x8_t*)(B0 + (off) + (fi) * 1024 + lane * 16))
            bf16x8_t Sb[4];
#pragma unroll
            for (int ks = 0; ks < 4; ++ks) Sb[ks] = pack_acc2(Sacc[2 * ks], Sacc[2 * ks + 1]);
            pg8::f32x4 X1[4], X2[4];
#pragma unroll
            for (int mt = 0; mt < 4; ++mt) { X1[mt] = (pg8::f32x4){0.f, 0.f, 0.f, 0.f}; X2[mt] = X1[mt];
#pragma unroll
                for (int ks = 0; ks < 4; ++ks) { X1[mt] = __builtin_amdgcn_mfma_f32_16x16x32_bf16(DN_A(0, mt * 4 + ks), Sb[ks], X1[mt], 0, 0, 0); X2[mt] = __builtin_amdgcn_mfma_f32_16x16x32_bf16(DN_A(16384, mt * 4 + ks), Sb[ks], X2[mt], 0, 0, 0); } }
            const unsigned vw[8] = {vcur0.x, vcur0.y, vcur0.z, vcur0.w, vcur1.x, vcur1.y, vcur1.z, vcur1.w};
            pg8::f32x4 Y[4];
#pragma unroll
            for (int mt = 0; mt < 4; ++mt) { const pg8::f32x4 be = *(const LAS pg8::f32x4*)(vec + 16 * mt + 4 * q4), aa = *(const LAS pg8::f32x4*)(vec + 64 + 16 * mt + 4 * q4);
                const pg8::f32x4 vv = {bflo(vw[2 * mt]), bfhi(vw[2 * mt]), bflo(vw[2 * mt + 1]), bfhi(vw[2 * mt + 1])}; Y[mt] = be * vv - aa * X1[mt]; }
            const bf16x8_t Yb0 = pack_acc2(Y[0], Y[1]), Yb1 = pack_acc2(Y[2], Y[3]);
            pg8::f32x4 vn[4];
#pragma unroll
#ifdef PROBE_NOT
            for (int mt = 0; mt < 4; ++mt) vn[mt] = Y[mt];
#else
            for (int mt = 0; mt < 4; ++mt) { vn[mt] = __builtin_amdgcn_mfma_f32_16x16x32_bf16(DN_A(49152, mt * 2), Yb0, (pg8::f32x4){0.f, 0.f, 0.f, 0.f}, 0, 0, 0); vn[mt] = __builtin_amdgcn_mfma_f32_16x16x32_bf16(DN_A(49152, mt * 2 + 1), Yb1, vn[mt], 0, 0, 0); }
#endif
            const bf16x8_t vb0 = pack_acc2(vn[0], vn[1]), vb1 = pack_acc2(vn[2], vn[3]);
            pg8::f32x4 dd[4];
#pragma unroll
            for (int mt = 0; mt < 4; ++mt) { const pg8::f32x4 eg = *(const LAS pg8::f32x4*)(vec + 128 + 16 * mt + 4 * q4); dd[mt] = *(const LAS pg8::f32x4*)(vec + 192 + 16 * mt + 4 * q4);
#ifdef PROBE_NOIT
                pg8::f32x4 o = eg * X2[mt] + vn[mt];
#else
                pg8::f32x4 o = eg * X2[mt]; o = __builtin_amdgcn_mfma_f32_16x16x32_bf16(DN_A(57344, mt * 2), vb0, o, 0, 0, 0); o = __builtin_amdgcn_mfma_f32_16x16x32_bf16(DN_A(57344, mt * 2 + 1), vb1, o, 0, 0, 0);
#endif
                bf16* op = O + ((size_t)(b * S + n * 64 + 16 * mt + 4 * q4)) * 1024 + h * 128 + 16 * w + c16;
#pragma unroll
                for (int r = 0; r < 4; ++r) op[(size_t)r * 1024] = (bf16)(cvt_pk_bf16(o[r], 0.f) & 0xffffu); }
            const bf16x8_t db0 = pack_acc2(dd[0] * vn[0], dd[1] * vn[1]), db1 = pack_acc2(dd[2] * vn[2], dd[3] * vn[3]);
            const float dec = vec[128 + (dir ? 0 : 63)];
#pragma unroll
            for (int T8 = 0; T8 < 8; ++T8) { pg8::f32x4 a = Sacc[T8] * dec; a = __builtin_amdgcn_mfma_f32_16x16x32_bf16(DN_A(32768, T8 * 2), db0, a, 0, 0, 0); a = __builtin_amdgcn_mfma_f32_16x16x32_bf16(DN_A(32768, T8 * 2 + 1), db1, a, 0, 0, 0); Sacc[T8] = a; }
            if (w == 0 && step + 1 < NCH) *(LAS v4u*)(lds + 131072 + (buf ^ 1) * 1024 + lane * 16) = vecn;
            __syncthreads();
            buf ^= 1; n = nn; vcur0 = vn0; vcur1 = vn1;
        }
#undef DN_A
#undef DN_STAGE
    }
}

__device__ __forceinline__ void phase_combine(const Ptrs& P, const bf16* OF, const bf16* OB, const bf16* Z, bf16* DNOUT, int gw, int NGW, int lane) {
    for (int item = gw; item < TG * 8; item += NGW) { const size_t off = (size_t)item * 128 + lane * 2;
        const unsigned a = *(const unsigned*)(OF + off), b = *(const unsigned*)(OB + off), z = *(const unsigned*)(Z + off);
#ifdef PROBE_NODN
        const float o0 = 0.5f + 0.f * bflo(z), o1 = 0.25f;
#else
        const float o0 = bflo(a) + bflo(b), o1 = bfhi(a) + bfhi(b);
#endif
        const float ss = wave_sum(o0 * o0 + o1 * o1); const float rs = rsqrtf(ss * (1.0f / 128.0f) + EPS);
        const float y0 = o0 * rs * P.out_norm_g[lane * 2] * siluf_(bflo(z)), y1 = o1 * rs * P.out_norm_g[lane * 2 + 1] * siluf_(bfhi(z));
        *(unsigned*)(DNOUT + off) = cvt_pk_bf16(y0, y1); }
}

__device__ __forceinline__ float gelu_erf(float v) { const pg8::f32x2 r = pg8::gelu_pk((pg8::f32x2){v, v}); return r.x; }
__device__ __forceinline__ void phase_act_naive(const Ptrs& P, const bf16* UP, bf16* ACT, int S, int gt, int NGT) {
    for (int item = gt; item < TG * (DFF / 8); item += NGT) { const int tok = item / (DFF / 8), c = (item % (DFF / 8)) * 8; const int pos = tok % S;
        float a[8], vv[8];
#pragma unroll
        for (int e = 0; e < 8; ++e) a[e] = P.ffn_conv_b[c + e];
#pragma unroll
        for (int i = 0; i < 3; ++i) { const int p2 = pos + i - 1; if (p2 >= 0 && p2 < S) { float g[8]; load8bf(UP + (size_t)(tok + i - 1) * NUP + c, g);
#pragma unroll
                for (int e = 0; e < 8; ++e) a[e] += g[e] * P.ffn_conv_w[i * DFF + c + e]; } }
        load8bf(UP + (size_t)tok * NUP + DFF + c, vv);
#pragma unroll
        for (int e = 0; e < 8; ++e) a[e] = gelu_erf(a[e]) * vv[e];
        v4u w; w.x = cvt_pk_bf16(a[0], a[1]); w.y = cvt_pk_bf16(a[2], a[3]); w.z = cvt_pk_bf16(a[4], a[5]); w.w = cvt_pk_bf16(a[6], a[7]);
        *(v4u*)(ACT + (size_t)tok * DFF + c) = w; }
}

__device__ __forceinline__ void phase_final(const Ptrs& P, const float* ssq3, int gw, int NGW, int lane) {
    for (int m = gw; m < NTOK; m += NGW) { const float rs = rsqrtf(ssq3[m] * (1.0f / 1024.0f) + EPS); f32x4* xr = (f32x4*)(P.out + (size_t)m * D) + lane; const f32x4* gr = (const f32x4*)P.norm_final_g + lane;
#pragma unroll
        for (int j = 0; j < 4; ++j) { f32x4 y = xr[64 * j] * rs * gr[64 * j];
#ifdef PROBE_NANFIX
            for (int e = 0; e < 4; ++e) if (!(fabsf(y[e]) < 1e30f)) y[e] = 0.f;
#endif
            xr[64 * j] = y; } }
}

typedef __attribute__((address_space(1))) unsigned gu32;
#define RLX_AGENT __ATOMIC_RELAXED, __HIP_MEMORY_SCOPE_AGENT
#define XB_TMO      128
#define XB_XCNT(j)  (256  + 64 * (j))
#define XB_XSUB(j)  (1280 + 64 * (j))
#define XB_XGEN(j)  (2304 + 64 * (j))
#define XB_TOP      3328
#define XB_TOPGEN   3392
#define XCD_BAR_WORDS 3456
#define XB_SPIN_CAP (1u << 18)

__device__ __forceinline__ unsigned xb_ld(unsigned* p)              { return __hip_atomic_load(p, __ATOMIC_RELAXED, __HIP_MEMORY_SCOPE_AGENT); }
__device__ __forceinline__ unsigned xb_add(unsigned* p, unsigned v) { return __hip_atomic_fetch_add(p, v, __ATOMIC_RELAXED, __HIP_MEMORY_SCOPE_AGENT); }
__device__ __forceinline__ unsigned xb_xcc_id() { return (unsigned)__builtin_amdgcn_s_getreg((3 << 11) | 20) & 0xFu; }
#define XB_SPIN(cond, bar) do { unsigned _sp = 0; while (cond) { __builtin_amdgcn_s_sleep(1); \
    if ((++_sp & 255u) == 0u) { if (xb_ld(&(bar)[XB_TMO])) break; if (_sp > XB_SPIN_CAP) { atomicAdd(&(bar)[XB_TMO], 1u); break; } } } } while (0)

struct XcdBarrier {
    unsigned* bar; unsigned x;
    volatile LAS unsigned* st;
};

__device__ __forceinline__ XcdBarrier xcd_barrier_post(unsigned* bar, volatile LAS unsigned* st, int tid) {
    XcdBarrier b; b.bar = bar; b.x = xb_xcc_id(); b.st = st;
    if (tid == 0) (void)xb_add(&bar[XB_XCNT(b.x)], 1u);
    return b;
}
__device__ __forceinline__ void xcd_barrier_complete(unsigned* bar, unsigned x, unsigned& nloc, unsigned& nx) {
    const unsigned G = gridDim.x * gridDim.y * gridDim.z;
    unsigned sum, cnt, mine, sp = 0u;
    for (;;) {
        sum = 0u; cnt = 0u; mine = 0u;
#pragma unroll
        for (unsigned j = 0; j < 16; ++j) { const unsigned c = xb_ld(&bar[XB_XCNT(j)]); sum += c; cnt += (c > 0u) ? 1u : 0u; mine = (j == x) ? c : mine; }
        if (sum == G) break;
        __builtin_amdgcn_s_sleep(1);
        if ((++sp & 255u) == 0u) { if (xb_ld(&bar[XB_TMO])) break; if (sp > XB_SPIN_CAP) { atomicAdd(&bar[XB_TMO], 1u); break; } }
    }
    nloc = mine > 0u ? mine : 1u; nx = cnt > 0u ? cnt : 1u;
}

__device__ __forceinline__ void xcd_barrier(const XcdBarrier& b, int tid) {
    asm volatile("s_waitcnt vmcnt(0)" ::: "memory");
    __syncthreads();
    if (tid == 0) {
        unsigned* bar = b.bar;
        __builtin_amdgcn_s_waitcnt(0);
        unsigned nloc = b.st[0], nx = b.st[1];
        if (nloc == 0u) { xcd_barrier_complete(bar, b.x, nloc, nx); b.st[0] = nloc; b.st[1] = nx; }
        const unsigned old = xb_add(&bar[XB_XSUB(b.x)], 1u);
        const unsigned gen = old / nloc;
        if (old + 1u == (gen + 1u) * nloc) {
            __builtin_amdgcn_fence(__ATOMIC_RELEASE, "agent");
            asm volatile("s_waitcnt vmcnt(0)" ::: "memory");
            const unsigned og = xb_add(&bar[XB_TOP], 1u);
            const unsigned tg = og / nx;
            if (og + 1u == (tg + 1u) * nx) xb_add(&bar[XB_TOPGEN], 1u);
            else XB_SPIN(xb_ld(&bar[XB_TOPGEN]) == tg, bar);
            __builtin_amdgcn_fence(__ATOMIC_ACQUIRE, "agent");
            xb_add(&bar[XB_XGEN(b.x)], 1u);
            asm volatile("s_waitcnt vmcnt(0)" ::: "memory");
        } else {
            XB_SPIN(xb_ld(&bar[XB_XGEN(b.x)]) == gen, bar);
            __builtin_amdgcn_fence(__ATOMIC_ACQUIRE, "agent");
            asm volatile("s_waitcnt vmcnt(0)" ::: "memory");
        }
    }
    __syncthreads();
}

constexpr int LDS_BYTES = 147456;
constexpr int CW_BAR = 4096;
constexpr int STEPS_PER_GROUP = 10, NSTEPS = 1 + NGROUPS * STEPS_PER_GROUP + 1;

#define LDP(i) ((const float*)ap->in[i])
#define MKP() Ptrs P; P.x_p = LDP(0); P.x_s = LDP(1); P.norm_mix_g = LDP(2); P.w_in = LDP(3); P.conv_w = LDP(4); P.a_log_f = LDP(5); P.a_log_b = LDP(6); P.dt_f = LDP(7); P.dt_b = LDP(8); \
        P.out_norm_g = LDP(9); P.w_a = LDP(10); P.w_b = LDP(11); P.w_out = LDP(12); P.norm_ffn_g = LDP(13); P.w_up = LDP(14); P.ffn_conv_w = LDP(15); P.ffn_conv_b = LDP(16); P.w_down = LDP(17); P.norm_final_g = LDP(18); \
        P.out = ap->out; P.ws = ap->ws;
#define WSP ((unsigned char*)ap->ws)
#define ARP (WSP + WS_ARENA)
#define Win ((bf16*)(WSP + WS_WIN))
#define Wup ((bf16*)(WSP + WS_WUP))
#define Wdn ((bf16*)(WSP + WS_WDOWN))
#define Wout ((bf16*)(WSP + WS_WOUT))
#define Wa ((bf16*)(WSP + WS_WA))
#define Wb ((bf16*)(WSP + WS_WB))
#define ropeC ((const float*)(WSP + WS_ROPE))
#define ropeS (ropeC + 4096 * 8)
#define ssq2 ((float*)(WSP + WS_CTL + CTL_SSQ2))
#define ssq3 ((float*)(WSP + WS_CTL + CTL_SSQ3))
#define XBg ((bf16*)(WSP + WS_XB))
#define rstd1 ((const float*)(WSP + WS_RSTD1) + t0)
#define ATT ((bf16*)(ARP + AR_ATT))
#define DNQ ((bf16*)(ARP + AR_DNQ))
#define Z ((bf16*)(ARP + AR_Z))
#define SMALL ((float*)(ARP + AR_SMALL))
#define AO ((bf16*)(ARP + AR_AO))
#define MIX ((bf16*)(ARP + AR_MIX))
#define PO ((bf16*)(ARP + AR_PO))
#define LSE2 ((float*)(ARP + AR_LSE))
#define FRAGP ((unsigned char*)(ARP + AR_FRAG))
#define VACCP ((bf16*)(ARP + AR_VACC))
#define TIP ((unsigned char*)(ARP + AR_TI))
#define VECP ((float*)(ARP + AR_VEC))
#define OF ((bf16*)(ARP + AR_OF))
#define OB ((bf16*)(ARP + AR_OB))
#define DNOUT ((bf16*)(ARP + AR_DNOUT))
#define Gt ((bf16*)(ARP + AR_G))
#define YA ((float*)(ARP + AR_YA))
#define UP ((bf16*)(ARP + AR_UP))
#define ACT ((bf16*)(ARP + AR_ACT))
#define OUTg ((float*)ap->out + (size_t)t0 * D)
#define STEP_PRE() int tid = wave_u * 64 + (int)__builtin_amdgcn_mbcnt_hi(~0u, __builtin_amdgcn_mbcnt_lo(~0u, 0u)), bid = blockIdx.x; typedef const __attribute__((address_space(4))) Args* kargp_t; kargp_t ap = (kargp_t)__builtin_amdgcn_kernarg_segment_ptr(); asm volatile("" : "+v"(tid), "+s"(bid), "+s"(ap)); \
        const int lane = tid & 63, wave = tid >> 6, gw = bid * NWAVES + wave, gt = bid * NTHREADS + tid; (void)lane; (void)wave; (void)gw; (void)gt;
template <int ONLYK, int STEP> __device__ __forceinline__ void run_step(unsigned char* lds, int G, int NGW, int NGT, int wave_u) {
    STEP_PRE();
    constexpr int g = (STEP - 1) / STEPS_PER_GROUP, k = (STEP - 1) % STEPS_PER_GROUP; constexpr int t0 = g * TG; constexpr int S = (g < 2) ? 2048 : 4096;
    if constexpr (STEP == 0) {
        { MKP(); phase_prologue(P, lds, bid, G, tid); }
    } else if constexpr (STEP == NSTEPS - 1) {
        { MKP(); phase_final(P, ssq3, gw, NGW, lane); }
    } else {
            if constexpr (k == 0) {
                pg8::Gemm gm{XBg, Win, TG, NPA, D}; pg8::StaticOrder So; So.init(TG, NPA, G, bid); pg8::EpiProjA E{ATT, DNQ, Z, SMALL, rstd1, ropeC, ropeS, S - 1};
                pg8::gemm_phase<pg8::EpiProjA, pg8::StaticOrder, true, true>((LAS unsigned char*)lds, gm, So, E, tid);
            } else if constexpr (k == 1) {
                phase_attn(ATT, PO, LSE2, S, lds, bid, G, tid);
            } else if constexpr (k == 2) {
                phase_attn_combine(PO, LSE2, AO, gt, NGT); MKP(); phase_dna(P, DNQ, SMALL, FRAGP, VACCP, TIP, VECP, S, lds, bid, G, tid);
#if defined(DUP_PHASE) && DUP_PHASE == 2
                phase_dna(P, DNQ, SMALL, FRAGP, VACCP, TIP, VECP, S, lds, bid, G, tid);
#endif
            } else if constexpr (k == 3) {
                phase_scan(FRAGP, TIP, VACCP, VECP, OF, OB, S, lds, bid, G, tid);
#if defined(DUP_PHASE) && DUP_PHASE == 3
                phase_scan(FRAGP, TIP, VACCP, VECP, OF, OB, S, lds, bid, G, tid);
#endif
            } else if constexpr (k == 4) {
                { MKP(); phase_combine(P, OF, OB, Z, DNOUT, gw, NGW, lane); }
                { pg8::Gemm gm{XBg, Win + (size_t)NPA * D, TG, 2048, D}; pg8::StaticOrder So; So.init(TG, 2048, G, bid); pg8::EpiGates E{Gt, rstd1};
                  pg8::gemm_phase<pg8::EpiGates, pg8::StaticOrder, true, true>((LAS unsigned char*)lds, gm, So, E, tid); }
                { pg8::Gemm gm{AO, Wa, TG, D, 512}; pg8::StaticOrder So; So.init(TG, D, G, bid); pg8::EpiF32 E{YA, D};
                  pg8::gemm_phase<pg8::EpiF32, pg8::StaticOrder, true, true>((LAS unsigned char*)lds, gm, So, E, tid); }
            } else if constexpr (k == 5) {
                pg8::Gemm gm{DNOUT, Wb, TG, D, D}; pg8::StaticOrder So; So.init(TG, D, G, bid); pg8::EpiMix E{Gt, YA, MIX};
                pg8::gemm_phase<pg8::EpiMix, pg8::StaticOrder, true, true>((LAS unsigned char*)lds, gm, So, E, tid);
            } else if constexpr (k == 6) {
                pg8::Gemm gm{MIX, Wout, TG, D, D}; pg8::StaticOrder So; So.init(TG, D, G, bid);
                const float* RES = (g < 2) ? LDP(0) + (size_t)t0 * D : LDP(1); pg8::EpiRes E{RES, OUTg, XBg, ssq2 + t0};
                pg8::gemm_phase<pg8::EpiRes, pg8::StaticOrder, true, true>((LAS unsigned char*)lds, gm, So, E, tid);
            } else if constexpr (k == 7) {
                pg8::Gemm gm{XBg, Wup, TG, NUP, D}; pg8::StaticOrder So; So.init(TG, NUP, G, bid); pg8::EpiUp E{UP, ssq2 + t0};
                pg8::gemm_phase<pg8::EpiUp, pg8::StaticOrder, true, true>((LAS unsigned char*)lds, gm, So, E, tid);
            } else if constexpr (k == 8) {
                MKP(); phase_act_naive(P, UP, ACT, S, gt, NGT);
                if constexpr (g + 1 < NGROUPS) phase_xb(P, g + 1, gw, NGW, lane);
            } else {
                pg8::Gemm gm{ACT, Wdn, TG, D, DFF}; pg8::StaticOrder So; So.init(TG, D, G, bid); pg8::EpiRes E{OUTg, OUTg, nullptr, ssq3 + t0};
                pg8::gemm_phase<pg8::EpiRes, pg8::StaticOrder, true, true>((LAS unsigned char*)lds, gm, So, E, tid);
            }
    }
}
template <int ONLYK, int STEP> __device__ __forceinline__ void run_steps(unsigned char* lds, cg::grid_group& grid, const XcdBarrier& xb, int lo, int hi, int G, int NGW, int NGT, int wave_u) {
    if constexpr (STEP < NSTEPS) {
        if (lo <= STEP && STEP < hi) { run_step<ONLYK, STEP>(lds, G, NGW, NGT, wave_u);
            if (STEP + 1 < hi) {
#if defined(DUP_PHASE) && DUP_PHASE == 5
                grid.sync();
#endif
                if constexpr (STEP == 0) grid.sync();
                else { const int tid = wave_u * 64 + (int)__builtin_amdgcn_mbcnt_hi(~0u, __builtin_amdgcn_mbcnt_lo(~0u, 0u)); xcd_barrier(xb, tid); } } }
        run_steps<ONLYK, STEP + 1>(lds, grid, xb, lo, hi, G, NGW, NGT, wave_u);
    }
}
template <int ONLYK> __global__ void __launch_bounds__(NTHREADS, 2) fwd(Args args) {
    extern __shared__ __attribute__((aligned(16))) unsigned char lds[];
    const int G = gridDim.x, NGW = G * NWAVES, NGT = G * NTHREADS;
    cg::grid_group grid = cg::this_grid();
    const int wave_u = __builtin_amdgcn_readfirstlane((int)threadIdx.x >> 6);
    volatile LAS unsigned* st = (volatile LAS unsigned*)((LAS unsigned char*)lds + LDS_BYTES - 16);
    if (threadIdx.x < 4) st[threadIdx.x] = 0u;
    __syncthreads();
    const XcdBarrier xb = xcd_barrier_post((unsigned*)(args.ws + WS_CTL) + CW_BAR, st, (int)threadIdx.x);
    run_steps<ONLYK, 0>(lds, grid, xb, args.lo, args.hi, G, NGW, NGT, wave_u);
}

extern "C" void kernel_launch(void* const* d_in, const int* in_sizes, int n_in, void* d_out, int out_size, void* d_ws, size_t ws_size, hipStream_t stream) {
    static int grid = 0;
    if (grid == 0) {
        if (n_in != 19 || ws_size < WS_END) { fprintf(stderr, "kernel_launch: unexpected n_in %d / ws_size %zu (need %zu)\n", n_in, ws_size, (size_t)WS_END); grid = -1; return; }
        int dev = 0, cus = 0; (void)hipGetDevice(&dev); (void)hipDeviceGetAttribute(&cus, hipDeviceAttributeMultiprocessorCount, dev);
        if (hipFuncSetAttribute((const void*)fwd<-1>, hipFuncAttributeMaxDynamicSharedMemorySize, LDS_BYTES) != hipSuccess) { fprintf(stderr, "kernel_launch: hipFuncSetAttribute failed\n"); grid = -1; return; }
        int per_cu = 0;
        if (hipOccupancyMaxActiveBlocksPerMultiprocessor(&per_cu, (const void*)fwd<-1>, NTHREADS, LDS_BYTES) != hipSuccess || per_cu < 1) { fprintf(stderr, "kernel_launch: occupancy query failed / %d blocks per CU\n", per_cu); grid = -1; return; }
        grid = cus;
    }
    if (grid < 0) return;
    (void)hipMemsetAsync((char*)d_ws + WS_CTL, 0, CTL_BYTES, stream);
    Args a{};
    for (int i = 0; i < 19; ++i) a.in[i] = (const float*)d_in[i];
    a.out = (float*)d_out; a.ws = (unsigned char*)d_ws;
    a.lo = 0; a.hi = NSTEPS; void* kargs[] = {&a};
    hipError_t e = hipLaunchCooperativeKernel((const void*)fwd<-1>, dim3(grid), dim3(NTHREADS), kargs, LDS_BYTES, stream);
    if (e != hipSuccess) fprintf(stderr, "cooperative launch failed: %s (grid %d)\n", hipGetErrorString(e), grid);
}
```

```cpp
#include <hip/hip_runtime.h>
#include <hip/hip_cooperative_groups.h>
#include <cstdio>
#include <cstdint>
namespace cg = cooperative_groups;
namespace pg8 {
#define PG8_LAS __attribute__((address_space(3)))
typedef unsigned short bf16_t;
typedef short bf16x8 __attribute__((ext_vector_type(8)));
typedef float f32x4 __attribute__((ext_vector_type(4)));
typedef unsigned u32x4 __attribute__((ext_vector_type(4)));
constexpr int BM = 256, BK = 64, HALF = 128, HTB = HALF * BK * 2  , STAGE_BYTES = 8 * HTB, NXCD = 8, WGM = 8;

__host__ __device__ __forceinline__ int lds_byte(int r, int c) { const int st = (r >> 4) * 2 + (c >> 5), rr = r & 15, cc = c & 31, ob = rr * 64 + cc * 2; return st * 1024 + (ob ^ (((ob >> 9) & 1) << 5)); }
__host__ __device__ __forceinline__ void stage_rc(int b, int& R, int& C) { const int st = b / 1024, sb = b % 1024, swz = sb ^ (((sb >> 9) & 1) << 5); R = (st >> 1) * 16 + swz / 64; C = (st & 1) * 32 + (swz % 64) / 2; }
__host__ __device__ __forceinline__ int perm32(int rho) { const int n = rho >> 4, i = rho & 15; return 8 * (i >> 2) + 4 * n + (i & 3); }

struct Unit { int pm, pn; };
struct Gemm { const bf16_t* A; const bf16_t* Bt; int M, N, K; };

struct StaticOrder {
    int nM, nN, nwg, G, c;
    __host__ __device__ void init(int M, int N, int G_, int c_) { nM = M / BM; nN = N / BM; nwg = nM * nN; G = G_; c = c_; }
    __host__ __device__ bool next(int i, Unit& u) const {
        const long L = (long)i * G + c; if (L >= nwg) return false;
        int wgid = (int)L; { const int q = nwg / NXCD, r = nwg % NXCD, xcd = wgid % NXCD, off = wgid / NXCD; wgid = (xcd < r ? xcd * (q + 1) : r * (q + 1) + (xcd - r) * q) + off; }
        const int nig = WGM * nN, gid = wgid / nig, fm = gid * WGM, gsz = (nM - fm) < WGM ? (nM - fm) : WGM;
        u.pm = fm + ((wgid % nig) % gsz); u.pn = (wgid % nig) / gsz; return true;
    }
    __device__ __forceinline__ void a_ready(const Unit&) const {}
    __device__ __forceinline__ void done(const Unit&) const {}
};

typedef float f32x2_cv __attribute__((ext_vector_type(2))); typedef __bf16 bf16x2_cv __attribute__((ext_vector_type(2)));
__device__ __forceinline__ unsigned cvt_pk_bf16(float lo, float hi) { const f32x2_cv v = {lo, hi}; const bf16x2_cv b = __builtin_convertvector(v, bf16x2_cv); return __builtin_bit_cast(unsigned, b); }
typedef float f32x2 __attribute__((ext_vector_type(2)));
typedef unsigned u32x2 __attribute__((ext_vector_type(2)));
__device__ __forceinline__ float bflo(unsigned w) { return __uint_as_float(w << 16); }
__device__ __forceinline__ float bfhi(unsigned w) { return __uint_as_float(w & 0xffff0000u); }
__device__ __forceinline__ float sigmoidf_(float x) { return __builtin_amdgcn_rcpf(1.0f + __expf(-x)); }
constexpr float RMS_EPS = 1e-6f;
__device__ __forceinline__ f32x2 gelu_pk(f32x2 v) {
    const f32x2 av = __builtin_elementwise_abs(v), d = av * 0.2316418882f + 1.0f;
    f32x2 t; t.x = __builtin_amdgcn_rcpf(d.x); t.y = __builtin_amdgcn_rcpf(d.y);
    f32x2 q = t * 0.5307027145f + (-0.7265760135f); q = q * t + 0.7107068705f; q = q * t + (-0.142248368f); q = q * t + 0.127414796f; q = q * t;
    const f32x2 s = (v * v) * (-0.72134752044f);
    f32x2 e; e.x = __builtin_amdgcn_exp2f(s.x); e.y = __builtin_amdgcn_exp2f(s.y);
    const f32x2 m = v * (q * e), r = v - m;
    f32x2 o; o.x = v.x < 0.f ? m.x : r.x; o.y = v.y < 0.f ? m.y : r.y; return o;
}

struct EpiProjA {
    static constexpr bool PERM = true, AFTER_DRAIN = false;
    bf16_t* ATT; bf16_t* DNQ; bf16_t* Z; float* SMALL; const float* rstd; const float* ropeC; const float* ropeS; int smask;
    __device__ __forceinline__ void operator()(const f32x4 (&acc)[2][2][4][2], const Unit& u, int wr, int wc, int fr, int fq) const {
        const int row0 = u.pm * BM + wr * 64 + fr; const int pn = u.pn;
        bf16_t* base; int ldc, colt;
        if (pn < 18) { base = ATT; ldc = 4608; colt = pn * 256; } else if (pn < 30) { base = DNQ; ldc = 3072; colt = (pn - 18) * 256; } else { base = Z; ldc = 1024; colt = (pn - 30) * 256; }
        const int col0 = colt + wc * 32 + 8 * fq;
        const bool do_rope = (pn < 12) && ((wc & 1) == 0);
        const float qs = (pn < 6) ? 0.18033688011112042f : 1.0f;
#pragma unroll
        for (int ai = 0; ai < 2; ++ai)
#pragma unroll
            for (int m = 0; m < 4; ++m) { const int r = row0 + ai * HALF + m * 16; const float rs = rstd[r];
                f32x4 c0 = {1.f, 1.f, 1.f, 1.f}, c1 = c0, s0 = {0.f, 0.f, 0.f, 0.f}, s1 = s0;
                if (do_rope) { const int pos = r & smask; c0 = *(const f32x4*)(ropeC + pos * 8); c1 = *(const f32x4*)(ropeC + pos * 8 + 4); s0 = *(const f32x4*)(ropeS + pos * 8); s1 = *(const f32x4*)(ropeS + pos * 8 + 4);
                    if (fq == 0) { s0 = -s0; s1 = -s1; } if (fq >= 2) { c0 = (f32x4){1.f, 1.f, 1.f, 1.f}; c1 = c0; s0 = (f32x4){0.f, 0.f, 0.f, 0.f}; s1 = s0; } }
#pragma unroll
                for (int bj = 0; bj < 2; ++bj) { f32x4 v0 = acc[ai][bj][m][0] * rs, v1 = acc[ai][bj][m][1] * rs;
                    if (do_rope) { f32x4 p0, p1;
#pragma unroll
                        for (int e = 0; e < 4; ++e) { p0[e] = __shfl_xor(v0[e], 16); p1[e] = __shfl_xor(v1[e], 16); }
                        v0 = v0 * c0 + p0 * s0; v1 = v1 * c1 + p1 * s1; }
                    v0 = v0 * qs; v1 = v1 * qs;
                    if (pn < 34) { u32x4 w; w.x = cvt_pk_bf16(v0[0], v0[1]); w.y = cvt_pk_bf16(v0[2], v0[3]); w.z = cvt_pk_bf16(v1[0], v1[1]); w.w = cvt_pk_bf16(v1[2], v1[3]);
                        *(u32x4*)(base + (size_t)r * ldc + col0 + bj * HALF) = w; }
                    else if (bj == 0 && wc == 0) { float* sp = SMALL + (size_t)r * 32 + 8 * fq; *(f32x4*)sp = v0; *(f32x4*)(sp + 4) = v1; } } }
    }
};
struct EpiGates {
    static constexpr bool PERM = true, AFTER_DRAIN = false;
    bf16_t* G; const float* rstd;
    __device__ __forceinline__ void operator()(const f32x4 (&acc)[2][2][4][2], const Unit& u, int wr, int wc, int fr, int fq) const {
        const int row0 = u.pm * BM + wr * 64 + fr; const int col0 = u.pn * BM + wc * 32 + 8 * fq;
#pragma unroll
        for (int ai = 0; ai < 2; ++ai)
#pragma unroll
            for (int m = 0; m < 4; ++m) { const int r = row0 + ai * HALF + m * 16; const float rs = rstd[r];
#pragma unroll
                for (int bj = 0; bj < 2; ++bj) { const f32x4 v0 = acc[ai][bj][m][0] * rs, v1 = acc[ai][bj][m][1] * rs;
                    u32x4 w; w.x = cvt_pk_bf16(sigmoidf_(v0[0]), sigmoidf_(v0[1])); w.y = cvt_pk_bf16(sigmoidf_(v0[2]), sigmoidf_(v0[3])); w.z = cvt_pk_bf16(sigmoidf_(v1[0]), sigmoidf_(v1[1])); w.w = cvt_pk_bf16(sigmoidf_(v1[2]), sigmoidf_(v1[3]));
                    *(u32x4*)(G + (size_t)r * 2048 + col0 + bj * HALF) = w; } }
    }
};
struct EpiF32 {
    static constexpr bool PERM = false, AFTER_DRAIN = false;
    float* C; int ldc;
    __device__ __forceinline__ void operator()(const f32x4 (&acc)[2][2][4][2], const Unit& u, int wr, int wc, int fr, int fq) const {
        const int row0 = u.pm * BM + wr * 64 + fr, col0 = u.pn * BM + wc * 32 + 4 * fq;
#pragma unroll
        for (int ai = 0; ai < 2; ++ai)
#pragma unroll
            for (int m = 0; m < 4; ++m) { float* rowp = C + (size_t)(row0 + ai * HALF + m * 16) * ldc + col0;
#pragma unroll
                for (int bj = 0; bj < 2; ++bj)
#pragma unroll
                    for (int n = 0; n < 2; ++n) *(f32x4*)(rowp + bj * HALF + n * 16) = acc[ai][bj][m][n]; }
    }
};
struct EpiMix {
    static constexpr bool PERM = true, AFTER_DRAIN = false, HAS_MID = true; static constexpr int MID_T = 8;
    const bf16_t* G; bf16_t* MIX;
    __device__ __forceinline__ void mid(f32x4 (&acc)[2][2][4][2], const Unit& u, int wr, int wc, int fr, int fq) const {
        asm volatile("" : "+v"(fr), "+v"(fq));
        const int row0 = u.pm * BM + wr * 64 + fr; const int col0 = u.pn * BM + wc * 32 + 8 * fq;
#pragma unroll
        for (int ai = 0; ai < 2; ++ai)
#pragma unroll
            for (int m = 0; m < 4; ++m) { const int r = row0 + ai * HALF + m * 16;
#pragma unroll
                for (int bj = 0; bj < 2; ++bj) { const int c = col0 + bj * HALF;
                    const u32x4 ga = *(const u32x4*)(G + (size_t)r * 2048 + c), gb = *(const u32x4*)(G + (size_t)r * 2048 + 1024 + c);
                    f32x4 r0, r1;
                    r0[0] = bflo(ga.x) * __builtin_amdgcn_rcpf(bflo(gb.x)); r0[1] = bfhi(ga.x) * __builtin_amdgcn_rcpf(bfhi(gb.x)); r0[2] = bflo(ga.y) * __builtin_amdgcn_rcpf(bflo(gb.y)); r0[3] = bfhi(ga.y) * __builtin_amdgcn_rcpf(bfhi(gb.y));
                    r1[0] = bflo(ga.z) * __builtin_amdgcn_rcpf(bflo(gb.z)); r1[1] = bfhi(ga.z) * __builtin_amdgcn_rcpf(bfhi(gb.z)); r1[2] = bflo(ga.w) * __builtin_amdgcn_rcpf(bflo(gb.w)); r1[3] = bfhi(ga.w) * __builtin_amdgcn_rcpf(bfhi(gb.w));
                    acc[ai][bj][m][0] = acc[ai][bj][m][0] * r0; acc[ai][bj][m][1] = acc[ai][bj][m][1] * r1; }
                asm volatile("" ::: "memory"); }
    }
    __device__ __forceinline__ void operator()(const f32x4 (&acc)[2][2][4][2], const Unit& u, int wr, int wc, int fr, int fq) const {
        const int row0 = u.pm * BM + wr * 64 + fr; const int col0 = u.pn * BM + wc * 32 + 8 * fq;
#pragma unroll
        for (int ai = 0; ai < 2; ++ai)
#pragma unroll
            for (int m = 0; m < 4; ++m) { const int r = row0 + ai * HALF + m * 16;
#pragma unroll
                for (int bj = 0; bj < 2; ++bj) { const int c = col0 + bj * HALF;
                    const u32x4 gb = *(const u32x4*)(G + (size_t)r * 2048 + 1024 + c);
                    const f32x4 a0 = acc[ai][bj][m][0], a1 = acc[ai][bj][m][1];
                    u32x4 w;
                    w.x = cvt_pk_bf16(bflo(gb.x) * a0[0], bfhi(gb.x) * a0[1]); w.y = cvt_pk_bf16(bflo(gb.y) * a0[2], bfhi(gb.y) * a0[3]);
                    w.z = cvt_pk_bf16(bflo(gb.z) * a1[0], bfhi(gb.z) * a1[1]); w.w = cvt_pk_bf16(bflo(gb.w) * a1[2], bfhi(gb.w) * a1[3]);
                    *(u32x4*)(MIX + (size_t)r * 1024 + c) = w; } }
    }
};
struct EpiRes {
    static constexpr bool PERM = false, AFTER_DRAIN = false;
    const float* RES; float* OUT; bf16_t* XB; float* ssq;
    __device__ __forceinline__ void operator()(const f32x4 (&acc)[2][2][4][2], const Unit& u, int wr, int wc, int fr, int fq) const {
        const int row0 = u.pm * BM + wr * 64 + fr, col0 = u.pn * BM + wc * 32 + 4 * fq;
#pragma unroll
        for (int ai = 0; ai < 2; ++ai)
#pragma unroll
            for (int m = 0; m < 4; ++m) { const int r = row0 + ai * HALF + m * 16; const size_t off = (size_t)r * 1024 + col0; float s = 0.f;
#pragma unroll
                for (int bj = 0; bj < 2; ++bj)
#pragma unroll
                    for (int n = 0; n < 2; ++n) { const size_t o2 = off + bj * HALF + n * 16; const f32x4 v = *(const f32x4*)(RES + o2) + acc[ai][bj][m][n];
                        *(f32x4*)(OUT + o2) = v; s += (v[0] * v[0] + v[1] * v[1]) + (v[2] * v[2] + v[3] * v[3]);
                        if (XB) { u32x2 w; w.x = cvt_pk_bf16(v[0], v[1]); w.y = cvt_pk_bf16(v[2], v[3]); *(u32x2*)(XB + o2) = w; } }
                s += __shfl_xor(s, 16); s += __shfl_xor(s, 32);
                if (fq == 0) atomicAdd(ssq + r, s); }
    }
};
__device__ __forceinline__ float dpp_ror1(float x) { return __int_as_float(__builtin_amdgcn_mov_dpp(__float_as_int(x), 0x121, 0xF, 0xF, true)); }
__device__ __forceinline__ float dpp_ror15(float x) { return __int_as_float(__builtin_amdgcn_mov_dpp(__float_as_int(x), 0x12F, 0xF, 0xF, true)); }
struct EpiUpAct {
    static constexpr bool PERM = true, AFTER_DRAIN = false;
    bf16_t* ACT; float* EDGE; const float* ssq; const float* cw; const float* cb; PG8_LAS unsigned char* ldsb;
    __device__ __forceinline__ void operator()(const f32x4 (&acc)[2][2][4][2], const Unit& u, int wr, int wc, int fr, int fq) const {
        const int cin0 = wc * 32 + 8 * fq, col = u.pn * 128 + cin0;
        PG8_LAS float* EX = (PG8_LAS float*)(ldsb + 131072);
        float* edge = EDGE + ((size_t)u.pm * 22 + u.pn) * 768;
        f32x4 g[2][4][2], v[2][4][2];
#pragma unroll
        for (int ai = 0; ai < 2; ++ai)
#pragma unroll
            for (int m = 0; m < 4; ++m) { const int r = u.pm * BM + ai * HALF + wr * 64 + m * 16 + fr; const float rs = rsqrtf(ssq[r] * (1.0f / 1024.0f) + RMS_EPS);
#pragma unroll
                for (int n = 0; n < 2; ++n) { g[ai][m][n] = acc[ai][0][m][n] * rs; v[ai][m][n] = acc[ai][1][m][n] * rs; } }
#pragma unroll
        for (int ai = 0; ai < 2; ++ai) { const int ci = 2 * ai + wr;
            if (fr == 0) { *(PG8_LAS f32x4*)(EX + (ci * 2 + 0) * 128 + cin0) = g[ai][0][0]; *(PG8_LAS f32x4*)(EX + (ci * 2 + 0) * 128 + cin0 + 4) = g[ai][0][1]; }
            if (fr == 15) { *(PG8_LAS f32x4*)(EX + (ci * 2 + 1) * 128 + cin0) = g[ai][3][0]; *(PG8_LAS f32x4*)(EX + (ci * 2 + 1) * 128 + cin0 + 4) = g[ai][3][1]; } }
        if (wr == 0 && fr <= 1) { *(f32x4*)(edge + fr * 128 + cin0) = g[0][0][0]; *(f32x4*)(edge + fr * 128 + cin0 + 4) = g[0][0][1]; }
        if (wr == 1 && fr >= 14) { *(f32x4*)(edge + (fr - 12) * 128 + cin0) = g[1][3][0]; *(f32x4*)(edge + (fr - 12) * 128 + cin0 + 4) = g[1][3][1]; }
        if (wr == 0 && fr == 0) { *(f32x4*)(edge + 4 * 128 + cin0) = v[0][0][0]; *(f32x4*)(edge + 4 * 128 + cin0 + 4) = v[0][0][1]; }
        if (wr == 1 && fr == 15) { *(f32x4*)(edge + 5 * 128 + cin0) = v[1][3][0]; *(f32x4*)(edge + 5 * 128 + cin0 + 4) = v[1][3][1]; }
        f32x4 w0[2], w1[2], w2[2], bb[2];
#pragma unroll
        for (int n = 0; n < 2; ++n) { w0[n] = *(const f32x4*)(cw + col + 4 * n); w1[n] = *(const f32x4*)(cw + 2816 + col + 4 * n); w2[n] = *(const f32x4*)(cw + 2 * 2816 + col + 4 * n); bb[n] = *(const f32x4*)(cb + col + 4 * n); }
        asm volatile("s_waitcnt lgkmcnt(0)" ::: "memory"); __builtin_amdgcn_s_barrier(); asm volatile("" ::: "memory");
#pragma unroll
        for (int ai = 0; ai < 2; ++ai) { const int ci = 2 * ai + wr; f32x4 topn[2], botn[2];
#pragma unroll
            for (int n = 0; n < 2; ++n) { topn[n] = (ci > 0) ? *(const PG8_LAS f32x4*)(EX + ((ci - 1) * 2 + 1) * 128 + cin0 + 4 * n) : (f32x4){0.f, 0.f, 0.f, 0.f};
                botn[n] = (ci < 3) ? *(const PG8_LAS f32x4*)(EX + ((ci + 1) * 2 + 0) * 128 + cin0 + 4 * n) : (f32x4){0.f, 0.f, 0.f, 0.f}; }
#pragma unroll
            for (int m = 0; m < 4; ++m) { const int r = u.pm * BM + ai * HALF + wr * 64 + m * 16 + fr; float o[8];
#pragma unroll
                for (int n = 0; n < 2; ++n)
#pragma unroll
                    for (int e2 = 0; e2 < 4; e2 += 2) { f32x2 gc;
#pragma unroll
                        for (int k = 0; k < 2; ++k) { const int e = e2 + k; const float gm = g[ai][m][n][e];
                            const float a1 = dpp_ror1(gm), b1 = (m > 0) ? dpp_ror1(g[ai][m > 0 ? m - 1 : 0][n][e]) : topn[n][e]; const float up = (fr == 0) ? b1 : a1;
                            const float a2 = dpp_ror15(gm), b2 = (m < 3) ? dpp_ror15(g[ai][m < 3 ? m + 1 : 3][n][e]) : botn[n][e]; const float dn = (fr == 15) ? b2 : a2;
                            gc[k] = bb[n][e] + w0[n][e] * up + w1[n][e] * gm + w2[n][e] * dn; }
                        const f32x2 ge = gelu_pk(gc); o[4 * n + e2] = ge.x * v[ai][m][n][e2]; o[4 * n + e2 + 1] = ge.y * v[ai][m][n][e2 + 1]; }
                u32x4 w; w.x = cvt_pk_bf16(o[0], o[1]); w.y = cvt_pk_bf16(o[2], o[3]); w.z = cvt_pk_bf16(o[4], o[5]); w.w = cvt_pk_bf16(o[6], o[7]);
                *(u32x4*)(ACT + (size_t)r * 2816 + col) = w; } }
    }
};
template <class T, class = void> struct has_mid { static constexpr bool value = false; };
template <class T> struct has_mid<T, decltype((void)T::HAS_MID)> { static constexpr bool value = true; };
template <class Epi, class Sched, bool ALIGN_EPI = false, bool SP2 = false>
__device__ __forceinline__ void gemm_phase(PG8_LAS unsigned char* lds, const Gemm g, const Sched& S, const Epi& E, int tid_) {
    asm volatile("" : "+v"(tid_)); const int tid = tid_, wid = __builtin_amdgcn_readfirstlane(tid >> 6), lane = tid & 63, wr = wid >> 2, wc = wid & 3, fr = lane & 15, fq = lane >> 4;
    const int K = g.K, nt = K / BK;
    unsigned voffA[2], voffB[2];
#pragma unroll
    for (int i = 0; i < 2; ++i) { int R, C; stage_rc(tid * 16 + i * 8192, R, C); const int Rb = Epi::PERM ? ((R & ~31) + perm32(R & 31)) : R;
        voffA[i] = (unsigned)(R * K + C) * 2u; voffB[i] = (unsigned)(Rb * K + C) * 2u; }
    const size_t kstep = (size_t)(BK * 2);
    const size_t hstep = (size_t)HALF * K * 2;
    const size_t tstep = 2 * hstep;
    const unsigned ldsw = (unsigned)wid * 1024u;
    const int aoff = lds_byte(wr * 64 + fr, fq * 8), boff = lds_byte(wc * 32 + fr, fq * 8);
#define PG8_SA(b, h) (((b) * 2 + (h)) * HTB)
#define PG8_SB(b, h) ((4 + (b) * 2 + (h)) * HTB)
#define PG8_STAGE(bufoff, gbase, voff) do { _Pragma("unroll") for (int _i = 0; _i < 2; ++_i) \
        __builtin_amdgcn_global_load_lds((const unsigned*)((const char*)(gbase) + (voff)[_i]), (PG8_LAS unsigned*)(lds + (bufoff) + ldsw + _i * 8192), 16, 0, 0); } while (0)
#define PG8_LDA(dst, b, h) do { _Pragma("unroll") for (int m = 0; m < 4; ++m) _Pragma("unroll") for (int k = 0; k < 2; ++k) dst[m][k] = *(const PG8_LAS bf16x8*)(lds + PG8_SA(b, h) + aoff + m * 2048 + k * 1024); } while (0)
#define PG8_LDB(dst, b, h) do { _Pragma("unroll") for (int n = 0; n < 2; ++n) _Pragma("unroll") for (int k = 0; k < 2; ++k) dst[n][k] = *(const PG8_LAS bf16x8*)(lds + PG8_SB(b, h) + boff + n * 2048 + k * 1024); } while (0)
#define PG8_MMA(ai, bj, At, Bt) do { __builtin_amdgcn_s_setprio(1); _Pragma("unroll") for (int m = 0; m < 4; ++m) _Pragma("unroll") for (int n = 0; n < 2; ++n) _Pragma("unroll") for (int k = 0; k < 2; ++k) \
        acc[ai][bj][m][n] = __builtin_amdgcn_mfma_f32_16x16x32_bf16(Bt[n][k], At[m][k], acc[ai][bj][m][n], 0, 0, 0); __builtin_amdgcn_s_setprio(0); } while (0)
#define PG8_WAIT_V(n) asm volatile("s_waitcnt vmcnt(" #n ")" ::: "memory")
#define PG8_WAIT_L(n) asm volatile("s_waitcnt lgkmcnt(" #n ")" ::: "memory")
#define PG8_BAR __builtin_amdgcn_s_barrier()
#define PG8_SCHED __builtin_amdgcn_sched_barrier(0)
    Unit cur, nxt; int ui = 0;
    if (!S.next(0, cur)) return;
    f32x4 acc[2][2][4][2];
    f32x4 zz_ = (f32x4){0.f, 0.f, 0.f, 0.f}; asm volatile("" : "+v"(zz_));
#pragma unroll
    for (int a = 0; a < 2; ++a)
#pragma unroll
        for (int b = 0; b < 2; ++b)
#pragma unroll
            for (int m = 0; m < 4; ++m)
#pragma unroll
                for (int n = 0; n < 2; ++n) acc[a][b][m][n] = zz_;
    bf16x8 At[4][2], B0[2][2], B1[2][2];
    const char* cA = (const char*)g.A + (size_t)cur.pm * tstep; const char* cB = (const char*)g.Bt + (size_t)cur.pn * tstep;
    S.a_ready(cur);
    if constexpr (SP2) {
        PG8_STAGE(PG8_SB(0, 0), cB, voffB); PG8_STAGE(PG8_SB(0, 1), cB + hstep, voffB); PG8_STAGE(PG8_SA(0, 0), cA, voffA); PG8_STAGE(PG8_SA(0, 1), cA + hstep, voffA);
        if (wr == 1) PG8_BAR;
        PG8_WAIT_V(2); PG8_BAR;
        PG8_STAGE(PG8_SB(1, 0), cB + kstep, voffB); PG8_STAGE(PG8_SA(1, 0), cA + kstep, voffA); PG8_STAGE(PG8_SB(1, 1), cB + hstep + kstep, voffB);
        PG8_WAIT_V(6); PG8_BAR;
    } else {
        PG8_STAGE(PG8_SB(0, 0), cB, voffB); PG8_STAGE(PG8_SA(0, 0), cA, voffA); PG8_STAGE(PG8_SB(0, 1), cB + hstep, voffB); PG8_STAGE(PG8_SA(0, 1), cA + hstep, voffA);
        if (wr == 1) PG8_BAR;
        PG8_WAIT_V(4); PG8_BAR;
        PG8_STAGE(PG8_SB(1, 0), cB + kstep, voffB); PG8_STAGE(PG8_SA(1, 0), cA + kstep, voffA); PG8_STAGE(PG8_SB(1, 1), cB + hstep + kstep, voffB);
        PG8_WAIT_V(6); PG8_BAR;
    }
    for (;;) {
        const bool has_next = S.next(ui + 1, nxt);
        const char* nA = has_next ? (const char*)g.A + (size_t)nxt.pm * tstep : cA; const char* nB = has_next ? (const char*)g.Bt + (size_t)nxt.pn * tstep : cB;
        for (int t = 0; t < nt; t += 2) {
            if constexpr (has_mid<Epi>::value) { if (t == Epi::MID_T) E.mid(acc, cur, wr, wc, fr, fq); }
            const bool last = (t == nt - 2);
            const char* a1 = cA + (size_t)(t + 1) * kstep;
            const char* a2 = last ? nA : cA + (size_t)(t + 2) * kstep; const char* b2 = last ? nB : cB + (size_t)(t + 2) * kstep;
            const char* a3 = a2 + kstep; const char* b3 = b2 + kstep;
            if (last && has_next) S.a_ready(nxt);
            if constexpr (SP2) {
            PG8_LDB(B0, 0, 0); PG8_LDB(B1, 0, 1); PG8_SCHED; PG8_LDA(At, 0, 0); PG8_STAGE(PG8_SA(1, 1), a1 + hstep, voffA);
            PG8_WAIT_V(8); PG8_WAIT_L(0); PG8_BAR; PG8_MMA(0, 0, At, B0); PG8_MMA(0, 1, At, B1); PG8_BAR; PG8_SCHED;
            PG8_LDA(At, 0, 1); PG8_STAGE(PG8_SB(0, 0), b2, voffB); PG8_STAGE(PG8_SB(0, 1), b2 + hstep, voffB); PG8_STAGE(PG8_SA(0, 0), a2, voffA);
            PG8_WAIT_V(8); PG8_WAIT_L(0); PG8_BAR; PG8_MMA(1, 0, At, B0); PG8_MMA(1, 1, At, B1); PG8_BAR; PG8_SCHED;
            PG8_LDB(B0, 1, 0); PG8_LDB(B1, 1, 1); PG8_SCHED; PG8_LDA(At, 1, 0); PG8_STAGE(PG8_SA(0, 1), a2 + hstep, voffA);
            PG8_WAIT_V(8); PG8_WAIT_L(0); PG8_BAR; PG8_MMA(0, 0, At, B0); PG8_MMA(0, 1, At, B1); PG8_BAR; PG8_SCHED;
            PG8_LDA(At, 1, 1); PG8_STAGE(PG8_SB(1, 0), b3, voffB); PG8_STAGE(PG8_SB(1, 1), b3 + hstep, voffB); PG8_STAGE(PG8_SA(1, 0), a3, voffA);
            PG8_WAIT_V(8); PG8_WAIT_L(0); PG8_BAR; PG8_MMA(1, 0, At, B0); PG8_MMA(1, 1, At, B1); PG8_BAR; PG8_SCHED;
            } else {
            PG8_LDB(B0, 0, 0); PG8_SCHED; PG8_LDA(At, 0, 0); PG8_STAGE(PG8_SA(1, 1), a1 + hstep, voffA);
            PG8_WAIT_L(8); PG8_BAR; PG8_WAIT_L(0); PG8_MMA(0, 0, At, B0); PG8_BAR; PG8_SCHED;
            PG8_LDB(B1, 0, 1); PG8_STAGE(PG8_SB(0, 0), b2, voffB);
            PG8_BAR; PG8_WAIT_L(0); PG8_MMA(0, 1, At, B1); PG8_BAR;
            PG8_LDA(At, 0, 1); PG8_STAGE(PG8_SA(0, 0), a2, voffA);
            PG8_BAR; PG8_WAIT_L(0); PG8_MMA(1, 0, At, B0); PG8_BAR; PG8_SCHED;
            PG8_STAGE(PG8_SB(0, 1), b2 + hstep, voffB);
            PG8_WAIT_V(6); PG8_BAR; PG8_MMA(1, 1, At, B1); PG8_BAR;
            PG8_LDB(B0, 1, 0); PG8_SCHED; PG8_LDA(At, 1, 0); PG8_STAGE(PG8_SA(0, 1), a2 + hstep, voffA);
            PG8_WAIT_L(8); PG8_BAR; PG8_WAIT_L(0); PG8_MMA(0, 0, At, B0); PG8_BAR; PG8_SCHED;
            PG8_LDB(B1, 1, 1); PG8_STAGE(PG8_SB(1, 0), b3, voffB);
            PG8_BAR; PG8_WAIT_L(0); PG8_MMA(0, 1, At, B1); PG8_BAR;
            PG8_LDA(At, 1, 1); PG8_STAGE(PG8_SA(1, 0), a3, voffA);
            PG8_BAR; PG8_WAIT_L(0); PG8_MMA(1, 0, At, B0); PG8_BAR; PG8_SCHED;
            PG8_STAGE(PG8_SB(1, 1), b3 + hstep, voffB);
            PG8_WAIT_V(6); PG8_BAR; PG8_MMA(1, 1, At, B1); PG8_BAR;
            }
        }
        if constexpr (ALIGN_EPI) { if (wr == 0) PG8_BAR; }
        if constexpr (!Epi::AFTER_DRAIN) { E(acc, cur, wr, wc, fr, fq); S.done(cur); }
        if (!has_next) break;
        zz_ = (f32x4){0.f, 0.f, 0.f, 0.f}; asm volatile("" : "+v"(zz_));
#pragma unroll
        for (int a = 0; a < 2; ++a)
#pragma unroll
            for (int b = 0; b < 2; ++b)
#pragma unroll
                for (int m = 0; m < 4; ++m)
#pragma unroll
                    for (int n = 0; n < 2; ++n) acc[a][b][m][n] = zz_;
        cur = nxt; cA = nA; cB = nB; ++ui;
        if constexpr (ALIGN_EPI) { if (wr == 1) PG8_BAR; }
    }
    PG8_WAIT_V(0);
    if constexpr (!ALIGN_EPI) { if (wr == 0) PG8_BAR; }
    PG8_BAR;
    if constexpr (Epi::AFTER_DRAIN) { E.fused(acc, cur, wr, wc, fr, fq, lds, wid, lane); S.done(cur); }
#undef PG8_SA
#undef PG8_SB
#undef PG8_STAGE
#undef PG8_LDA
#undef PG8_LDB
#undef PG8_MMA
#undef PG8_WAIT_V
#undef PG8_WAIT_L
#undef PG8_BAR
#undef PG8_SCHED
}
}

#define LAS __attribute__((address_space(3)))
typedef unsigned short bf16;
typedef float f32x4 __attribute__((ext_vector_type(4)));
typedef unsigned v4u __attribute__((ext_vector_type(4)));
typedef unsigned v2u __attribute__((ext_vector_type(2)));
using pg8::cvt_pk_bf16; using pg8::bflo; using pg8::bfhi;

constexpr int NWAVES = 8, NTHREADS = 512;
constexpr int D = 1024, NTOK = 49152, TG = 16384, NGROUPS = 3;
constexpr int ATTW = 4608, DNW = 3072, NPA = 8960  , NIN_T = 11008, DFF = 2816, NUP = 5632;
constexpr float EPS = 1e-6f;

constexpr size_t MiB = 1u << 20;
constexpr size_t WS_CTL = 0, CTL_BYTES = 1 * MiB;
constexpr size_t CTL_SSQ2 = 256 * 1024, CTL_SSQ3 = 512 * 1024;
constexpr size_t WS_WIN = 1 * MiB, WS_WUP = 23 * MiB, WS_WDOWN = 34 * MiB, WS_WOUT = 40 * MiB, WS_WA = 42 * MiB, WS_WB = 43 * MiB;
constexpr size_t WS_ROPE = 45 * MiB, WS_RSTD1 = 46 * MiB, WS_XB = 48 * MiB  , WS_ARENA = 80 * MiB, WS_END = 512 * MiB;
constexpr size_t AR_ATT = 0, AR_DNQ = 144 * MiB, AR_Z = 240 * MiB, AR_SMALL = 272 * MiB, AR_AO = 274 * MiB, AR_PO = 290 * MiB, AR_LSE = 338 * MiB, AR_MIX = 290 * MiB;
constexpr size_t AR_FRAG = 0, AR_VACC = 96 * MiB, AR_TI = 340 * MiB, AR_VEC = 404 * MiB;
constexpr size_t AR_OF = 144 * MiB, AR_OB = 176 * MiB, AR_DNOUT = 208 * MiB;
constexpr size_t AR_G = 0, AR_YA = 64 * MiB;
constexpr size_t AR_UP = 0, AR_ACT = 176 * MiB;
static_assert(WS_ARENA + AR_VEC + 8 * MiB <= WS_END, "ws map");

struct Args { const float* in[19]; float* out; unsigned char* ws; int lo, hi; };

__device__ __forceinline__ float wave_sum(float v) {
#pragma unroll
    for (int o = 1; o < 64; o <<= 1) v += __shfl_xor(v, o);
    return v;
}
__device__ __forceinline__ float bf2f(bf16 u) { return __uint_as_float((unsigned)u << 16); }
__device__ __forceinline__ float siluf_(float x) { return x * __builtin_amdgcn_rcpf(1.0f + __expf(-x)); }

__device__ __forceinline__ void p0_transpose_item(const float* W, int ldw, int col_off, int K, int ncols, const float* gain, bf16* WT, int row_off, LAS float* scr, int item, int lane, int ldt = 0, int kofs = 0) {
    if (ldt == 0) ldt = K;
    const int nblk = ncols / 32, kb = item / nblk, nb = item % nblk, k0 = 64 * kb, n0 = 32 * nb;
#pragma unroll 8
    for (int i = 0; i < 32; ++i) { const int kk = 2 * i + (lane >> 5); float w = W[(size_t)(k0 + kk) * ldw + col_off + n0 + (lane & 31)]; if (gain) w *= gain[k0 + kk]; scr[kk * 33 + (lane & 31)] = w; }
    asm volatile("s_waitcnt lgkmcnt(0)" ::: "memory");
    const int c = lane & 7;
#pragma unroll
    for (int j = 0; j < 4; ++j) { const int n = (lane >> 3) + 8 * j; const LAS float* s = scr + (8 * c) * 33 + n;
        v4u o; o.x = cvt_pk_bf16(s[0 * 33], s[1 * 33]); o.y = cvt_pk_bf16(s[2 * 33], s[3 * 33]); o.z = cvt_pk_bf16(s[4 * 33], s[5 * 33]); o.w = cvt_pk_bf16(s[6 * 33], s[7 * 33]);
        *(v4u*)(WT + (size_t)(row_off + n0 + n) * ldt + kofs + k0 + 8 * c) = o; }
    asm volatile("s_waitcnt lgkmcnt(0)" ::: "memory");
}

struct Ptrs {
    const float *x_p, *x_s, *norm_mix_g, *w_in, *conv_w, *a_log_f, *a_log_b, *dt_f, *dt_b, *out_norm_g, *w_a, *w_b, *w_out, *norm_ffn_g, *w_up, *ffn_conv_w, *ffn_conv_b, *w_down, *norm_final_g;
    float* out; unsigned char* ws;
};
__device__ __forceinline__ const float* x_row(const Ptrs& P, int tok) { return tok < 32768 ? P.x_p + (size_t)tok * D : P.x_s + (size_t)(tok - 32768) * D; }

__device__ __forceinline__ void phase_xb(const Ptrs& P, int g, int gw, int NGW, int lane) {
    bf16* XB = (bf16*)(P.ws + WS_XB); float* rstd1 = (float*)(P.ws + WS_RSTD1);
    for (int m = gw; m < TG; m += NGW) {
        const f32x4* xr = (const f32x4*)x_row(P, g * TG + m) + lane; f32x4 v[4]; float s = 0.f;
#pragma unroll
        for (int j = 0; j < 4; ++j) { v[j] = xr[64 * j]; s += (v[j].x * v[j].x + v[j].y * v[j].y) + (v[j].z * v[j].z + v[j].w * v[j].w); }
        s = wave_sum(s);
        if (lane == 0) rstd1[g * TG + m] = rsqrtf(s * (1.0f / 1024.0f) + EPS);
        unsigned long long* o8 = (unsigned long long*)(XB + (size_t)m * D) + lane;
#pragma unroll
        for (int j = 0; j < 4; ++j) o8[64 * j] = (unsigned long long)cvt_pk_bf16(v[j].x, v[j].y) | ((unsigned long long)cvt_pk_bf16(v[j].z, v[j].w) << 32);
    }
}
template <int PART> __device__ __forceinline__ void phase_prologue(const Ptrs& P, unsigned char* lds, int bid, int G, int tid) {
    const int lane = tid & 63, wave = tid >> 6;
    LAS float* scr = (LAS float*)((LAS unsigned char*)lds + wave * 16384);
    const int gw = bid * NWAVES + wave, NGW = G * NWAVES;
    bf16* Win = (bf16*)(P.ws + WS_WIN); bf16* Wup = (bf16*)(P.ws + WS_WUP); bf16* Wdn = (bf16*)(P.ws + WS_WDOWN); bf16* Wout = (bf16*)(P.ws + WS_WOUT); bf16* Wa = (bf16*)(P.ws + WS_WA); bf16* Wb = (bf16*)(P.ws + WS_WB);
    constexpr int I1 = 16 * 273, I2 = 16 * 64, I3 = 8 * 32, I4 = 16 * 32, I5 = 16 * 32, I6 = 16 * 176, I7 = 44 * 32;
    constexpr int NIT = I1 + I2 + I3 + I4 + I5 + I6 + I7;
    for (int it = gw + (PART == 0 ? 0 : I1 + I2); it < (PART == 0 ? I1 + I2 : NIT); it += NGW) {
        int r = it;
        if (r < I1) { p0_transpose_item(P.w_in, 10784, 0, 1024, 8736, P.norm_mix_g, Win, 0, scr, r, lane); continue; } r -= I1;
        if (r < I2) { p0_transpose_item(P.w_in, 10784, 8736, 1024, 2048, P.norm_mix_g, Win, 8960, scr, r, lane); continue; } r -= I2;
        if (r < I3) { p0_transpose_item(P.w_a, 1024, 0, 512, 1024, nullptr, Wa, 0, scr, r, lane, 1536, 0); continue; } r -= I3;
        if (r < I4) { p0_transpose_item(P.w_b, 1024, 0, 1024, 1024, nullptr, Wa, 0, scr, r, lane, 1536, 512); continue; } r -= I4;
        if (r < I5) { p0_transpose_item(P.w_out, 1024, 0, 1024, 1024, nullptr, Wout, 0, scr, r, lane); continue; } r -= I5;
        if (r < I6) { const int seg = r >> 6, pn = seg >> 1, isval = seg & 1;
            p0_transpose_item(P.w_up, 5632, isval * 2816 + pn * 128, 1024, 128, P.norm_ffn_g, Wup, pn * 256 + isval * 128, scr, r & 63, lane); continue; } r -= I6;
        p0_transpose_item(P.w_down, 1024, 0, 2816, 1024, nullptr, Wdn, 0, scr, r, lane);
    }
    if constexpr (PART == 1) return;
    const int gt = bid * NTHREADS + tid, NGT = G * NTHREADS;
    for (int i = gt; i < 28672; i += NGT) ((v4u*)(Win + (size_t)8736 * 1024))[i] = (v4u){0u, 0u, 0u, 0u};
    float* ropeC = (float*)(P.ws + WS_ROPE); float* ropeS = ropeC + 4096 * 8;
    for (int i = gt; i < 4096 * 8; i += NGT) { const int pos = i >> 3, j = i & 7;
        const float invt[8] = {1.0f, 0.19392274f, 0.03760603f, 0.0072926646f, 0.0014142136f, 0.0002742482f, 5.3182957e-05f, 1.0313385e-05f};
        const float inv = invt[j]; const float ang = (float)pos * inv;
        const float c_hi = 0.15915494f, c_lo = 6.4206382e-09f;
        const float kq = rintf(ang * c_hi); float r = fmaf(ang, c_hi, -kq); r = fmaf(ang, c_lo, r);
        ropeC[i] = __builtin_amdgcn_cosf(r); ropeS[i] = __builtin_amdgcn_sinf(r); }
    phase_xb(P, 0, gw, NGW, lane);
}

__device__ __forceinline__ void load8bf(const bf16* p, float* o) { const v4u w = *(const v4u*)p; o[0] = bflo(w.x); o[1] = bfhi(w.x); o[2] = bflo(w.y); o[3] = bfhi(w.y); o[4] = bflo(w.z); o[5] = bfhi(w.z); o[6] = bflo(w.w); o[7] = bfhi(w.w); }
typedef short bf16x8_t __attribute__((ext_vector_type(8)));
typedef float f32x16 __attribute__((ext_vector_type(16)));
typedef short s16x4_t __attribute__((ext_vector_type(4)));
struct AttU { int h, dil, L, seq0, two, r0, p0, sbase, nrows; };
__device__ __forceinline__ AttU att_decode(int u, int S, int NU) { AttU a; const int idx = u % NU, bh = u / NU; a.h = bh % 24; const int b = bh / 24, gi = a.h >> 3; a.dil = (gi == 0) ? 1 : (gi == 1) ? 4 : 16; a.L = S / a.dil; a.seq0 = b * S;
    a.two = (a.L < 256); a.r0 = a.two ? 2 * idx : idx % a.dil; a.p0 = a.two ? 0 : (idx / a.dil) * 256; a.sbase = a.two ? 0 : a.p0 - 64; a.nrows = a.two ? 256 : 384; return a; }
__device__ __forceinline__ void phase_attn(const bf16* ATT, bf16* PO, float* LSE, int S, unsigned char* lds_, int bid, int G, int tid) {
    LAS unsigned char* lds = (LAS unsigned char*)lds_;
    const int lane = tid & 63, w = __builtin_amdgcn_readfirstlane(tid >> 6), ql = lane & 31, h2 = lane >> 5;
    const int NU = S >> 8, nunits = (TG / S) * 24 * NU;
    constexpr int KOFF = 0, VOFF = 49152;
    const int ri = lane >> 3, c8 = lane & 7;
#define ATT_STAGE(A_, isV) do { for (int pc = w; pc < (A_).nrows / 8; pc += NWAVES) { const int row = pc * 8 + ri; int cls_, pos_; \
            if ((A_).two) { cls_ = (A_).r0 + (row >> 7); pos_ = row & 127; } else { cls_ = (A_).r0; pos_ = (A_).sbase + row; pos_ = pos_ < 0 ? 0 : (pos_ >= (A_).L ? (A_).L - 1 : pos_); } \
            const bf16* src_ = ATT + (size_t)((A_).seq0 + cls_ + (A_).dil * pos_) * ATTW + (A_).h * 64; \
            if (isV) __builtin_amdgcn_global_load_lds((const unsigned*)(src_ + 3072 + ((c8 ^ (((ri >> 1) & 1) << 2)) << 3)), (LAS unsigned*)(lds + VOFF + pc * 1024), 16, 0, 0); \
            else __builtin_amdgcn_global_load_lds((const unsigned*)(src_ + 1536 + ((c8 ^ ri) << 3)), (LAS unsigned*)(lds + KOFF + pc * 1024), 16, 0, 0); } } while (0)
#define ATT_QLOAD(A_, dst) do { const int cls_ = (A_).two ? (A_).r0 + (w >> 2) : (A_).r0; const int qp_ = (A_).two ? 32 * (w & 3) : (A_).p0 + 32 * w; const size_t tq_ = (size_t)((A_).seq0 + cls_ + (A_).dil * (qp_ + ql)); \
        _Pragma("unroll") for (int s4 = 0; s4 < 4; ++s4) dst[s4] = *(const bf16x8_t*)(ATT + tq_ * ATTW + (A_).h * 64 + 16 * s4 + 8 * h2); } while (0)
    bf16x8_t qf[4], qn[4];
    if (bid < nunits) { const AttU a0 = att_decode(bid, S, NU); ATT_STAGE(a0, false); ATT_QLOAD(a0, qf); }
    for (int u = bid; u < nunits; u += G) {
        const AttU A = att_decode(u, S, NU); const int h = A.h, L = A.L;
        const int cls = A.two ? A.r0 + (w >> 2) : A.r0; const int qp0 = A.two ? 32 * (w & 3) : A.p0 + 32 * w;
        const int tokq = A.seq0 + cls + A.dil * (qp0 + ql);
        const int lrow0 = (A.two ? (w >> 2) * 128 : 0) + qp0 - 64 - A.sbase;
        __syncthreads();
        ATT_STAGE(A, true);
        f32x16 St[5]; float mx = -1e30f;
#pragma unroll
        for (int t = 0; t < 5; ++t) { const int kp0 = qp0 - 64 + 32 * t; const bool ok = (kp0 >= 0) && (kp0 < L);
            if (ok) { const int R = lrow0 + 32 * t + ql; f32x16 a = {};
#pragma unroll
                for (int s4 = 0; s4 < 4; ++s4) { const bf16x8_t kf = *(const LAS bf16x8_t*)(lds + KOFF + R * 128 + (((2 * s4 + h2) ^ (R & 7)) << 4)); a = __builtin_amdgcn_mfma_f32_32x32x16_bf16(kf, qf[s4], a, 0, 0, 0); }
#pragma unroll
                for (int rg = 0; rg < 16; ++rg) { const int row = (rg & 3) + 8 * (rg >> 2) + 4 * h2; if ((t == 0 && row < ql) || (t == 4 && row > ql)) a[rg] = -1e30f; mx = fmaxf(mx, a[rg]); }
                St[t] = a; }
            else { St[t] = (f32x16){}; } }
        mx = fmaxf(mx, __shfl_xor(mx, 32));
        __syncthreads();
        if (u + G < nunits) { const AttU An = att_decode(u + G, S, NU); ATT_STAGE(An, false); ATT_QLOAD(An, qn); }
        float lsum = 0.f; f32x16 O0 = {}, O1 = {};
#pragma unroll
        for (int t = 0; t < 5; ++t) { const int kp0 = qp0 - 64 + 32 * t; const bool ok = (kp0 >= 0) && (kp0 < L);
            if (ok) { f32x16 p = St[t];
#pragma unroll
                for (int rg = 0; rg < 16; ++rg) { p[rg] = __builtin_amdgcn_exp2f(p[rg] - mx); lsum += p[rg]; }
#pragma unroll
                for (int s2 = 0; s2 < 2; ++s2) { v4u pk; pk.x = cvt_pk_bf16(p[8 * s2], p[8 * s2 + 1]); pk.y = cvt_pk_bf16(p[8 * s2 + 2], p[8 * s2 + 3]); pk.z = cvt_pk_bf16(p[8 * s2 + 4], p[8 * s2 + 5]); pk.w = cvt_pk_bf16(p[8 * s2 + 6], p[8 * s2 + 7]);
                    const bf16x8_t pb = __builtin_bit_cast(bf16x8_t, pk);
#pragma unroll
                    for (int dt = 0; dt < 2; ++dt) { const int g16 = (lane >> 4) & 1, qq = (lane & 15) >> 2, pp = lane & 3;
                        const int k0 = lrow0 + 32 * t + 16 * s2 + 4 * h2 + qq, k1 = k0 + 8;
                        const int a0 = VOFF + k0 * 128 + (((dt ^ ((k0 >> 1) & 1)) << 6) | (g16 << 5) | (pp << 3)), a1 = VOFF + k1 * 128 + (((dt ^ ((k1 >> 1) & 1)) << 6) | (g16 << 5) | (pp << 3));
                        const s16x4_t lo = __builtin_bit_cast(s16x4_t, __builtin_amdgcn_ds_read_tr16_b64_v4i16((LAS s16x4_t*)(lds + a0))), hi = __builtin_bit_cast(s16x4_t, __builtin_amdgcn_ds_read_tr16_b64_v4i16((LAS s16x4_t*)(lds + a1)));
                        const bf16x8_t vf = (bf16x8_t){lo[0], lo[1], lo[2], lo[3], hi[0], hi[1], hi[2], hi[3]};
                        if (dt == 0) O0 = __builtin_amdgcn_mfma_f32_32x32x16_bf16(vf, pb, O0, 0, 0, 0); else O1 = __builtin_amdgcn_mfma_f32_32x32x16_bf16(vf, pb, O1, 0, 0, 0); } } } }
        lsum += __shfl_xor(lsum, 32);
        const float il = 1.0f / lsum;
        bf16* po = PO + ((size_t)tokq * 24 + h) * 64;
#pragma unroll
        for (int g4 = 0; g4 < 4; ++g4) { v2u w0, w1; w0.x = cvt_pk_bf16(O0[4 * g4] * il, O0[4 * g4 + 1] * il); w0.y = cvt_pk_bf16(O0[4 * g4 + 2] * il, O0[4 * g4 + 3] * il); w1.x = cvt_pk_bf16(O1[4 * g4] * il, O1[4 * g4 + 1] * il); w1.y = cvt_pk_bf16(O1[4 * g4 + 2] * il, O1[4 * g4 + 3] * il);
            *(v2u*)(po + 8 * g4 + 4 * h2) = w0; *(v2u*)(po + 32 + 8 * g4 + 4 * h2) = w1; }
        if (h2 == 0) LSE[(size_t)tokq * 24 + h] = mx + __builtin_amdgcn_logf(lsum);
#pragma unroll
        for (int s4 = 0; s4 < 4; ++s4) qf[s4] = qn[s4];
    }
    __syncthreads();
#undef ATT_STAGE
#undef ATT_QLOAD
}
__device__ __forceinline__ void phase_attn_combine(const bf16* PO, const float* LSE, bf16* AO, int gt, int NGT) {
    for (int item = gt; item < TG * 64; item += NGT) { const int tok = item >> 6, hg = (item >> 3) & 7, c = item & 7;
        const float l0 = LSE[(size_t)tok * 24 + hg], l1 = LSE[(size_t)tok * 24 + 8 + hg], l2 = LSE[(size_t)tok * 24 + 16 + hg]; const float m = fmaxf(l0, fmaxf(l1, l2));
        float w0 = __builtin_amdgcn_exp2f(l0 - m), w1 = __builtin_amdgcn_exp2f(l1 - m), w2 = __builtin_amdgcn_exp2f(l2 - m); const float inv = 1.0f / (w0 + w1 + w2); w0 *= inv; w1 *= inv; w2 *= inv;
        float a[8], b8[8], c8[8]; load8bf(PO + ((size_t)tok * 24 + hg) * 64 + c * 8, a); load8bf(PO + ((size_t)tok * 24 + 8 + hg) * 64 + c * 8, b8); load8bf(PO + ((size_t)tok * 24 + 16 + hg) * 64 + c * 8, c8);
#pragma unroll
        for (int e = 0; e < 8; ++e) a[e] = w0 * a[e] + w1 * b8[e] + w2 * c8[e];
        v4u o; o.x = cvt_pk_bf16(a[0], a[1]); o.y = cvt_pk_bf16(a[2], a[3]); o.z = cvt_pk_bf16(a[4], a[5]); o.w = cvt_pk_bf16(a[6], a[7]);
        *(v4u*)(AO + (size_t)tok * 1536 + hg * 64 + c * 8) = o; }
}

constexpr int DN_FRAG_U = 49152  , DN_TI_UD = 16384  , DN_VEC_UD = 512  ;
__device__ __forceinline__ int pi_q(int q, int j) { return (j < 4) ? (4 * q + j) : (16 + 4 * q + (j - 4)); }
__device__ __forceinline__ float dpp_xor1(float x) { return __int_as_float(__builtin_amdgcn_mov_dpp(__float_as_int(x), 0xB1, 0xF, 0xF, true)); }
__device__ __forceinline__ float dpp_xor2(float x) { return __int_as_float(__builtin_amdgcn_mov_dpp(__float_as_int(x), 0x4E, 0xF, 0xF, true)); }

__device__ __forceinline__ void phase_dna(const Ptrs& P, const bf16* DNQ, const float* SMALL, unsigned char* FRAG, bf16* VACC, unsigned char* TI, float* VEC, int S, unsigned char* lds_, int bid, int G, int tid) {
    LAS unsigned char* lds = (LAS unsigned char*)lds_;
    const int lane = tid & 63, w = __builtin_amdgcn_readfirstlane(tid >> 6), c16 = lane & 15, q4 = lane >> 4;
    constexpr int RAW = 0, RM = 52224, RMP = 132  , RMPART = 64 * RMP, MM = 102912, LP = RM, TM = MM, GV = 135680;
    LAS bf16* raw = (LAS bf16*)(lds + RAW); LAS bf16* rm = (LAS bf16*)(lds + RM); LAS float* mm = (LAS float*)(lds + MM); LAS float* lp = (LAS float*)(lds + LP); LAS float* tm = (LAS float*)(lds + TM); LAS float* gv = (LAS float*)(lds + GV);
    const int NU = (TG / 64) * 8;
#define DNA_STAGE(u_) do { const int n_ = (u_) >> 3, h_ = (u_) & 7; const int tok0_ = n_ * 64, pos0_ = tok0_ & (S - 1), seq0_ = tok0_ - pos0_; \
        for (int pc = w; pc < 51; pc += NWAVES) { const int part_ = pc / 17, rg_ = pc - part_ * 17; int p_ = pos0_ - 2 + 4 * rg_ + (lane >> 4); p_ = p_ < 0 ? 0 : (p_ >= S ? S - 1 : p_); \
            __builtin_amdgcn_global_load_lds((const unsigned*)(DNQ + (size_t)(seq0_ + p_) * DNW + part_ * 1024 + h_ * 128 + (lane & 15) * 8), (LAS unsigned*)(lds + RAW + pc * 1024), 16, 0, 0); } } while (0)
    if (bid < NU) DNA_STAGE(bid);
    for (int ui = bid; ui < NU; ui += G) {
        const int n = ui >> 3, h = ui & 7; const int tok0 = n * 64, pos0 = tok0 & (S - 1);
        __syncthreads();
#pragma unroll
        for (int i6 = 0; i6 < 6; ++i6) { const int it = w * 6 + i6, part = it >> 4, t = ((it & 15) << 2) + q4; const int ch = part * 1024 + h * 128 + 8 * c16;
            float a[8];
#pragma unroll
            for (int e = 0; e < 8; ++e) a[e] = 0.f;
#pragma unroll
            for (int i = 0; i < 5; ++i) { const int p2 = pos0 + t + i - 2; const v4u x = *(const LAS v4u*)(raw + (part * 68 + t + i) * 128 + 8 * c16);
                const f32x4 wa = *(const f32x4*)(P.conv_w + i * DNW + ch), wb = *(const f32x4*)(P.conv_w + i * DNW + ch + 4);
                if (p2 >= 0 && p2 < S) { a[0] += bflo(x.x) * wa[0]; a[1] += bfhi(x.x) * wa[1]; a[2] += bflo(x.y) * wa[2]; a[3] += bfhi(x.y) * wa[3]; a[4] += bflo(x.z) * wb[0]; a[5] += bfhi(x.z) * wb[1]; a[6] += bflo(x.w) * wb[2]; a[7] += bfhi(x.w) * wb[3]; } }
            float ss = 0.f;
#pragma unroll
            for (int e = 0; e < 8; ++e) { a[e] = a[e] * __builtin_amdgcn_rcpf(1.0f + __expf(-a[e])); ss += a[e] * a[e]; }
            if (part < 2) { ss += __int_as_float(__builtin_amdgcn_mov_dpp(__float_as_int(ss), 0xB1, 0xF, 0xF, true)); ss += __int_as_float(__builtin_amdgcn_mov_dpp(__float_as_int(ss), 0x4E, 0xF, 0xF, true));
                ss += __int_as_float(__builtin_amdgcn_mov_dpp(__float_as_int(ss), 0x124, 0xF, 0xF, true));
                ss += __int_as_float(__builtin_amdgcn_mov_dpp(__float_as_int(ss), 0x128, 0xF, 0xF, true));
                float sc = rsqrtf(ss + EPS); if (part == 0) sc *= 0.08838834764831845f;
#pragma unroll
                for (int e = 0; e < 8; ++e) a[e] *= sc; }
            const v4u o = {cvt_pk_bf16(a[0], a[1]), cvt_pk_bf16(a[2], a[3]), cvt_pk_bf16(a[4], a[5]), cvt_pk_bf16(a[6], a[7])};
            *(LAS v2u*)(rm + part * RMPART + t * RMP + 8 * c16) = (v2u){o.x, o.y}; *(LAS v2u*)(rm + part * RMPART + t * RMP + 8 * c16 + 4) = (v2u){o.z, o.w}; }
        __syncthreads();
        if (ui + G < NU) DNA_STAGE(ui + G);
        unsigned char* fr_u = FRAG + (size_t)ui * DN_FRAG_U;
#pragma unroll
        for (int i = 0; i < 4; ++i) { const int fidx = 4 * w + i, isQ = fidx >> 4, ff = fidx & 15, mt = ff >> 2, ks = ff & 3; const int row = 16 * mt + c16;
            const LAS bf16* src = rm + (isQ ? 0 : RMPART) + row * RMP + 32 * ks + 4 * q4;
            const v2u lo = *(const LAS v2u*)src, hi = *(const LAS v2u*)(src + 16); const v4u val = {lo.x, lo.y, hi.x, hi.y};
            *(v4u*)(fr_u + (isQ * 16 + ff) * 1024 + lane * 16) = val; }
#pragma unroll
        for (int i = 0; i < 2; ++i) { const int f = 2 * w + i, mt8 = f >> 1, ks = f & 1; const int dim = 16 * mt8 + c16; unsigned short e[8];
#pragma unroll
            for (int j = 0; j < 8; ++j) e[j] = rm[RMPART + (32 * ks + pi_q(q4, j)) * RMP + dim];
            const v4u val = {(unsigned)e[0] | ((unsigned)e[1] << 16), (unsigned)e[2] | ((unsigned)e[3] << 16), (unsigned)e[4] | ((unsigned)e[5] << 16), (unsigned)e[6] | ((unsigned)e[7] << 16)};
            *(v4u*)(fr_u + (32 + f) * 1024 + lane * 16) = val; }
        { unsigned short e[16];
#pragma unroll
          for (int mt = 0; mt < 4; ++mt)
#pragma unroll
              for (int r = 0; r < 4; ++r) e[mt * 4 + r] = rm[2 * RMPART + (16 * mt + 4 * q4 + r) * RMP + 16 * w + c16];
          v4u a = {(unsigned)e[0] | ((unsigned)e[1] << 16), (unsigned)e[2] | ((unsigned)e[3] << 16), (unsigned)e[4] | ((unsigned)e[5] << 16), (unsigned)e[6] | ((unsigned)e[7] << 16)};
          v4u b = {(unsigned)e[8] | ((unsigned)e[9] << 16), (unsigned)e[10] | ((unsigned)e[11] << 16), (unsigned)e[12] | ((unsigned)e[13] << 16), (unsigned)e[14] | ((unsigned)e[15] << 16)};
          v4u* dst = (v4u*)(VACC + (((size_t)ui * 8 + w) * 64 + lane) * 16); dst[0] = a; dst[1] = b; }
#pragma unroll
        for (int i = 0; i < 4; ++i) { const int t4 = 4 * w + i, isQK = t4 >> 4, tt = t4 & 15, mt = tt >> 2, nt = tt & 3; pg8::f32x4 acc = {0.f, 0.f, 0.f, 0.f};
#pragma unroll
            for (int ks = 0; ks < 4; ++ks) { const LAS bf16* sa = rm + (isQK ? 0 : RMPART) + (16 * mt + c16) * RMP + 32 * ks + 4 * q4; const LAS bf16* sb = rm + RMPART + (16 * nt + c16) * RMP + 32 * ks + 4 * q4;
                const v2u alo = *(const LAS v2u*)sa, ahi = *(const LAS v2u*)(sa + 16), blo = *(const LAS v2u*)sb, bhi = *(const LAS v2u*)(sb + 16);
                const v4u av = {alo.x, alo.y, ahi.x, ahi.y}, bv = {blo.x, blo.y, bhi.x, bhi.y};
                acc = __builtin_amdgcn_mfma_f32_16x16x32_bf16(__builtin_bit_cast(bf16x8_t, av), __builtin_bit_cast(bf16x8_t, bv), acc, 0, 0, 0); }
#pragma unroll
            for (int r = 0; r < 4; ++r) mm[isQK * 4096 + (16 * mt + 4 * q4 + r) * 64 + 16 * nt + c16] = acc[r]; }
        if (w < 2) { const int dir = w; int lane_g = lane; asm volatile("" : "+v"(lane_g)); const float* sm = SMALL + (size_t)(tok0 + lane_g) * 32;
            const float beta = __builtin_amdgcn_rcpf(1.0f + __expf(-sm[dir * 8 + h])); const float al = dir ? P.a_log_b[h] : P.a_log_f[h], db = dir ? P.dt_b[h] : P.dt_f[h];
            const float xx = sm[16 + dir * 8 + h] + db; const float sp = (xx > 20.f) ? xx : __logf(1.0f + __expf(xx)); const float gg = -__expf(al) * sp;
            float gc = gg;
#pragma unroll
            for (int o = 1; o < 64; o <<= 1) { const int src = dir ? lane_g + o : lane_g - o; const float tt = __int_as_float(__builtin_amdgcn_ds_bpermute(src << 2, __float_as_int(gc))); const bool okk = dir ? (lane_g + o < 64) : (lane_g >= o); if (okk) gc += tt; }
            const float glast = __int_as_float(__builtin_amdgcn_ds_bpermute((dir ? 0 : 63) << 2, __float_as_int(gc)));
            gv[dir * 128 + lane_g] = gc; gv[dir * 128 + 64 + lane_g] = beta;
            float* vec = VEC + ((size_t)ui * 2 + dir) * DN_VEC_UD; const float eg = __expf(gc);
            vec[lane_g] = beta; vec[64 + lane_g] = beta * eg; vec[128 + lane_g] = eg; vec[192 + lane_g] = __expf(glast - gc); }
        __syncthreads();
        unsigned char* ti_u = TI + (size_t)ui * 2 * DN_TI_UD;
#pragma unroll
        for (int k2 = 0; k2 < 2; ++k2) { const int task = tid + 512 * k2, dir = task >> 9, f = (task >> 6) & 7, mt = f >> 1, ks = f & 1; const int i = 16 * mt + c16; const float gci = gv[dir * 128 + i]; float e[8];
#pragma unroll
            for (int j8 = 0; j8 < 8; ++j8) { const int j = 32 * ks + pi_q(q4, j8); const bool incl = dir ? (i <= j) : (i >= j); e[j8] = incl ? mm[4096 + i * 64 + j] * __expf(gci - gv[dir * 128 + j]) : 0.f; }
            const v4u val = {cvt_pk_bf16(e[0], e[1]), cvt_pk_bf16(e[2], e[3]), cvt_pk_bf16(e[4], e[5]), cvt_pk_bf16(e[6], e[7])};
            *(v4u*)(ti_u + dir * DN_TI_UD + (8 + f) * 1024 + lane * 16) = val; }
        f32x4 lpv[4];
#pragma unroll
        for (int k4 = 0; k4 < 4; ++k4) { const int vi = tid + 512 * k4, dir = vi >> 10, ip = (vi >> 4) & 63, p = (vi >> 2) & 3, jj4 = vi & 3; const int i = dir ? 63 - ip : ip; const float gci = gv[dir * 128 + i], bi = gv[dir * 128 + 64 + i];
#pragma unroll
            for (int e = 0; e < 4; ++e) { const int jp = 16 * jj4 + 4 * e + p; const int j = dir ? 63 - jp : jp; lpv[k4][e] = (jp < ip) ? bi * mm[i * 64 + j] * __expf(gci - gv[dir * 128 + j]) : 0.f; } }
        __syncthreads();
#pragma unroll
        for (int k4 = 0; k4 < 4; ++k4) { const int vi = tid + 512 * k4; *(LAS f32x4*)(lp + vi * 4) = lpv[k4]; }
        __syncthreads();
        { const int dir = w >> 2, cc = (w & 3) * 16 + (lane >> 2), p = lane & 3; float t[16];
#pragma unroll
          for (int jj = 0; jj < 16; ++jj) t[jj] = 0.f;
#pragma unroll
          for (int ip = 0; ip < 64; ++ip) { float part = 0.f;
#pragma unroll
              for (int jj4 = 0; jj4 < (ip + 15) / 16; ++jj4) { const f32x4 l4 = *(const LAS f32x4*)(lp + ((dir * 64 + ip) * 4 + p) * 16 + jj4 * 4);
#pragma unroll
                  for (int e = 0; e < 4; ++e) if (16 * jj4 + 4 * e < ip) part += l4[e] * t[4 * jj4 + e]; }
              part += dpp_xor1(part); part += dpp_xor2(part);
              const float val = ((cc == ip) ? 1.0f : 0.0f) - part; if (p == (ip & 3)) t[ip >> 2] = val; }
#pragma unroll
          for (int jj = 0; jj < 16; ++jj) tm[(dir * 64 + 4 * jj + p) * 64 + cc] = t[jj]; }
        __syncthreads();
#pragma unroll
        for (int k2 = 0; k2 < 2; ++k2) { const int task = tid + 512 * k2, dir = task >> 9, f = (task >> 6) & 7, mt = f >> 1, ks = f & 1; const int i = 16 * mt + c16; float e[8];
#pragma unroll
            for (int j8 = 0; j8 < 8; ++j8) { const int j = 32 * ks + pi_q(q4, j8); e[j8] = dir ? tm[(64 + 63 - i) * 64 + 63 - j] : tm[i * 64 + j]; }
            const v4u val = {cvt_pk_bf16(e[0], e[1]), cvt_pk_bf16(e[2], e[3]), cvt_pk_bf16(e[4], e[5]), cvt_pk_bf16(e[6], e[7])};
            *(v4u*)(ti_u + dir * DN_TI_UD + f * 1024 + lane * 16) = val; }
    }
#undef DNA_STAGE
}

__device__ __forceinline__ bf16x8_t pack_acc2(const pg8::f32x4& a, const pg8::f32x4& b) { const v4u v = {cvt_pk_bf16(a[0], a[1]), cvt_pk_bf16(a[2], a[3]), cvt_pk_bf16(b[0], b[1]), cvt_pk_bf16(b[2], b[3])}; return __builtin_bit_cast(bf16x8_t, v); }
__device__ __forceinline__ void phase_scan(const unsigned char* FRAG, const unsigned char* TI, const bf16* VACC, const float* VEC, bf16* OF, bf16* OB, int S, unsigned char* lds_, int bid, int G, int tid) {
    LAS unsigned char* lds = (LAS unsigned char*)lds_;
    const int lane = tid & 63, w = __builtin_amdgcn_readfirstlane(tid >> 6), c16 = lane & 15, q4 = lane >> 4;
    const int NCH = S >> 6, nchain = (TG / S) * 16;
    constexpr int BUFB = 65536;
    for (int chain = bid; chain < nchain; chain += G) {
        const int dir = chain & 1, h = (chain >> 1) & 7, b = chain >> 4;
        bf16* O = dir ? OB : OF;
        pg8::f32x4 Sacc[8];
#pragma unroll
        for (int T8 = 0; T8 < 8; ++T8) Sacc[T8] = (pg8::f32x4){0.f, 0.f, 0.f, 0.f};
#define DN_STAGE(bufoff, nn) do { const size_t ui_ = ((size_t)(b * NCH + (nn)) * 8 + h); \
            for (int pc = w; pc < 64; pc += NWAVES) { const unsigned char* src = (pc < 48) ? FRAG + ui_ * DN_FRAG_U + pc * 1024 : TI + (ui_ * 2 + dir) * DN_TI_UD + (pc - 48) * 1024; \
                __builtin_amdgcn_global_load_lds((const unsigned*)(src + lane * 16), (LAS unsigned*)(lds + (bufoff) + pc * 1024), 16, 0, 0); } } while (0)
        int n = dir ? NCH - 1 : 0;
        DN_STAGE(0, n);
        v4u vcur0, vcur1; { const v4u* vp = (const v4u*)(VACC + ((((size_t)(b * NCH + n) * 8 + h) * 8 + w) * 64 + lane) * 16); vcur0 = vp[0]; vcur1 = vp[1]; }
        if (w == 0) { const v4u vv = *(const v4u*)(VEC + (((size_t)(b * NCH + n) * 8 + h) * 2 + dir) * DN_VEC_UD + lane * 4); *(LAS v4u*)(lds + 131072 + lane * 16) = vv; }
        __syncthreads();
        int buf = 0;
        for (int step = 0; step < NCH; ++step) {
            const int nn = dir ? n - 1 : n + 1; v4u vn0 = vcur0, vn1 = vcur1;
            v4u vecn = {0u, 0u, 0u, 0u};
            if (step + 1 < NCH) { DN_STAGE((buf ^ 1) * BUFB, nn); const v4u* vp = (const v4u*)(VACC + ((((size_t)(b * NCH + nn) * 8 + h) * 8 + w) * 64 + lane) * 16); vn0 = vp[0]; vn1 = vp[1];  if (w == 0) vecn = *(const v4u*)(VEC + (((size_t)(b * NCH + nn) * 8 + h) * 2 + dir) * DN_VEC_UD + lane * 4); }
            const LAS unsigned char* B0 = lds + buf * BUFB; const LAS float* vec = (const LAS float*)(lds + 131072 + buf * 1024);
#define DN_A(off, fi) (*(const LAS bf16x8_t*)(B0 + (off) + (fi) * 1024 + lane * 16))
            bf16x8_t Sb[4];
#pragma unroll
            for (int ks = 0; ks < 4; ++ks) Sb[ks] = pack_acc2(Sacc[2 * ks], Sacc[2 * ks + 1]);
            pg8::f32x4 X1[4], X2[4];
#pragma unroll
            for (int mt = 0; mt < 4; ++mt) { X1[mt] = (pg8::f32x4){0.f, 0.f, 0.f, 0.f}; X2[mt] = X1[mt];
#pragma unroll
                for (int ks = 0; ks < 4; ++ks) { X1[mt] = __builtin_amdgcn_mfma_f32_16x16x32_bf16(DN_A(0, mt * 4 + ks), Sb[ks], X1[mt], 0, 0, 0); X2[mt] = __builtin_amdgcn_mfma_f32_16x16x32_bf16(DN_A(16384, mt * 4 + ks), Sb[ks], X2[mt], 0, 0, 0); } }
            const unsigned vw[8] = {vcur0.x, vcur0.y, vcur0.z, vcur0.w, vcur1.x, vcur1.y, vcur1.z, vcur1.w};
            pg8::f32x4 Y[4];
#pragma unroll
            for (int mt = 0; mt < 4; ++mt) { const pg8::f32x4 be = *(const LAS pg8::f32x4*)(vec + 16 * mt + 4 * q4), aa = *(const LAS pg8::f32x4*)(vec + 64 + 16 * mt + 4 * q4);
                const pg8::f32x4 vv = {bflo(vw[2 * mt]), bfhi(vw[2 * mt]), bflo(vw[2 * mt + 1]), bfhi(vw[2 * mt + 1])}; Y[mt] = be * vv - aa * X1[mt]; }
            const bf16x8_t Yb0 = pack_acc2(Y[0], Y[1]), Yb1 = pack_acc2(Y[2], Y[3]);
            pg8::f32x4 vn[4];
#pragma unroll
#ifdef PROBE_NOT
            for (int mt = 0; mt < 4; ++mt) vn[mt] = Y[mt];
#else
            for (int mt = 0; mt < 4; ++mt) { vn[mt] = __builtin_amdgcn_mfma_f32_16x16x32_bf16(DN_A(49152, mt * 2), Yb0, (pg8::f32x4){0.f, 0.f, 0.f, 0.f}, 0, 0, 0); vn[mt] = __builtin_amdgcn_mfma_f32_16x16x32_bf16(DN_A(49152, mt * 2 + 1), Yb1, vn[mt], 0, 0, 0); }
#endif
            const bf16x8_t vb0 = pack_acc2(vn[0], vn[1]), vb1 = pack_acc2(vn[2], vn[3]);
            pg8::f32x4 dd[4];
#pragma unroll
            for (int mt = 0; mt < 4; ++mt) { const pg8::f32x4 eg = *(const LAS pg8::f32x4*)(vec + 128 + 16 * mt + 4 * q4); dd[mt] = *(const LAS pg8::f32x4*)(vec + 192 + 16 * mt + 4 * q4);
#ifdef PROBE_NOIT
                pg8::f32x4 o = eg * X2[mt] + vn[mt];
#else
                pg8::f32x4 o = eg * X2[mt]; o = __builtin_amdgcn_mfma_f32_16x16x32_bf16(DN_A(57344, mt * 2), vb0, o, 0, 0, 0); o = __builtin_amdgcn_mfma_f32_16x16x32_bf16(DN_A(57344, mt * 2 + 1), vb1, o, 0, 0, 0);
#endif
                bf16* op = O + ((size_t)(b * S + n * 64 + 16 * mt + 4 * q4)) * 1024 + h * 128 + 16 * w + c16;
#pragma unroll
                for (int r = 0; r < 4; ++r) op[(size_t)r * 1024] = (bf16)(cvt_pk_bf16(o[r], 0.f) & 0xffffu); }
            const bf16x8_t db0 = pack_acc2(dd[0] * vn[0], dd[1] * vn[1]), db1 = pack_acc2(dd[2] * vn[2], dd[3] * vn[3]);
            const float dec = vec[128 + (dir ? 0 : 63)];
#pragma unroll
            for (int T8 = 0; T8 < 8; ++T8) { pg8::f32x4 a = Sacc[T8] * dec; a = __builtin_amdgcn_mfma_f32_16x16x32_bf16(DN_A(32768, T8 * 2), db0, a, 0, 0, 0); a = __builtin_amdgcn_mfma_f32_16x16x32_bf16(DN_A(32768, T8 * 2 + 1), db1, a, 0, 0, 0); Sacc[T8] = a; }
            if (w == 0 && step + 1 < NCH) *(LAS v4u*)(lds + 131072 + (buf ^ 1) * 1024 + lane * 16) = vecn;
            __syncthreads();
            buf ^= 1; n = nn; vcur0 = vn0; vcur1 = vn1;
        }
#undef DN_A
#undef DN_STAGE
    }
}

__device__ __forceinline__ void phase_combine(const Ptrs& P, const bf16* OF, const bf16* OB, const bf16* Z, bf16* DNOUT, int gw, int NGW, int lane) {
    for (int item = gw; item < TG * 8; item += NGW) { const size_t off = (size_t)item * 128 + lane * 2;
        const unsigned a = *(const unsigned*)(OF + off), b = *(const unsigned*)(OB + off), z = *(const unsigned*)(Z + off);
#ifdef PROBE_NODN
        const float o0 = 0.5f + 0.f * bflo(z), o1 = 0.25f;
#else
        const float o0 = bflo(a) + bflo(b), o1 = bfhi(a) + bfhi(b);
#endif
        const float ss = wave_sum(o0 * o0 + o1 * o1); const float rs = rsqrtf(ss * (1.0f / 128.0f) + EPS);
        const float y0 = o0 * rs * P.out_norm_g[lane * 2] * siluf_(bflo(z)), y1 = o1 * rs * P.out_norm_g[lane * 2 + 1] * siluf_(bfhi(z));
        *(unsigned*)(DNOUT + (size_t)(item >> 3) * 1536 + 512 + (item & 7) * 128 + lane * 2) = cvt_pk_bf16(y0, y1); }
}

__device__ __forceinline__ void unpack8(const v4u w, float* o) { o[0] = bflo(w.x); o[1] = bfhi(w.x); o[2] = bflo(w.y); o[3] = bfhi(w.y); o[4] = bflo(w.z); o[5] = bfhi(w.z); o[6] = bflo(w.w); o[7] = bfhi(w.w); }
__device__ __forceinline__ void phase_act(const Ptrs& P, const bf16* UP, bf16* ACT, int S, int gt, int NGT) {
    constexpr int TB = 16, NCG = DFF / 8;
    for (int item = gt; item < (TG / TB) * NCG; item += NGT) { const int tb = item / NCG, cg = item - tb * NCG, c = cg * 8, t0 = tb * TB, pos0 = t0 & (S - 1);
        float w0[8], w1[8], w2[8], bb[8];
#pragma unroll
        for (int e = 0; e < 8; e += 4) { const f32x4 a = *(const f32x4*)(P.ffn_conv_w + c + e), b = *(const f32x4*)(P.ffn_conv_w + DFF + c + e), d = *(const f32x4*)(P.ffn_conv_w + 2 * DFF + c + e), f = *(const f32x4*)(P.ffn_conv_b + c + e);
#pragma unroll
            for (int k = 0; k < 4; ++k) { w0[e + k] = a[k]; w1[e + k] = b[k]; w2[e + k] = d[k]; bb[e + k] = f[k]; } }
        const bf16* gp = UP + (size_t)t0 * NUP + c; const bf16* vp = gp + DFF; bf16* op = ACT + (size_t)t0 * DFF + c;
        float gprev[8], gcur[8], gnext[8];
        if (pos0 > 0) unpack8(*(const v4u*)(gp - NUP), gprev); else {
#pragma unroll
            for (int e = 0; e < 8; ++e) gprev[e] = 0.f; }
        unpack8(*(const v4u*)gp, gcur);
#pragma unroll 4
        for (int t = 0; t < TB; ++t) {
            if (t + 1 < TB || pos0 + TB < S) unpack8(*(const v4u*)(gp + (size_t)(t + 1) * NUP), gnext); else {
#pragma unroll
                for (int e = 0; e < 8; ++e) gnext[e] = 0.f; }
            float vv[8]; unpack8(*(const v4u*)(vp + (size_t)t * NUP), vv); float r[8];
#pragma unroll
            for (int e = 0; e < 8; e += 2) { const pg8::f32x2 gg = {bb[e] + w0[e] * gprev[e] + w1[e] * gcur[e] + w2[e] * gnext[e], bb[e + 1] + w0[e + 1] * gprev[e + 1] + w1[e + 1] * gcur[e + 1] + w2[e + 1] * gnext[e + 1]}; const pg8::f32x2 ge = pg8::gelu_pk(gg); r[e] = ge.x * vv[e]; r[e + 1] = ge.y * vv[e + 1]; }
            const v4u o = {cvt_pk_bf16(r[0], r[1]), cvt_pk_bf16(r[2], r[3]), cvt_pk_bf16(r[4], r[5]), cvt_pk_bf16(r[6], r[7])}; *(v4u*)(op + (size_t)t * DFF) = o;
#pragma unroll
            for (int e = 0; e < 8; ++e) { gprev[e] = gcur[e]; gcur[e] = gnext[e]; } }
    }
}

__device__ __forceinline__ void act_fix(const Ptrs& P, const float* EDGE, bf16* ACT, int pm, int S, int tid) {
    for (int i = tid; i < 2 * DFF; i += NTHREADS) { const int which = i / DFF, c = i - which * DFF, pt = c >> 7, ci = c & 127; const int tr = pm * 256 + (which ? 255 : 0);
        const bool need = which ? (((tr + 1) & (S - 1)) != 0) : ((tr & (S - 1)) != 0);
        if (need) { const float* e0 = EDGE + ((size_t)pm * 22 + pt) * 768; const float* en = EDGE + ((size_t)(pm + (which ? 1 : -1)) * 22 + pt) * 768;
            const float up = which ? e0[2 * 128 + ci] : en[3 * 128 + ci], gm = which ? e0[3 * 128 + ci] : e0[ci], dn = which ? en[ci] : e0[128 + ci], vv = which ? e0[5 * 128 + ci] : e0[4 * 128 + ci];
            const float gc = P.ffn_conv_b[c] + P.ffn_conv_w[c] * up + P.ffn_conv_w[DFF + c] * gm + P.ffn_conv_w[2 * DFF + c] * dn;
            const pg8::f32x2 ge = pg8::gelu_pk((pg8::f32x2){gc, gc}); ACT[(size_t)tr * DFF + c] = (bf16)(cvt_pk_bf16(ge.x * vv, 0.f) & 0xffffu); } }
}

__device__ __forceinline__ void phase_final(const Ptrs& P, const float* ssq3, int g, int gw, int NGW, int lane) {
    for (int m = g * TG + gw; m < (g + 1) * TG; m += NGW) { const float rs = rsqrtf(ssq3[m] * (1.0f / 1024.0f) + EPS); f32x4* xr = (f32x4*)(P.out + (size_t)m * D) + lane; const f32x4* gr = (const f32x4*)P.norm_final_g + lane;
#pragma unroll
        for (int j = 0; j < 4; ++j) xr[64 * j] = xr[64 * j] * rs * gr[64 * j]; }
}

typedef __attribute__((address_space(1))) unsigned gu32;
#define RLX_AGENT __ATOMIC_RELAXED, __HIP_MEMORY_SCOPE_AGENT
#define XB_TMO      128
#define XB_XCNT(j)  (256  + 64 * (j))
#define XB_XSUB(j)  (1280 + 64 * (j))
#define XB_XGEN(j)  (2304 + 64 * (j))
#define XB_TOP      3328
#define XB_TOPGEN   3392
#define XCD_BAR_WORDS 3456
#define XB_SPIN_CAP (1u << 18)

__device__ __forceinline__ unsigned xb_ld(unsigned* p)              { return __hip_atomic_load(p, __ATOMIC_RELAXED, __HIP_MEMORY_SCOPE_AGENT); }
__device__ __forceinline__ unsigned xb_add(unsigned* p, unsigned v) { return __hip_atomic_fetch_add(p, v, __ATOMIC_RELAXED, __HIP_MEMORY_SCOPE_AGENT); }
__device__ __forceinline__ unsigned xb_xcc_id() { return (unsigned)__builtin_amdgcn_s_getreg((3 << 11) | 20) & 0xFu; }
#define XB_SPIN(cond, bar) do { unsigned _sp = 0; while (cond) { __builtin_amdgcn_s_sleep(1); \
    if ((++_sp & 255u) == 0u) { if (xb_ld(&(bar)[XB_TMO])) break; if (_sp > XB_SPIN_CAP) { atomicAdd(&(bar)[XB_TMO], 1u); break; } } } } while (0)

struct XcdBarrier {
    unsigned* bar; unsigned x;
    volatile LAS unsigned* st;
};

__device__ __forceinline__ XcdBarrier xcd_barrier_post(unsigned* bar, volatile LAS unsigned* st, int tid) {
    XcdBarrier b; b.bar = bar; b.x = xb_xcc_id(); b.st = st;
    if (tid == 0) (void)xb_add(&bar[XB_XCNT(b.x)], 1u);
    return b;
}
__device__ __forceinline__ void xcd_barrier_complete(unsigned* bar, unsigned x, unsigned& nloc, unsigned& nx) {
    const unsigned G = gridDim.x * gridDim.y * gridDim.z;
    unsigned sum, cnt, mine, sp = 0u;
    for (;;) {
        sum = 0u; cnt = 0u; mine = 0u;
#pragma unroll
        for (unsigned j = 0; j < 16; ++j) { const unsigned c = xb_ld(&bar[XB_XCNT(j)]); sum += c; cnt += (c > 0u) ? 1u : 0u; mine = (j == x) ? c : mine; }
        if (sum == G) break;
        __builtin_amdgcn_s_sleep(1);
        if ((++sp & 255u) == 0u) { if (xb_ld(&bar[XB_TMO])) break; if (sp > XB_SPIN_CAP) { atomicAdd(&bar[XB_TMO], 1u); break; } }
    }
    nloc = mine > 0u ? mine : 1u; nx = cnt > 0u ? cnt : 1u;
}

__device__ __forceinline__ void xcd_barrier(const XcdBarrier& b, int tid) {
    asm volatile("s_waitcnt vmcnt(0)" ::: "memory");
    __syncthreads();
    if (tid == 0) {
        unsigned* bar = b.bar;
        __builtin_amdgcn_s_waitcnt(0);
        unsigned nloc = b.st[0], nx = b.st[1];
        if (nloc == 0u) { xcd_barrier_complete(bar, b.x, nloc, nx); b.st[0] = nloc; b.st[1] = nx; }
        const unsigned old = xb_add(&bar[XB_XSUB(b.x)], 1u);
        const unsigned gen = old / nloc;
        if (old + 1u == (gen + 1u) * nloc) {
            __builtin_amdgcn_fence(__ATOMIC_RELEASE, "agent");
            asm volatile("s_waitcnt vmcnt(0)" ::: "memory");
            const unsigned og = xb_add(&bar[XB_TOP], 1u);
            const unsigned tg = og / nx;
            if (og + 1u == (tg + 1u) * nx) xb_add(&bar[XB_TOPGEN], 1u);
            else XB_SPIN(xb_ld(&bar[XB_TOPGEN]) == tg, bar);
            __builtin_amdgcn_fence(__ATOMIC_ACQUIRE, "agent");
            xb_add(&bar[XB_XGEN(b.x)], 1u);
            asm volatile("s_waitcnt vmcnt(0)" ::: "memory");
        } else {
            XB_SPIN(xb_ld(&bar[XB_XGEN(b.x)]) == gen, bar);
            __builtin_amdgcn_fence(__ATOMIC_ACQUIRE, "agent");
            asm volatile("s_waitcnt vmcnt(0)" ::: "memory");
        }
    }
    __syncthreads();
}

constexpr int LDS_BYTES = 147456;
constexpr int CW_BAR = 4096;
constexpr int STEPS_PER_GROUP = 9, NSTEPS = 1 + NGROUPS * STEPS_PER_GROUP + 1;

#define LDP(i) ((const float*)ap->in[i])
#define MKP() Ptrs P; P.x_p = LDP(0); P.x_s = LDP(1); P.norm_mix_g = LDP(2); P.w_in = LDP(3); P.conv_w = LDP(4); P.a_log_f = LDP(5); P.a_log_b = LDP(6); P.dt_f = LDP(7); P.dt_b = LDP(8); \
        P.out_norm_g = LDP(9); P.w_a = LDP(10); P.w_b = LDP(11); P.w_out = LDP(12); P.norm_ffn_g = LDP(13); P.w_up = LDP(14); P.ffn_conv_w = LDP(15); P.ffn_conv_b = LDP(16); P.w_down = LDP(17); P.norm_final_g = LDP(18); \
        P.out = ap->out; P.ws = ap->ws;
#define WSP ((unsigned char*)ap->ws)
#define ARP (WSP + WS_ARENA)
#define Win ((bf16*)(WSP + WS_WIN))
#define Wup ((bf16*)(WSP + WS_WUP))
#define Wdn ((bf16*)(WSP + WS_WDOWN))
#define Wout ((bf16*)(WSP + WS_WOUT))
#define Wa ((bf16*)(WSP + WS_WA))
#define Wb ((bf16*)(WSP + WS_WB))
#define ropeC ((const float*)(WSP + WS_ROPE))
#define ropeS (ropeC + 4096 * 8)
#define ssq2 ((float*)(WSP + WS_CTL + CTL_SSQ2))
#define ssq3 ((float*)(WSP + WS_CTL + CTL_SSQ3))
#define XBg ((bf16*)(WSP + WS_XB))
#define rstd1 ((const float*)(WSP + WS_RSTD1) + t0)
#define ATT ((bf16*)(ARP + AR_ATT))
#define DNQ ((bf16*)(ARP + AR_DNQ))
#define Z ((bf16*)(ARP + AR_Z))
#define SMALL ((float*)(ARP + AR_SMALL))
#define AB ((bf16*)(ARP + AR_ATT))
#define MIX ((bf16*)(ARP + AR_MIX))
#define PO ((bf16*)(ARP + AR_PO))
#define LSE2 ((float*)(ARP + AR_LSE))
#define FRAGP ((unsigned char*)(ARP + AR_FRAG))
#define VACCP ((bf16*)(ARP + AR_VACC))
#define TIP ((unsigned char*)(ARP + AR_TI))
#define VECP ((float*)(ARP + AR_VEC))
#define OF ((bf16*)(ARP + AR_OF))
#define OB ((bf16*)(ARP + AR_OB))
#define Gt ((bf16*)OUTg)
#define EDGEP ((float*)(ARP + AR_AO))
#define ACT ((bf16*)(ARP + AR_ACT))
#define OUTg ((float*)ap->out + (size_t)t0 * D)
#define STEP_PRE() int tid = wave_u * 64 + (int)__builtin_amdgcn_mbcnt_hi(~0u, __builtin_amdgcn_mbcnt_lo(~0u, 0u)), bid = blockIdx.x; typedef const __attribute__((address_space(4))) Args* kargp_t; kargp_t ap = (kargp_t)__builtin_amdgcn_kernarg_segment_ptr(); asm volatile("" : "+v"(tid), "+s"(bid), "+s"(ap)); \
        const int lane = tid & 63, wave = tid >> 6, gw = bid * NWAVES + wave, gt = bid * NTHREADS + tid; (void)lane; (void)wave; (void)gw; (void)gt;
template <int ONLYK, int STEP> __device__ __forceinline__ void run_step(unsigned char* lds, int G, int NGW, int NGT, int wave_u) {
    STEP_PRE();
    constexpr int g = (STEP - 1) / STEPS_PER_GROUP, k = (STEP - 1) % STEPS_PER_GROUP; constexpr int t0 = g * TG; constexpr int S = (g < 2) ? 2048 : 4096;
    if constexpr (STEP == 0) {
        { MKP(); phase_prologue<0>(P, lds, bid, G, tid); }
    } else if constexpr (STEP == NSTEPS - 1) {
        { MKP(); phase_final(P, ssq3, NGROUPS - 1, gw, NGW, lane); }
    } else {
            if constexpr (k == 0) {
                pg8::Gemm gm{XBg, Win, TG, NPA, D}; pg8::StaticOrder So; So.init(TG, NPA, G, bid); pg8::EpiProjA E{ATT, DNQ, Z, SMALL, rstd1, ropeC, ropeS, S - 1};
                pg8::gemm_phase<pg8::EpiProjA, pg8::StaticOrder, true, true>((LAS unsigned char*)lds, gm, So, E, tid);
            } else if constexpr (k == 1) {
                phase_attn(ATT, PO, LSE2, S, lds, bid, G, tid);
            } else if constexpr (k == 2) {
                MKP(); if constexpr (g > 0) phase_final(P, ssq3, g - 1, gw, NGW, lane);
                if constexpr (g == 0) { phase_prologue<1>(P, lds, bid, G, tid); __syncthreads(); }
                phase_dna(P, DNQ, SMALL, FRAGP, VACCP, TIP, VECP, S, lds, bid, G, tid);
            } else if constexpr (k == 3) {
                constexpr int nchain = (TG / S) * 16;
                if (bid < nchain) phase_scan(FRAGP, TIP, VACCP, VECP, OF, OB, S, lds, bid, G, tid);
                else { pg8::Gemm gm{XBg, Win + (size_t)NPA * D, TG, 2048, D}; pg8::StaticOrder So; So.init(TG, 2048, G - nchain, bid - nchain); pg8::EpiGates E{Gt, rstd1};
                  pg8::gemm_phase<pg8::EpiGates, pg8::StaticOrder, true, true>((LAS unsigned char*)lds, gm, So, E, tid); }
            } else if constexpr (k == 4) {
                phase_attn_combine(PO, LSE2, AB, gt, NGT); MKP(); phase_combine(P, OF, OB, Z, AB, gw, NGW, lane);
            } else if constexpr (k == 5) {
                pg8::Gemm gm{AB, Wa, TG, D, 1536}; pg8::StaticOrder So; So.init(TG, D, G, bid); pg8::EpiMix E{Gt, MIX};
                pg8::gemm_phase<pg8::EpiMix, pg8::StaticOrder, true, true>((LAS unsigned char*)lds, gm, So, E, tid);
            } else if constexpr (k == 6) {
                pg8::Gemm gm{MIX, Wout, TG, D, D}; pg8::StaticOrder So; So.init(TG, D, G, bid);
                const float* RES = (g < 2) ? LDP(0) + (size_t)t0 * D : LDP(1); pg8::EpiRes E{RES, OUTg, XBg, ssq2 + t0};
                pg8::gemm_phase<pg8::EpiRes, pg8::StaticOrder, true, true>((LAS unsigned char*)lds, gm, So, E, tid);
            } else if constexpr (k == 7) {
                pg8::Gemm gm{XBg, Wup, TG, NUP, D}; pg8::StaticOrder So; So.init(TG, NUP, G, bid); pg8::EpiUpAct E{ACT, EDGEP, ssq2 + t0, LDP(15), LDP(16), (LAS unsigned char*)lds};
                pg8::gemm_phase<pg8::EpiUpAct, pg8::StaticOrder, true, true>((LAS unsigned char*)lds, gm, So, E, tid);
            } else {
                { MKP(); if constexpr (g + 1 < NGROUPS) phase_xb(P, g + 1, gw, NGW, lane);
                  pg8::StaticOrder So; So.init(TG, D, G, bid); pg8::Unit u0; if (So.next(0, u0)) act_fix(P, EDGEP, ACT, u0.pm, S, tid);
                  asm volatile("s_waitcnt vmcnt(0)" ::: "memory"); __syncthreads(); }
                pg8::Gemm gm{ACT, Wdn, TG, D, DFF}; pg8::StaticOrder So; So.init(TG, D, G, bid); pg8::EpiRes E{OUTg, OUTg, nullptr, ssq3 + t0};
                pg8::gemm_phase<pg8::EpiRes, pg8::StaticOrder, true, true>((LAS unsigned char*)lds, gm, So, E, tid);
            }
    }
}
template <int ONLYK, int STEP> __device__ __forceinline__ void run_steps(unsigned char* lds, cg::grid_group& grid, const XcdBarrier& xb, int lo, int hi, int G, int NGW, int NGT, int wave_u) {
    if constexpr (STEP < NSTEPS) {
        if (lo <= STEP && STEP < hi) { run_step<ONLYK, STEP>(lds, G, NGW, NGT, wave_u);
            if (STEP + 1 < hi) {
#if defined(DUP_PHASE) && DUP_PHASE == 5
                grid.sync();
#endif
                if constexpr (STEP == 0) grid.sync();
                else { const int tid = wave_u * 64 + (int)__builtin_amdgcn_mbcnt_hi(~0u, __builtin_amdgcn_mbcnt_lo(~0u, 0u)); xcd_barrier(xb, tid); } } }
        run_steps<ONLYK, STEP + 1>(lds, grid, xb, lo, hi, G, NGW, NGT, wave_u);
    }
}
template <int ONLYK> __global__ void __launch_bounds__(NTHREADS, 2) fwd(Args args) {
    extern __shared__ __attribute__((aligned(16))) unsigned char lds[];
    const int G = gridDim.x, NGW = G * NWAVES, NGT = G * NTHREADS;
    cg::grid_group grid = cg::this_grid();
    const int wave_u = __builtin_amdgcn_readfirstlane((int)threadIdx.x >> 6);
    volatile LAS unsigned* st = (volatile LAS unsigned*)((LAS unsigned char*)lds + LDS_BYTES - 16);
    if (threadIdx.x < 4) st[threadIdx.x] = 0u;
    __syncthreads();
    const XcdBarrier xb = xcd_barrier_post((unsigned*)(args.ws + WS_CTL) + CW_BAR, st, (int)threadIdx.x);
    run_steps<ONLYK, 0>(lds, grid, xb, args.lo, args.hi, G, NGW, NGT, wave_u);
}

extern "C" void kernel_launch(void* const* d_in, const int* in_sizes, int n_in, void* d_out, int out_size, void* d_ws, size_t ws_size, hipStream_t stream) {
    static int grid = 0;
    if (grid == 0) {
        if (n_in != 19 || ws_size < WS_END) { fprintf(stderr, "kernel_launch: unexpected n_in %d / ws_size %zu (need %zu)\n", n_in, ws_size, (size_t)WS_END); grid = -1; return; }
        int dev = 0, cus = 0; (void)hipGetDevice(&dev); (void)hipDeviceGetAttribute(&cus, hipDeviceAttributeMultiprocessorCount, dev);
        if (hipFuncSetAttribute((const void*)fwd<-1>, hipFuncAttributeMaxDynamicSharedMemorySize, LDS_BYTES) != hipSuccess) { fprintf(stderr, "kernel_launch: hipFuncSetAttribute failed\n"); grid = -1; return; }
        int per_cu = 0;
        if (hipOccupancyMaxActiveBlocksPerMultiprocessor(&per_cu, (const void*)fwd<-1>, NTHREADS, LDS_BYTES) != hipSuccess || per_cu < 1) { fprintf(stderr, "kernel_launch: occupancy query failed / %d blocks per CU\n", per_cu); grid = -1; return; }
        grid = cus;
    }
    if (grid < 0) return;
    (void)hipMemsetAsync((char*)d_ws + WS_CTL, 0, CTL_BYTES, stream);
    Args a{};
    for (int i = 0; i < 19; ++i) a.in[i] = (const float*)d_in[i];
    a.out = (float*)d_out; a.ws = (unsigned char*)d_ws;
    a.lo = 0; a.hi = NSTEPS; void* kargs[] = {&a};
    hipError_t e = hipLaunchCooperativeKernel((const void*)fwd<-1>, dim3(grid), dim3(NTHREADS), kargs, LDS_BYTES, stream);
    if (e != hipSuccess) fprintf(stderr, "cooperative launch failed: %s (grid %d)\n", hipGetErrorString(e), grid);
}
```

```cpp
#include <hip/hip_runtime.h>
#include <hip/hip_cooperative_groups.h>
#include <cstdio>
#include <cstdint>
namespace cg = cooperative_groups;
namespace pg8 {
#define PG8_LAS __attribute__((address_space(3)))
typedef unsigned short bf16_t;
typedef short bf16x8 __attribute__((ext_vector_type(8)));
typedef float f32x4 __attribute__((ext_vector_type(4)));
typedef unsigned u32x4 __attribute__((ext_vector_type(4)));
constexpr int BM = 256, BK = 64, HALF = 128, HTB = HALF * BK * 2  , STAGE_BYTES = 8 * HTB, NXCD = 8, WGM = 8;

__host__ __device__ __forceinline__ int lds_byte(int r, int c) { const int st = (r >> 4) * 2 + (c >> 5), rr = r & 15, cc = c & 31, ob = rr * 64 + cc * 2; return st * 1024 + (ob ^ (((ob >> 9) & 1) << 5)); }
__host__ __device__ __forceinline__ void stage_rc(int b, int& R, int& C) { const int st = b / 1024, sb = b % 1024, swz = sb ^ (((sb >> 9) & 1) << 5); R = (st >> 1) * 16 + swz / 64; C = (st & 1) * 32 + (swz % 64) / 2; }
__host__ __device__ __forceinline__ int perm32(int rho) { const int n = rho >> 4, i = rho & 15; return 8 * (i >> 2) + 4 * n + (i & 3); }

struct Unit { int pm, pn; };
struct Gemm { const bf16_t* A; const bf16_t* Bt; int M, N, K; };

struct StaticOrder {
    int nM, nN, nwg, G, c;
    __host__ __device__ void init(int M, int N, int G_, int c_) { nM = M / BM; nN = N / BM; nwg = nM * nN; G = G_; c = c_; }
    __host__ __device__ bool next(int i, Unit& u) const {
        const long L = (long)i * G + c; if (L >= nwg) return false;
        int wgid = (int)L; { const int q = nwg / NXCD, r = nwg % NXCD, xcd = wgid % NXCD, off = wgid / NXCD; wgid = (xcd < r ? xcd * (q + 1) : r * (q + 1) + (xcd - r) * q) + off; }
        const int nig = WGM * nN, gid = wgid / nig, fm = gid * WGM, gsz = (nM - fm) < WGM ? (nM - fm) : WGM;
        u.pm = fm + ((wgid % nig) % gsz); u.pn = (wgid % nig) / gsz; return true;
    }
    __device__ __forceinline__ void a_ready(const Unit&) const {}
    __device__ __forceinline__ void done(const Unit&) const {}
};

typedef float f32x2_cv __attribute__((ext_vector_type(2))); typedef __bf16 bf16x2_cv __attribute__((ext_vector_type(2)));
__device__ __forceinline__ unsigned cvt_pk_bf16(float lo, float hi) { const f32x2_cv v = {lo, hi}; const bf16x2_cv b = __builtin_convertvector(v, bf16x2_cv); return __builtin_bit_cast(unsigned, b); }
typedef float f32x2 __attribute__((ext_vector_type(2)));
typedef unsigned u32x2 __attribute__((ext_vector_type(2)));
__device__ __forceinline__ float bflo(unsigned w) { return __uint_as_float(w << 16); }
__device__ __forceinline__ float bfhi(unsigned w) { return __uint_as_float(w & 0xffff0000u); }
__device__ __forceinline__ float sigmoidf_(float x) { return __builtin_amdgcn_rcpf(1.0f + __expf(-x)); }
constexpr float RMS_EPS = 1e-6f;
__device__ __forceinline__ f32x2 gelu_pk(f32x2 v) {
    const f32x2 av = __builtin_elementwise_abs(v), d = av * 0.2316418882f + 1.0f;
    f32x2 t; t.x = __builtin_amdgcn_rcpf(d.x); t.y = __builtin_amdgcn_rcpf(d.y);
    f32x2 q = t * 0.5307027145f + (-0.7265760135f); q = q * t + 0.7107068705f; q = q * t + (-0.142248368f); q = q * t + 0.127414796f; q = q * t;
    const f32x2 s = (v * v) * (-0.72134752044f);
    f32x2 e; e.x = __builtin_amdgcn_exp2f(s.x); e.y = __builtin_amdgcn_exp2f(s.y);
    const f32x2 m = v * (q * e), r = v - m;
    f32x2 o; o.x = v.x < 0.f ? m.x : r.x; o.y = v.y < 0.f ? m.y : r.y; return o;
}

struct EpiProjA {
    static constexpr bool PERM = true, AFTER_DRAIN = false;
    bf16_t* ATT; bf16_t* DNQ; bf16_t* Z; float* SMALL; const float* rstd; const float* ropeC; const float* ropeS; int smask;
    __device__ __forceinline__ void operator()(const f32x4 (&acc)[2][2][4][2], const Unit& u, int wr, int wc, int fr, int fq) const {
        const int row0 = u.pm * BM + wr * 64 + fr; const int pn = u.pn;
        bf16_t* base; int ldc, colt;
        if (pn < 18) { base = ATT; ldc = 4608; colt = pn * 256; } else if (pn < 30) { base = DNQ; ldc = 3072; colt = (pn - 18) * 256; } else { base = Z; ldc = 1024; colt = (pn - 30) * 256; }
        const int col0 = colt + wc * 32 + 8 * fq;
        const bool do_rope = (pn < 12) && ((wc & 1) == 0);
        const float qs = (pn < 6) ? 0.18033688011112042f : 1.0f;
        float rs[2][4];
#pragma unroll
        for (int ai = 0; ai < 2; ++ai)
#pragma unroll
            for (int m = 0; m < 4; ++m) rs[ai][m] = rstd[row0 + ai * HALF + m * 16] * qs;
#pragma unroll
        for (int ai = 0; ai < 2; ++ai) {
            f32x4 cc[4], ss[4];
            if (do_rope) {
#pragma unroll
                for (int m = 0; m < 4; ++m) { const int pos = (row0 + ai * HALF + m * 16) & smask; cc[m] = *(const f32x4*)(ropeC + pos * 8 + 4 * (fq & 1)); ss[m] = *(const f32x4*)(ropeS + pos * 8 + 4 * (fq & 1));
                    if (fq >= 2) { cc[m] = (f32x4){1.f, 1.f, 1.f, 1.f}; ss[m] = (f32x4){0.f, 0.f, 0.f, 0.f}; } } }
#pragma unroll
            for (int m = 0; m < 4; ++m) { const int r = row0 + ai * HALF + m * 16;
#pragma unroll
                for (int bj = 0; bj < 2; ++bj) { f32x4 v0 = acc[ai][bj][m][0] * rs[ai][m], v1 = acc[ai][bj][m][1] * rs[ai][m];
                    if (do_rope) { const f32x4 c = cc[m], s = ss[m];
                        const f32x4 a0 = v0, a1 = v1;
                        v0[0] = a0[0] * c[0] - a0[1] * s[0]; v0[1] = a0[1] * c[0] + a0[0] * s[0]; v0[2] = a0[2] * c[1] - a0[3] * s[1]; v0[3] = a0[3] * c[1] + a0[2] * s[1];
                        v1[0] = a1[0] * c[2] - a1[1] * s[2]; v1[1] = a1[1] * c[2] + a1[0] * s[2]; v1[2] = a1[2] * c[3] - a1[3] * s[3]; v1[3] = a1[3] * c[3] + a1[2] * s[3]; }
                    if (pn < 34) { u32x4 w; w.x = cvt_pk_bf16(v0[0], v0[1]); w.y = cvt_pk_bf16(v0[2], v0[3]); w.z = cvt_pk_bf16(v1[0], v1[1]); w.w = cvt_pk_bf16(v1[2], v1[3]);
                        *(u32x4*)(base + (size_t)r * ldc + col0 + bj * HALF) = w; }
                    else if (bj == 0 && wc == 0) { float* sp = SMALL + (size_t)r * 32 + 8 * fq; *(f32x4*)sp = v0; *(f32x4*)(sp + 4) = v1; } } } }
    }
};
struct EpiGates {
    static constexpr bool PERM = true, AFTER_DRAIN = false;
    bf16_t* G; const float* rstd;
    __device__ __forceinline__ void operator()(const f32x4 (&acc)[2][2][4][2], const Unit& u, int wr, int wc, int fr, int fq) const {
        const int row0 = u.pm * BM + wr * 64 + fr; const int col0 = u.pn * BM + wc * 32 + 8 * fq;
        float rs8[2][4];
#pragma unroll
        for (int ai = 0; ai < 2; ++ai)
#pragma unroll
            for (int m = 0; m < 4; ++m) rs8[ai][m] = rstd[row0 + ai * HALF + m * 16];
#pragma unroll
        for (int ai = 0; ai < 2; ++ai)
#pragma unroll
            for (int m = 0; m < 4; ++m) { const int r = row0 + ai * HALF + m * 16; const float rs = rs8[ai][m];
#pragma unroll
                for (int bj = 0; bj < 2; ++bj) { const f32x4 v0 = acc[ai][bj][m][0] * rs, v1 = acc[ai][bj][m][1] * rs;
                    u32x4 w; w.x = cvt_pk_bf16(sigmoidf_(v0[0]), sigmoidf_(v0[1])); w.y = cvt_pk_bf16(sigmoidf_(v0[2]), sigmoidf_(v0[3])); w.z = cvt_pk_bf16(sigmoidf_(v1[0]), sigmoidf_(v1[1])); w.w = cvt_pk_bf16(sigmoidf_(v1[2]), sigmoidf_(v1[3]));
                    *(u32x4*)(G + (size_t)r * 2048 + col0 + bj * HALF) = w; } }
    }
};
struct EpiF32 {
    static constexpr bool PERM = false, AFTER_DRAIN = false;
    float* C; int ldc;
    __device__ __forceinline__ void operator()(const f32x4 (&acc)[2][2][4][2], const Unit& u, int wr, int wc, int fr, int fq) const {
        const int row0 = u.pm * BM + wr * 64 + fr, col0 = u.pn * BM + wc * 32 + 4 * fq;
#pragma unroll
        for (int ai = 0; ai < 2; ++ai)
#pragma unroll
            for (int m = 0; m < 4; ++m) { float* rowp = C + (size_t)(row0 + ai * HALF + m * 16) * ldc + col0;
#pragma unroll
                for (int bj = 0; bj < 2; ++bj)
#pragma unroll
                    for (int n = 0; n < 2; ++n) *(f32x4*)(rowp + bj * HALF + n * 16) = acc[ai][bj][m][n]; }
    }
};
struct EpiMix {
    static constexpr bool PERM = true, AFTER_DRAIN = false, HAS_MID = true; static constexpr int MID_T = 8;
    const bf16_t* G; bf16_t* MIX;
    __device__ __forceinline__ void mid(f32x4 (&acc)[2][2][4][2], const Unit& u, int wr, int wc, int fr, int fq) const {
        asm volatile("" : "+v"(fr), "+v"(fq));
        const int row0 = u.pm * BM + wr * 64 + fr; const int col0 = u.pn * BM + wc * 32 + 8 * fq;
#pragma unroll
        for (int ai = 0; ai < 2; ++ai)
#pragma unroll
            for (int m = 0; m < 4; ++m) { const int r = row0 + ai * HALF + m * 16;
#pragma unroll
                for (int bj = 0; bj < 2; ++bj) { const int c = col0 + bj * HALF;
                    const u32x4 ga = *(const u32x4*)(G + (size_t)r * 2048 + c), gb = *(const u32x4*)(G + (size_t)r * 2048 + 1024 + c);
                    f32x4 r0, r1;
                    r0[0] = bflo(ga.x) * __builtin_amdgcn_rcpf(bflo(gb.x)); r0[1] = bfhi(ga.x) * __builtin_amdgcn_rcpf(bfhi(gb.x)); r0[2] = bflo(ga.y) * __builtin_amdgcn_rcpf(bflo(gb.y)); r0[3] = bfhi(ga.y) * __builtin_amdgcn_rcpf(bfhi(gb.y));
                    r1[0] = bflo(ga.z) * __builtin_amdgcn_rcpf(bflo(gb.z)); r1[1] = bfhi(ga.z) * __builtin_amdgcn_rcpf(bfhi(gb.z)); r1[2] = bflo(ga.w) * __builtin_amdgcn_rcpf(bflo(gb.w)); r1[3] = bfhi(ga.w) * __builtin_amdgcn_rcpf(bfhi(gb.w));
                    acc[ai][bj][m][0] = acc[ai][bj][m][0] * r0; acc[ai][bj][m][1] = acc[ai][bj][m][1] * r1; }
                asm volatile("" ::: "memory"); }
    }
    __device__ __forceinline__ void operator()(const f32x4 (&acc)[2][2][4][2], const Unit& u, int wr, int wc, int fr, int fq) const {
        const int row0 = u.pm * BM + wr * 64 + fr; const int col0 = u.pn * BM + wc * 32 + 8 * fq;
#pragma unroll
        for (int ai = 0; ai < 2; ++ai)
#pragma unroll
            for (int m = 0; m < 4; ++m) { const int r = row0 + ai * HALF + m * 16;
#pragma unroll
                for (int bj = 0; bj < 2; ++bj) { const int c = col0 + bj * HALF;
                    const u32x4 gb = *(const u32x4*)(G + (size_t)r * 2048 + 1024 + c);
                    const f32x4 a0 = acc[ai][bj][m][0], a1 = acc[ai][bj][m][1];
                    u32x4 w;
                    w.x = cvt_pk_bf16(bflo(gb.x) * a0[0], bfhi(gb.x) * a0[1]); w.y = cvt_pk_bf16(bflo(gb.y) * a0[2], bfhi(gb.y) * a0[3]);
                    w.z = cvt_pk_bf16(bflo(gb.z) * a1[0], bfhi(gb.z) * a1[1]); w.w = cvt_pk_bf16(bflo(gb.w) * a1[2], bfhi(gb.w) * a1[3]);
                    *(u32x4*)(MIX + (size_t)r * 1024 + c) = w; } }
    }
};
struct EpiRes {
    static constexpr bool PERM = false, AFTER_DRAIN = false;
    const float* RES; float* OUT; bf16_t* XB; float* ssq;
    __device__ __forceinline__ void operator()(const f32x4 (&acc)[2][2][4][2], const Unit& u, int wr, int wc, int fr, int fq) const {
        const int row0 = u.pm * BM + wr * 64 + fr, col0 = u.pn * BM + wc * 32 + 4 * fq;
#pragma unroll
        for (int ai = 0; ai < 2; ++ai)
#pragma unroll
            for (int m = 0; m < 4; ++m) { const int r = row0 + ai * HALF + m * 16; const size_t off = (size_t)r * 1024 + col0; float s = 0.f;
#pragma unroll
                for (int bj = 0; bj < 2; ++bj)
#pragma unroll
                    for (int n = 0; n < 2; ++n) { const size_t o2 = off + bj * HALF + n * 16; const f32x4 v = *(const f32x4*)(RES + o2) + acc[ai][bj][m][n];
                        *(f32x4*)(OUT + o2) = v; s += (v[0] * v[0] + v[1] * v[1]) + (v[2] * v[2] + v[3] * v[3]);
                        if (XB) { u32x2 w; w.x = cvt_pk_bf16(v[0], v[1]); w.y = cvt_pk_bf16(v[2], v[3]); *(u32x2*)(XB + o2) = w; } }
                s += __shfl_xor(s, 16); s += __shfl_xor(s, 32);
                if (fq == 0) atomicAdd(ssq + r, s); }
    }
};
struct EpiResB {
    static constexpr bool PERM = false, AFTER_DRAIN = false;
    const bf16_t* RESB; float* OUT; bf16_t* XB; float* ssq;
    __device__ __forceinline__ void operator()(const f32x4 (&acc)[2][2][4][2], const Unit& u, int wr, int wc, int fr, int fq) const {
        const int row0 = u.pm * BM + wr * 64 + fr, col0 = u.pn * BM + wc * 32 + 4 * fq;
#pragma unroll
        for (int ai = 0; ai < 2; ++ai)
#pragma unroll
            for (int m = 0; m < 4; ++m) { const int r = row0 + ai * HALF + m * 16; const size_t off = (size_t)r * 1024 + col0; float s = 0.f;
#pragma unroll
                for (int bj = 0; bj < 2; ++bj)
#pragma unroll
                    for (int n = 0; n < 2; ++n) { const size_t o2 = off + bj * HALF + n * 16; const u32x2 rb = *(const u32x2*)(RESB + o2);
                        const f32x4 v = (f32x4){bflo(rb.x), bfhi(rb.x), bflo(rb.y), bfhi(rb.y)} + acc[ai][bj][m][n];
                        if (OUT) *(f32x4*)(OUT + o2) = v; s += (v[0] * v[0] + v[1] * v[1]) + (v[2] * v[2] + v[3] * v[3]);
                        if (XB) { u32x2 w; w.x = cvt_pk_bf16(v[0], v[1]); w.y = cvt_pk_bf16(v[2], v[3]); *(u32x2*)(XB + o2) = w; } }
                s += __shfl_xor(s, 16); s += __shfl_xor(s, 32);
                if (fq == 0) atomicAdd(ssq + r, s); }
    }
};
__device__ __forceinline__ float dpp_ror1(float x) { return __int_as_float(__builtin_amdgcn_mov_dpp(__float_as_int(x), 0x121, 0xF, 0xF, true)); }
__device__ __forceinline__ float dpp_ror15(float x) { return __int_as_float(__builtin_amdgcn_mov_dpp(__float_as_int(x), 0x12F, 0xF, 0xF, true)); }
struct EpiUpAct {
    static constexpr bool PERM = true, AFTER_DRAIN = false;
    bf16_t* ACT; float* EDGE; const float* ssq; const float* cw; const float* cb; PG8_LAS unsigned char* ldsb;
    __device__ __forceinline__ void operator()(const f32x4 (&acc)[2][2][4][2], const Unit& u, int wr, int wc, int fr, int fq) const {
        const int cin0 = wc * 32 + 8 * fq, col = u.pn * 128 + cin0;
        PG8_LAS float* EX = (PG8_LAS float*)(ldsb + 131072);
        float* edge = EDGE + ((size_t)u.pm * 22 + u.pn) * 768;
        f32x4 g[2][4][2], v[2][4][2];
#pragma unroll
        for (int ai = 0; ai < 2; ++ai)
#pragma unroll
            for (int m = 0; m < 4; ++m) { const int r = u.pm * BM + ai * HALF + wr * 64 + m * 16 + fr; const float rs = rsqrtf(ssq[r] * (1.0f / 1024.0f) + RMS_EPS);
#pragma unroll
                for (int n = 0; n < 2; ++n) { g[ai][m][n] = acc[ai][0][m][n] * rs; v[ai][m][n] = acc[ai][1][m][n] * rs; } }
#pragma unroll
        for (int ai = 0; ai < 2; ++ai) { const int ci = 2 * ai + wr;
            if (fr == 0) { *(PG8_LAS f32x4*)(EX + (ci * 2 + 0) * 128 + cin0) = g[ai][0][0]; *(PG8_LAS f32x4*)(EX + (ci * 2 + 0) * 128 + cin0 + 4) = g[ai][0][1]; }
            if (fr == 15) { *(PG8_LAS f32x4*)(EX + (ci * 2 + 1) * 128 + cin0) = g[ai][3][0]; *(PG8_LAS f32x4*)(EX + (ci * 2 + 1) * 128 + cin0 + 4) = g[ai][3][1]; } }
        if (wr == 0 && fr <= 1) { *(f32x4*)(edge + fr * 128 + cin0) = g[0][0][0]; *(f32x4*)(edge + fr * 128 + cin0 + 4) = g[0][0][1]; }
        if (wr == 1 && fr >= 14) { *(f32x4*)(edge + (fr - 12) * 128 + cin0) = g[1][3][0]; *(f32x4*)(edge + (fr - 12) * 128 + cin0 + 4) = g[1][3][1]; }
        if (wr == 0 && fr == 0) { *(f32x4*)(edge + 4 * 128 + cin0) = v[0][0][0]; *(f32x4*)(edge + 4 * 128 + cin0 + 4) = v[0][0][1]; }
        if (wr == 1 && fr == 15) { *(f32x4*)(edge + 5 * 128 + cin0) = v[1][3][0]; *(f32x4*)(edge + 5 * 128 + cin0 + 4) = v[1][3][1]; }
        f32x4 w0[2], w1[2], w2[2], bb[2];
#pragma unroll
        for (int n = 0; n < 2; ++n) { w0[n] = *(const f32x4*)(cw + col + 4 * n); w1[n] = *(const f32x4*)(cw + 2816 + col + 4 * n); w2[n] = *(const f32x4*)(cw + 2 * 2816 + col + 4 * n); bb[n] = *(const f32x4*)(cb + col + 4 * n); }
        asm volatile("s_waitcnt lgkmcnt(0)" ::: "memory"); __builtin_amdgcn_s_barrier(); asm volatile("" ::: "memory");
#pragma unroll
        for (int ai = 0; ai < 2; ++ai) { const int ci = 2 * ai + wr; f32x4 topn[2], botn[2];
#pragma unroll
            for (int n = 0; n < 2; ++n) { topn[n] = (ci > 0) ? *(const PG8_LAS f32x4*)(EX + ((ci - 1) * 2 + 1) * 128 + cin0 + 4 * n) : (f32x4){0.f, 0.f, 0.f, 0.f};
                botn[n] = (ci < 3) ? *(const PG8_LAS f32x4*)(EX + ((ci + 1) * 2 + 0) * 128 + cin0 + 4 * n) : (f32x4){0.f, 0.f, 0.f, 0.f}; }
#pragma unroll
            for (int m = 0; m < 4; ++m) { const int r = u.pm * BM + ai * HALF + wr * 64 + m * 16 + fr; float o[8];
#pragma unroll
                for (int n = 0; n < 2; ++n)
#pragma unroll
                    for (int e2 = 0; e2 < 4; e2 += 2) { f32x2 gc;
#pragma unroll
                        for (int k = 0; k < 2; ++k) { const int e = e2 + k; const float gm = g[ai][m][n][e];
                            const float a1 = dpp_ror1(gm), b1 = (m > 0) ? dpp_ror1(g[ai][m > 0 ? m - 1 : 0][n][e]) : topn[n][e]; const float up = (fr == 0) ? b1 : a1;
                            const float a2 = dpp_ror15(gm), b2 = (m < 3) ? dpp_ror15(g[ai][m < 3 ? m + 1 : 3][n][e]) : botn[n][e]; const float dn = (fr == 15) ? b2 : a2;
                            gc[k] = bb[n][e] + w0[n][e] * up + w1[n][e] * gm + w2[n][e] * dn; }
                        const f32x2 ge = gelu_pk(gc); o[4 * n + e2] = ge.x * v[ai][m][n][e2]; o[4 * n + e2 + 1] = ge.y * v[ai][m][n][e2 + 1]; }
                u32x4 w; w.x = cvt_pk_bf16(o[0], o[1]); w.y = cvt_pk_bf16(o[2], o[3]); w.z = cvt_pk_bf16(o[4], o[5]); w.w = cvt_pk_bf16(o[6], o[7]);
                *(u32x4*)(ACT + (size_t)r * 2816 + col) = w; } }
    }
};
template <class T, class = void> struct has_mid { static constexpr bool value = false; };
template <class T> struct has_mid<T, decltype((void)T::HAS_MID)> { static constexpr bool value = true; };
template <class Epi, class Sched, bool ALIGN_EPI = false, bool SP2 = false>
__device__ __forceinline__ void gemm_phase(PG8_LAS unsigned char* lds, const Gemm g, const Sched& S, const Epi& E, int tid_) {
    asm volatile("" : "+v"(tid_)); const int tid = tid_, wid = __builtin_amdgcn_readfirstlane(tid >> 6), lane = tid & 63, wr = wid >> 2, wc = wid & 3, fr = lane & 15, fq = lane >> 4;
    const int K = g.K, nt = K / BK;
    unsigned voffA[2], voffB[2];
#pragma unroll
    for (int i = 0; i < 2; ++i) { int R, C; stage_rc(tid * 16 + i * 8192, R, C); const int Rb = Epi::PERM ? ((R & ~31) + perm32(R & 31)) : R;
        voffA[i] = (unsigned)(R * K + C) * 2u; voffB[i] = (unsigned)(Rb * K + C) * 2u; }
    const size_t kstep = (size_t)(BK * 2);
    const size_t hstep = (size_t)HALF * K * 2;
    const size_t tstep = 2 * hstep;
    const unsigned ldsw = (unsigned)wid * 1024u;
    const int aoff = lds_byte(wr * 64 + fr, fq * 8), boff = lds_byte(wc * 32 + fr, fq * 8);
#define PG8_SA(b, h) (((b) * 2 + (h)) * HTB)
#define PG8_SB(b, h) ((4 + (b) * 2 + (h)) * HTB)
#define PG8_STAGE(bufoff, gbase, voff) do { _Pragma("unroll") for (int _i = 0; _i < 2; ++_i) \
        __builtin_amdgcn_global_load_lds((const unsigned*)((const char*)(gbase) + (voff)[_i]), (PG8_LAS unsigned*)(lds + (bufoff) + ldsw + _i * 8192), 16, 0, 0); } while (0)
#define PG8_LDA(dst, b, h) do { _Pragma("unroll") for (int m = 0; m < 4; ++m) _Pragma("unroll") for (int k = 0; k < 2; ++k) dst[m][k] = *(const PG8_LAS bf16x8*)(lds + PG8_SA(b, h) + aoff + m * 2048 + k * 1024); } while (0)
#define PG8_LDB(dst, b, h) do { _Pragma("unroll") for (int n = 0; n < 2; ++n) _Pragma("unroll") for (int k = 0; k < 2; ++k) dst[n][k] = *(const PG8_LAS bf16x8*)(lds + PG8_SB(b, h) + boff + n * 2048 + k * 1024); } while (0)
#define PG8_MMA(ai, bj, At, Bt) do { __builtin_amdgcn_s_setprio(1); _Pragma("unroll") for (int m = 0; m < 4; ++m) _Pragma("unroll") for (int n = 0; n < 2; ++n) _Pragma("unroll") for (int k = 0; k < 2; ++k) \
        acc[ai][bj][m][n] = __builtin_amdgcn_mfma_f32_16x16x32_bf16(Bt[n][k], At[m][k], acc[ai][bj][m][n], 0, 0, 0); __builtin_amdgcn_s_setprio(0); } while (0)
#define PG8_WAIT_V(n) asm volatile("s_waitcnt vmcnt(" #n ")" ::: "memory")
#define PG8_WAIT_L(n) asm volatile("s_waitcnt lgkmcnt(" #n ")" ::: "memory")
#define PG8_BAR __builtin_amdgcn_s_barrier()
#define PG8_SCHED __builtin_amdgcn_sched_barrier(0)
    Unit cur, nxt; int ui = 0;
    if (!S.next(0, cur)) return;
    f32x4 acc[2][2][4][2];
    f32x4 zz_ = (f32x4){0.f, 0.f, 0.f, 0.f}; asm volatile("" : "+v"(zz_));
#pragma unroll
    for (int a = 0; a < 2; ++a)
#pragma unroll
        for (int b = 0; b < 2; ++b)
#pragma unroll
            for (int m = 0; m < 4; ++m)
#pragma unroll
                for (int n = 0; n < 2; ++n) acc[a][b][m][n] = zz_;
    bf16x8 At[4][2], B0[2][2], B1[2][2];
    const char* cA = (const char*)g.A + (size_t)cur.pm * tstep; const char* cB = (const char*)g.Bt + (size_t)cur.pn * tstep;
    S.a_ready(cur);
    if constexpr (SP2) {
        PG8_STAGE(PG8_SB(0, 0), cB, voffB); PG8_STAGE(PG8_SB(0, 1), cB + hstep, voffB); PG8_STAGE(PG8_SA(0, 0), cA, voffA); PG8_STAGE(PG8_SA(0, 1), cA + hstep, voffA);
        if (wr == 1) PG8_BAR;
        PG8_WAIT_V(2); PG8_BAR;
        PG8_STAGE(PG8_SB(1, 0), cB + kstep, voffB); PG8_STAGE(PG8_SA(1, 0), cA + kstep, voffA); PG8_STAGE(PG8_SB(1, 1), cB + hstep + kstep, voffB);
        PG8_WAIT_V(6); PG8_BAR;
    } else {
        PG8_STAGE(PG8_SB(0, 0), cB, voffB); PG8_STAGE(PG8_SA(0, 0), cA, voffA); PG8_STAGE(PG8_SB(0, 1), cB + hstep, voffB); PG8_STAGE(PG8_SA(0, 1), cA + hstep, voffA);
        if (wr == 1) PG8_BAR;
        PG8_WAIT_V(4); PG8_BAR;
        PG8_STAGE(PG8_SB(1, 0), cB + kstep, voffB); PG8_STAGE(PG8_SA(1, 0), cA + kstep, voffA); PG8_STAGE(PG8_SB(1, 1), cB + hstep + kstep, voffB);
        PG8_WAIT_V(6); PG8_BAR;
    }
    for (;;) {
        const bool has_next = S.next(ui + 1, nxt);
        const char* nA = has_next ? (const char*)g.A + (size_t)nxt.pm * tstep : cA; const char* nB = has_next ? (const char*)g.Bt + (size_t)nxt.pn * tstep : cB;
        for (int t = 0; t < nt; t += 2) {
            if constexpr (has_mid<Epi>::value) { if (t == Epi::MID_T) E.mid(acc, cur, wr, wc, fr, fq); }
            const bool last = (t == nt - 2);
            const char* a1 = cA + (size_t)(t + 1) * kstep;
            const char* a2 = last ? nA : cA + (size_t)(t + 2) * kstep; const char* b2 = last ? nB : cB + (size_t)(t + 2) * kstep;
            const char* a3 = a2 + kstep; const char* b3 = b2 + kstep;
            if (last && has_next) S.a_ready(nxt);
            if constexpr (SP2) {
            PG8_LDB(B0, 0, 0); PG8_LDB(B1, 0, 1); PG8_SCHED; PG8_LDA(At, 0, 0); PG8_STAGE(PG8_SA(1, 1), a1 + hstep, voffA);
            PG8_WAIT_V(8); PG8_WAIT_L(0); PG8_BAR; PG8_MMA(0, 0, At, B0); PG8_MMA(0, 1, At, B1); PG8_BAR; PG8_SCHED;
            PG8_LDA(At, 0, 1); PG8_STAGE(PG8_SB(0, 0), b2, voffB); PG8_STAGE(PG8_SB(0, 1), b2 + hstep, voffB); PG8_STAGE(PG8_SA(0, 0), a2, voffA);
            PG8_WAIT_V(8); PG8_WAIT_L(0); PG8_BAR; PG8_MMA(1, 0, At, B0); PG8_MMA(1, 1, At, B1); PG8_BAR; PG8_SCHED;
            PG8_LDB(B0, 1, 0); PG8_LDB(B1, 1, 1); PG8_SCHED; PG8_LDA(At, 1, 0); PG8_STAGE(PG8_SA(0, 1), a2 + hstep, voffA);
            PG8_WAIT_V(8); PG8_WAIT_L(0); PG8_BAR; PG8_MMA(0, 0, At, B0); PG8_MMA(0, 1, At, B1); PG8_BAR; PG8_SCHED;
            PG8_LDA(At, 1, 1); PG8_STAGE(PG8_SB(1, 0), b3, voffB); PG8_STAGE(PG8_SB(1, 1), b3 + hstep, voffB); PG8_STAGE(PG8_SA(1, 0), a3, voffA);
            PG8_WAIT_V(8); PG8_WAIT_L(0); PG8_BAR; PG8_MMA(1, 0, At, B0); PG8_MMA(1, 1, At, B1); PG8_BAR; PG8_SCHED;
            } else {
            PG8_LDB(B0, 0, 0); PG8_SCHED; PG8_LDA(At, 0, 0); PG8_STAGE(PG8_SA(1, 1), a1 + hstep, voffA);
            PG8_WAIT_L(8); PG8_BAR; PG8_WAIT_L(0); PG8_MMA(0, 0, At, B0); PG8_BAR; PG8_SCHED;
            PG8_LDB(B1, 0, 1); PG8_STAGE(PG8_SB(0, 0), b2, voffB);
            PG8_BAR; PG8_WAIT_L(0); PG8_MMA(0, 1, At, B1); PG8_BAR;
            PG8_LDA(At, 0, 1); PG8_STAGE(PG8_SA(0, 0), a2, voffA);
            PG8_BAR; PG8_WAIT_L(0); PG8_MMA(1, 0, At, B0); PG8_BAR; PG8_SCHED;
            PG8_STAGE(PG8_SB(0, 1), b2 + hstep, voffB);
            PG8_WAIT_V(6); PG8_BAR; PG8_MMA(1, 1, At, B1); PG8_BAR;
            PG8_LDB(B0, 1, 0); PG8_SCHED; PG8_LDA(At, 1, 0); PG8_STAGE(PG8_SA(0, 1), a2 + hstep, voffA);
            PG8_WAIT_L(8); PG8_BAR; PG8_WAIT_L(0); PG8_MMA(0, 0, At, B0); PG8_BAR; PG8_SCHED;
            PG8_LDB(B1, 1, 1); PG8_STAGE(PG8_SB(1, 0), b3, voffB);
            PG8_BAR; PG8_WAIT_L(0); PG8_MMA(0, 1, At, B1); PG8_BAR;
            PG8_LDA(At, 1, 1); PG8_STAGE(PG8_SA(1, 0), a3, voffA);
            PG8_BAR; PG8_WAIT_L(0); PG8_MMA(1, 0, At, B0); PG8_BAR; PG8_SCHED;
            PG8_STAGE(PG8_SB(1, 1), b3 + hstep, voffB);
            PG8_WAIT_V(6); PG8_BAR; PG8_MMA(1, 1, At, B1); PG8_BAR;
            }
        }
        if constexpr (ALIGN_EPI) { if (wr == 0) PG8_BAR; }
        if constexpr (!Epi::AFTER_DRAIN) { E(acc, cur, wr, wc, fr, fq); S.done(cur); }
        if (!has_next) break;
        zz_ = (f32x4){0.f, 0.f, 0.f, 0.f}; asm volatile("" : "+v"(zz_));
#pragma unroll
        for (int a = 0; a < 2; ++a)
#pragma unroll
            for (int b = 0; b < 2; ++b)
#pragma unroll
                for (int m = 0; m < 4; ++m)
#pragma unroll
                    for (int n = 0; n < 2; ++n) acc[a][b][m][n] = zz_;
        cur = nxt; cA = nA; cB = nB; ++ui;
        if constexpr (ALIGN_EPI) { if (wr == 1) PG8_BAR; }
    }
    PG8_WAIT_V(0);
    if constexpr (!ALIGN_EPI) { if (wr == 0) PG8_BAR; }
    PG8_BAR;
    if constexpr (Epi::AFTER_DRAIN) { E.fused(acc, cur, wr, wc, fr, fq, lds, wid, lane); S.done(cur); }
#undef PG8_SA
#undef PG8_SB
#undef PG8_STAGE
#undef PG8_LDA
#undef PG8_LDB
#undef PG8_MMA
#undef PG8_WAIT_V
#undef PG8_WAIT_L
#undef PG8_BAR
#undef PG8_SCHED
}
}

#define LAS __attribute__((address_space(3)))
typedef unsigned short bf16;
typedef float f32x4 __attribute__((ext_vector_type(4)));
typedef unsigned v4u __attribute__((ext_vector_type(4)));
typedef unsigned v2u __attribute__((ext_vector_type(2)));
using pg8::cvt_pk_bf16; using pg8::bflo; using pg8::bfhi;

constexpr int NWAVES = 8, NTHREADS = 512;
constexpr int D = 1024, NTOK = 49152, TG = 16384, NGROUPS = 3;
constexpr int ATTW = 4608, DNW = 3072, NPA = 8960  , NIN_T = 11008, DFF = 2816, NUP = 5632;
constexpr float EPS = 1e-6f;

constexpr size_t MiB = 1u << 20;
constexpr size_t WS_CTL = 0, CTL_BYTES = 1 * MiB;
constexpr size_t CTL_SSQ2 = 256 * 1024, CTL_SSQ3 = 512 * 1024;
constexpr size_t WS_WIN = 1 * MiB, WS_WUP = 23 * MiB, WS_WDOWN = 34 * MiB, WS_WOUT = 40 * MiB, WS_WA = 42 * MiB, WS_WB = 43 * MiB;
constexpr size_t WS_ROPE = 45 * MiB, WS_RSTD1 = 46 * MiB, WS_XB = 48 * MiB  , WS_ARENA = 80 * MiB, WS_END = 512 * MiB;
constexpr size_t AR_ATT = 0, AR_DNQ = 144 * MiB, AR_Z = 240 * MiB, AR_SMALL = 272 * MiB, AR_AO = 274 * MiB, AR_PO = 290 * MiB, AR_LSE = 338 * MiB, AR_MIX = 290 * MiB;
constexpr size_t AR_FRAG = 0, AR_VACC = 96 * MiB, AR_TI = 340 * MiB, AR_VEC = 404 * MiB;
constexpr size_t AR_OF = 144 * MiB, AR_OB = 176 * MiB, AR_DNOUT = 208 * MiB;
constexpr size_t AR_G = 0, AR_YA = 64 * MiB;
constexpr size_t AR_UP = 0, AR_ACT = 176 * MiB;
static_assert(WS_ARENA + AR_VEC + 8 * MiB <= WS_END, "ws map");

struct Args { const float* in[19]; float* out; unsigned char* ws; int lo, hi; };

__device__ __forceinline__ float wave_sum(float v) {
#pragma unroll
    for (int o = 1; o < 64; o <<= 1) v += __shfl_xor(v, o);
    return v;
}
__device__ __forceinline__ float bf2f(bf16 u) { return __uint_as_float((unsigned)u << 16); }
__device__ __forceinline__ float siluf_(float x) { return x * __builtin_amdgcn_rcpf(1.0f + __expf(-x)); }

__device__ __forceinline__ int rope_rowperm(int n) { const int d = n & 63; if (d >= 16) return n; const int i = d & 7, hf = d >> 3; return (n - d) + ((i < 4) ? (2 * i + hf) : (8 + 2 * (i - 4) + hf)); }
__device__ __forceinline__ void p0_transpose_item(const float* W, int ldw, int col_off, int K, int ncols, const float* gain, bf16* WT, int row_off, LAS float* scr, int item, int lane, int ldt = 0, int kofs = 0, int qk_limit = 0) {
    if (ldt == 0) ldt = K;
    const int nblk = ncols / 32, kb = item / nblk, nb = item % nblk, k0 = 64 * kb, n0 = 32 * nb;
#pragma unroll 8
    for (int i = 0; i < 32; ++i) { const int kk = 2 * i + (lane >> 5); float w = W[(size_t)(k0 + kk) * ldw + col_off + n0 + (lane & 31)]; if (gain) w *= gain[k0 + kk]; scr[kk * 33 + (lane & 31)] = w; }
    asm volatile("s_waitcnt lgkmcnt(0)" ::: "memory");
    const int c = lane & 7;
#pragma unroll
    for (int j = 0; j < 4; ++j) { const int n = (lane >> 3) + 8 * j; const LAS float* s = scr + (8 * c) * 33 + n;
        v4u o; o.x = cvt_pk_bf16(s[0 * 33], s[1 * 33]); o.y = cvt_pk_bf16(s[2 * 33], s[3 * 33]); o.z = cvt_pk_bf16(s[4 * 33], s[5 * 33]); o.w = cvt_pk_bf16(s[6 * 33], s[7 * 33]);
        const int nrow = (n0 + n < qk_limit) ? rope_rowperm(n0 + n) : n0 + n;
        *(v4u*)(WT + (size_t)(row_off + nrow) * ldt + kofs + k0 + 8 * c) = o; }
    asm volatile("s_waitcnt lgkmcnt(0)" ::: "memory");
}

struct Ptrs {
    const float *x_p, *x_s, *norm_mix_g, *w_in, *conv_w, *a_log_f, *a_log_b, *dt_f, *dt_b, *out_norm_g, *w_a, *w_b, *w_out, *norm_ffn_g, *w_up, *ffn_conv_w, *ffn_conv_b, *w_down, *norm_final_g;
    float* out; unsigned char* ws;
};
__device__ __forceinline__ const float* x_row(const Ptrs& P, int tok) { return tok < 32768 ? P.x_p + (size_t)tok * D : P.x_s + (size_t)(tok - 32768) * D; }

__device__ __forceinline__ void phase_xb(const Ptrs& P, int g, int gw, int NGW, int lane) {
    bf16* XB = (bf16*)(P.ws + WS_XB); float* rstd1 = (float*)(P.ws + WS_RSTD1);
    for (int m = gw; m < TG; m += NGW) {
        const f32x4* xr = (const f32x4*)x_row(P, g * TG + m) + lane; f32x4 v[4]; float s = 0.f;
#pragma unroll
        for (int j = 0; j < 4; ++j) { v[j] = xr[64 * j]; s += (v[j].x * v[j].x + v[j].y * v[j].y) + (v[j].z * v[j].z + v[j].w * v[j].w); }
        s = wave_sum(s);
        if (lane == 0) rstd1[g * TG + m] = rsqrtf(s * (1.0f / 1024.0f) + EPS);
        unsigned long long* o8 = (unsigned long long*)(XB + (size_t)m * D) + lane;
#pragma unroll
        for (int j = 0; j < 4; ++j) o8[64 * j] = (unsigned long long)cvt_pk_bf16(v[j].x, v[j].y) | ((unsigned long long)cvt_pk_bf16(v[j].z, v[j].w) << 32);
    }
}
template <int PART> __device__ __forceinline__ void phase_prologue(const Ptrs& P, unsigned char* lds, int bid, int G, int tid) {
    const int lane = tid & 63, wave = tid >> 6;
    LAS float* scr = (LAS float*)((LAS unsigned char*)lds + wave * 16384);
    const int gw = bid * NWAVES + wave, NGW = G * NWAVES;
    bf16* Win = (bf16*)(P.ws + WS_WIN); bf16* Wup = (bf16*)(P.ws + WS_WUP); bf16* Wdn = (bf16*)(P.ws + WS_WDOWN); bf16* Wout = (bf16*)(P.ws + WS_WOUT); bf16* Wa = (bf16*)(P.ws + WS_WA); bf16* Wb = (bf16*)(P.ws + WS_WB);
    constexpr int I1 = 16 * 273, I2 = 16 * 64, I3 = 8 * 32, I4 = 16 * 32, I5 = 16 * 32, I6 = 16 * 176, I7 = 44 * 32;
    constexpr int NIT = I1 + I2 + I3 + I4 + I5 + I6 + I7;
    for (int it = gw + (PART == 0 ? 0 : I1 + I2); it < (PART == 0 ? I1 + I2 : NIT); it += NGW) {
        int r = it;
        if (r < I1) { p0_transpose_item(P.w_in, 10784, 0, 1024, 8736, P.norm_mix_g, Win, 0, scr, r, lane, 0, 0, 3072); continue; } r -= I1;
        if (r < I2) { p0_transpose_item(P.w_in, 10784, 8736, 1024, 2048, P.norm_mix_g, Win, 8960, scr, r, lane); continue; } r -= I2;
        if (r < I3) { p0_transpose_item(P.w_a, 1024, 0, 512, 1024, nullptr, Wa, 0, scr, r, lane, 1536, 0); continue; } r -= I3;
        if (r < I4) { p0_transpose_item(P.w_b, 1024, 0, 1024, 1024, nullptr, Wa, 0, scr, r, lane, 1536, 512); continue; } r -= I4;
        if (r < I5) { p0_transpose_item(P.w_out, 1024, 0, 1024, 1024, nullptr, Wout, 0, scr, r, lane); continue; } r -= I5;
        if (r < I6) { const int seg = r >> 6, pn = seg >> 1, isval = seg & 1;
            p0_transpose_item(P.w_up, 5632, isval * 2816 + pn * 128, 1024, 128, P.norm_ffn_g, Wup, pn * 256 + isval * 128, scr, r & 63, lane); continue; } r -= I6;
        p0_transpose_item(P.w_down, 1024, 0, 2816, 1024, nullptr, Wdn, 0, scr, r, lane);
    }
    if constexpr (PART == 1) return;
    const int gt = bid * NTHREADS + tid, NGT = G * NTHREADS;
    for (int i = gt; i < 28672; i += NGT) ((v4u*)(Win + (size_t)8736 * 1024))[i] = (v4u){0u, 0u, 0u, 0u};
    float* ropeC = (float*)(P.ws + WS_ROPE); float* ropeS = ropeC + 4096 * 8;
    for (int i = gt; i < 4096 * 8; i += NGT) { const int pos = i >> 3, j = i & 7;
        const float invt[8] = {1.0f, 0.19392274f, 0.03760603f, 0.0072926646f, 0.0014142136f, 0.0002742482f, 5.3182957e-05f, 1.0313385e-05f};
        const float inv = invt[j]; const float ang = (float)pos * inv;
        const float c_hi = 0.15915494f, c_lo = 6.4206382e-09f;
        const float kq = rintf(ang * c_hi); float r = fmaf(ang, c_hi, -kq); r = fmaf(ang, c_lo, r);
        ropeC[i] = __builtin_amdgcn_cosf(r); ropeS[i] = __builtin_amdgcn_sinf(r); }
    phase_xb(P, 0, gw, NGW, lane);
}

__device__ __forceinline__ void load8bf(const bf16* p, float* o) { const v4u w = *(const v4u*)p; o[0] = bflo(w.x); o[1] = bfhi(w.x); o[2] = bflo(w.y); o[3] = bfhi(w.y); o[4] = bflo(w.z); o[5] = bfhi(w.z); o[6] = bflo(w.w); o[7] = bfhi(w.w); }
typedef short bf16x8_t __attribute__((ext_vector_type(8)));
typedef float f32x16 __attribute__((ext_vector_type(16)));
typedef short s16x4_t __attribute__((ext_vector_type(4)));
struct AttU { int h, dil, L, seq0, two, r0, p0, sbase, nrows; };
__device__ __forceinline__ AttU att_decode(int u, int S, int NU) { AttU a; const int idx = u % NU, bh = u / NU; a.h = bh % 24; const int b = bh / 24, gi = a.h >> 3; a.dil = (gi == 0) ? 1 : (gi == 1) ? 4 : 16; a.L = S / a.dil; a.seq0 = b * S;
    a.two = (a.L < 256); a.r0 = a.two ? 2 * idx : idx % a.dil; a.p0 = a.two ? 0 : (idx / a.dil) * 256; a.sbase = a.two ? 0 : a.p0 - 64; a.nrows = a.two ? 256 : 384; return a; }
__device__ __forceinline__ void phase_attn(const bf16* ATT, bf16* PO, float* LSE, int S, unsigned char* lds_, int bid, int G, int tid) {
    LAS unsigned char* lds = (LAS unsigned char*)lds_;
    const int lane = tid & 63, w = __builtin_amdgcn_readfirstlane(tid >> 6), ql = lane & 31, h2 = lane >> 5;
    const int NU = S >> 8, nunits = (TG / S) * 24 * NU;
    constexpr int KOFF = 0, VOFF = 49152;
    const int ri = lane >> 3, c8 = lane & 7;
#define ATT_STAGE(A_, isV) do { for (int pc = w; pc < (A_).nrows / 8; pc += NWAVES) { const int row = pc * 8 + ri; int cls_, pos_; \
            if ((A_).two) { cls_ = (A_).r0 + (row >> 7); pos_ = row & 127; } else { cls_ = (A_).r0; pos_ = (A_).sbase + row; pos_ = pos_ < 0 ? 0 : (pos_ >= (A_).L ? (A_).L - 1 : pos_); } \
            const bf16* src_ = ATT + (size_t)((A_).seq0 + cls_ + (A_).dil * pos_) * ATTW + (A_).h * 64; \
            if (isV) __builtin_amdgcn_global_load_lds((const unsigned*)(src_ + 3072 + ((c8 ^ (((ri >> 1) & 1) << 2)) << 3)), (LAS unsigned*)(lds + VOFF + pc * 1024), 16, 0, 0); \
            else __builtin_amdgcn_global_load_lds((const unsigned*)(src_ + 1536 + ((c8 ^ ri) << 3)), (LAS unsigned*)(lds + KOFF + pc * 1024), 16, 0, 0); } } while (0)
#define ATT_QLOAD(A_, dst) do { const int cls_ = (A_).two ? (A_).r0 + (w >> 2) : (A_).r0; const int qp_ = (A_).two ? 32 * (w & 3) : (A_).p0 + 32 * w; const size_t tq_ = (size_t)((A_).seq0 + cls_ + (A_).dil * (qp_ + ql)); \
        _Pragma("unroll") for (int s4 = 0; s4 < 4; ++s4) dst[s4] = *(const bf16x8_t*)(ATT + tq_ * ATTW + (A_).h * 64 + 16 * s4 + 8 * h2); } while (0)
    bf16x8_t qf[4], qn[4];
    if (bid < nunits) { const AttU a0 = att_decode(bid, S, NU); ATT_STAGE(a0, false); ATT_QLOAD(a0, qf); }
    for (int u = bid; u < nunits; u += G) {
        const AttU A = att_decode(u, S, NU); const int h = A.h, L = A.L;
        const int cls = A.two ? A.r0 + (w >> 2) : A.r0; const int qp0 = A.two ? 32 * (w & 3) : A.p0 + 32 * w;
        const int tokq = A.seq0 + cls + A.dil * (qp0 + ql);
        const int lrow0 = (A.two ? (w >> 2) * 128 : 0) + qp0 - 64 - A.sbase;
        __syncthreads();
        ATT_STAGE(A, true);
        f32x16 St[5]; float mx = -1e30f;
#pragma unroll
        for (int t = 0; t < 5; ++t) { const int kp0 = qp0 - 64 + 32 * t; const bool ok = (kp0 >= 0) && (kp0 < L);
            if (ok) { const int R = lrow0 + 32 * t + ql; f32x16 a = {};
#pragma unroll
                for (int s4 = 0; s4 < 4; ++s4) { const bf16x8_t kf = *(const LAS bf16x8_t*)(lds + KOFF + R * 128 + (((2 * s4 + h2) ^ (R & 7)) << 4)); a = __builtin_amdgcn_mfma_f32_32x32x16_bf16(kf, qf[s4], a, 0, 0, 0); }
#pragma unroll
                for (int rg = 0; rg < 16; ++rg) { const int row = (rg & 3) + 8 * (rg >> 2) + 4 * h2; if ((t == 0 && row < ql) || (t == 4 && row > ql)) a[rg] = -1e30f; mx = fmaxf(mx, a[rg]); }
                St[t] = a; }
            else { St[t] = (f32x16){}; } }
        mx = fmaxf(mx, __shfl_xor(mx, 32));
        __syncthreads();
        if (u + G < nunits) { const AttU An = att_decode(u + G, S, NU); ATT_STAGE(An, false); ATT_QLOAD(An, qn); }
        float lsum = 0.f; f32x16 O0 = {}, O1 = {};
#pragma unroll
        for (int t = 0; t < 5; ++t) { const int kp0 = qp0 - 64 + 32 * t; const bool ok = (kp0 >= 0) && (kp0 < L);
            if (ok) { f32x16 p = St[t];
#pragma unroll
                for (int rg = 0; rg < 16; ++rg) { p[rg] = __builtin_amdgcn_exp2f(p[rg] - mx); lsum += p[rg]; }
#pragma unroll
                for (int s2 = 0; s2 < 2; ++s2) { v4u pk; pk.x = cvt_pk_bf16(p[8 * s2], p[8 * s2 + 1]); pk.y = cvt_pk_bf16(p[8 * s2 + 2], p[8 * s2 + 3]); pk.z = cvt_pk_bf16(p[8 * s2 + 4], p[8 * s2 + 5]); pk.w = cvt_pk_bf16(p[8 * s2 + 6], p[8 * s2 + 7]);
                    const bf16x8_t pb = __builtin_bit_cast(bf16x8_t, pk);
#pragma unroll
                    for (int dt = 0; dt < 2; ++dt) { const int g16 = (lane >> 4) & 1, qq = (lane & 15) >> 2, pp = lane & 3;
                        const int k0 = lrow0 + 32 * t + 16 * s2 + 4 * h2 + qq, k1 = k0 + 8;
                        const int a0 = VOFF + k0 * 128 + (((dt ^ ((k0 >> 1) & 1)) << 6) | (g16 << 5) | (pp << 3)), a1 = VOFF + k1 * 128 + (((dt ^ ((k1 >> 1) & 1)) << 6) | (g16 << 5) | (pp << 3));
                        const s16x4_t lo = __builtin_bit_cast(s16x4_t, __builtin_amdgcn_ds_read_tr16_b64_v4i16((LAS s16x4_t*)(lds + a0))), hi = __builtin_bit_cast(s16x4_t, __builtin_amdgcn_ds_read_tr16_b64_v4i16((LAS s16x4_t*)(lds + a1)));
                        const bf16x8_t vf = (bf16x8_t){lo[0], lo[1], lo[2], lo[3], hi[0], hi[1], hi[2], hi[3]};
                        if (dt == 0) O0 = __builtin_amdgcn_mfma_f32_32x32x16_bf16(vf, pb, O0, 0, 0, 0); else O1 = __builtin_amdgcn_mfma_f32_32x32x16_bf16(vf, pb, O1, 0, 0, 0); } } } }
        lsum += __shfl_xor(lsum, 32);
        const float il = 1.0f / lsum;
        bf16* po = PO + ((size_t)tokq * 24 + h) * 64;
#pragma unroll
        for (int g4 = 0; g4 < 4; ++g4) { v2u w0, w1; w0.x = cvt_pk_bf16(O0[4 * g4] * il, O0[4 * g4 + 1] * il); w0.y = cvt_pk_bf16(O0[4 * g4 + 2] * il, O0[4 * g4 + 3] * il); w1.x = cvt_pk_bf16(O1[4 * g4] * il, O1[4 * g4 + 1] * il); w1.y = cvt_pk_bf16(O1[4 * g4 + 2] * il, O1[4 * g4 + 3] * il);
            *(v2u*)(po + 8 * g4 + 4 * h2) = w0; *(v2u*)(po + 32 + 8 * g4 + 4 * h2) = w1; }
        if (h2 == 0) LSE[(size_t)tokq * 24 + h] = mx + __builtin_amdgcn_logf(lsum);
#pragma unroll
        for (int s4 = 0; s4 < 4; ++s4) qf[s4] = qn[s4];
    }
    __syncthreads();
#undef ATT_STAGE
#undef ATT_QLOAD
}
__device__ __forceinline__ void phase_attn_combine(const bf16* PO, const float* LSE, bf16* AO, int gt, int NGT) {
    for (int item = gt; item < TG * 64; item += NGT) { const int tok = item >> 6, hg = (item >> 3) & 7, c = item & 7;
        const float l0 = LSE[(size_t)tok * 24 + hg], l1 = LSE[(size_t)tok * 24 + 8 + hg], l2 = LSE[(size_t)tok * 24 + 16 + hg]; const float m = fmaxf(l0, fmaxf(l1, l2));
        float w0 = __builtin_amdgcn_exp2f(l0 - m), w1 = __builtin_amdgcn_exp2f(l1 - m), w2 = __builtin_amdgcn_exp2f(l2 - m); const float inv = 1.0f / (w0 + w1 + w2); w0 *= inv; w1 *= inv; w2 *= inv;
        float a[8], b8[8], c8[8]; load8bf(PO + ((size_t)tok * 24 + hg) * 64 + c * 8, a); load8bf(PO + ((size_t)tok * 24 + 8 + hg) * 64 + c * 8, b8); load8bf(PO + ((size_t)tok * 24 + 16 + hg) * 64 + c * 8, c8);
#pragma unroll
        for (int e = 0; e < 8; ++e) a[e] = w0 * a[e] + w1 * b8[e] + w2 * c8[e];
        v4u o; o.x = cvt_pk_bf16(a[0], a[1]); o.y = cvt_pk_bf16(a[2], a[3]); o.z = cvt_pk_bf16(a[4], a[5]); o.w = cvt_pk_bf16(a[6], a[7]);
        *(v4u*)(AO + (size_t)tok * 1536 + hg * 64 + c * 8) = o; }
}

constexpr int DN_FRAG_U = 49152  , DN_TI_UD = 16384  , DN_VEC_UD = 512  ;
__device__ __forceinline__ int pi_q(int q, int j) { return (j < 4) ? (4 * q + j) : (16 + 4 * q + (j - 4)); }
__device__ __forceinline__ float dpp_xor1(float x) { return __int_as_float(__builtin_amdgcn_mov_dpp(__float_as_int(x), 0xB1, 0xF, 0xF, true)); }
__device__ __forceinline__ float dpp_xor2(float x) { return __int_as_float(__builtin_amdgcn_mov_dpp(__float_as_int(x), 0x4E, 0xF, 0xF, true)); }

__device__ __forceinline__ void phase_dna(const Ptrs& P, const bf16* DNQ, const float* SMALL, unsigned char* FRAG, bf16* VACC, unsigned char* TI, float* VEC, int S, unsigned char* lds_, int bid, int G, int tid) {
    LAS unsigned char* lds = (LAS unsigned char*)lds_;
    const int lane = tid & 63, w = __builtin_amdgcn_readfirstlane(tid >> 6), c16 = lane & 15, q4 = lane >> 4;
    constexpr int RAW = 0, RM = 52224, RMP = 132  , RMPART = 64 * RMP, MM = 102912, LP = RM, TM = MM, GV = 135680;
    LAS bf16* raw = (LAS bf16*)(lds + RAW); LAS bf16* rm = (LAS bf16*)(lds + RM); LAS float* mm = (LAS float*)(lds + MM); LAS float* lp = (LAS float*)(lds + LP); LAS float* tm = (LAS float*)(lds + TM); LAS float* gv = (LAS float*)(lds + GV);
    const int NU = (TG / 64) * 8;
#define DNA_STAGE(u_) do { const int n_ = (u_) >> 3, h_ = (u_) & 7; const int tok0_ = n_ * 64, pos0_ = tok0_ & (S - 1), seq0_ = tok0_ - pos0_; \
        for (int pc = w; pc < 51; pc += NWAVES) { const int part_ = pc / 17, rg_ = pc - part_ * 17; int p_ = pos0_ - 2 + 4 * rg_ + (lane >> 4); p_ = p_ < 0 ? 0 : (p_ >= S ? S - 1 : p_); \
            __builtin_amdgcn_global_load_lds((const unsigned*)(DNQ + (size_t)(seq0_ + p_) * DNW + part_ * 1024 + h_ * 128 + (lane & 15) * 8), (LAS unsigned*)(lds + RAW + pc * 1024), 16, 0, 0); } } while (0)
    if (bid < NU) DNA_STAGE(bid);
    for (int ui = bid; ui < NU; ui += G) {
        const int n = ui >> 3, h = ui & 7; const int tok0 = n * 64, pos0 = tok0 & (S - 1);
        __syncthreads();
#pragma unroll
        for (int i6 = 0; i6 < 6; ++i6) { const int it = w * 6 + i6, part = it >> 4, t = ((it & 15) << 2) + q4; const int ch = part * 1024 + h * 128 + 8 * c16;
            float a[8];
#pragma unroll
            for (int e = 0; e < 8; ++e) a[e] = 0.f;
#pragma unroll
            for (int i = 0; i < 5; ++i) { const int p2 = pos0 + t + i - 2; const v4u x = *(const LAS v4u*)(raw + (part * 68 + t + i) * 128 + 8 * c16);
                const f32x4 wa = *(const f32x4*)(P.conv_w + i * DNW + ch), wb = *(const f32x4*)(P.conv_w + i * DNW + ch + 4);
                if (p2 >= 0 && p2 < S) { a[0] += bflo(x.x) * wa[0]; a[1] += bfhi(x.x) * wa[1]; a[2] += bflo(x.y) * wa[2]; a[3] += bfhi(x.y) * wa[3]; a[4] += bflo(x.z) * wb[0]; a[5] += bfhi(x.z) * wb[1]; a[6] += bflo(x.w) * wb[2]; a[7] += bfhi(x.w) * wb[3]; } }
            float ss = 0.f;
#pragma unroll
            for (int e = 0; e < 8; ++e) { a[e] = a[e] * __builtin_amdgcn_rcpf(1.0f + __expf(-a[e])); ss += a[e] * a[e]; }
            if (part < 2) { ss += __int_as_float(__builtin_amdgcn_mov_dpp(__float_as_int(ss), 0xB1, 0xF, 0xF, true)); ss += __int_as_float(__builtin_amdgcn_mov_dpp(__float_as_int(ss), 0x4E, 0xF, 0xF, true));
                ss += __int_as_float(__builtin_amdgcn_mov_dpp(__float_as_int(ss), 0x124, 0xF, 0xF, true));
                ss += __int_as_float(__builtin_amdgcn_mov_dpp(__float_as_int(ss), 0x128, 0xF, 0xF, true));
                float sc = rsqrtf(ss + EPS); if (part == 0) sc *= 0.08838834764831845f;
#pragma unroll
                for (int e = 0; e < 8; ++e) a[e] *= sc; }
            const v4u o = {cvt_pk_bf16(a[0], a[1]), cvt_pk_bf16(a[2], a[3]), cvt_pk_bf16(a[4], a[5]), cvt_pk_bf16(a[6], a[7])};
            *(LAS v2u*)(rm + part * RMPART + t * RMP + 8 * c16) = (v2u){o.x, o.y}; *(LAS v2u*)(rm + part * RMPART + t * RMP + 8 * c16 + 4) = (v2u){o.z, o.w}; }
        __syncthreads();
        if (ui + G < NU) DNA_STAGE(ui + G);
        unsigned char* fr_u = FRAG + (size_t)ui * DN_FRAG_U;
#pragma unroll
        for (int i = 0; i < 4; ++i) { const int fidx = 4 * w + i, isQ = fidx >> 4, ff = fidx & 15, mt = ff >> 2, ks = ff & 3; const int row = 16 * mt + c16;
            const LAS bf16* src = rm + (isQ ? 0 : RMPART) + row * RMP + 32 * ks + 4 * q4;
            const v2u lo = *(const LAS v2u*)src, hi = *(const LAS v2u*)(src + 16); const v4u val = {lo.x, lo.y, hi.x, hi.y};
            *(v4u*)(fr_u + (isQ * 16 + ff) * 1024 + lane * 16) = val; }
#pragma unroll
        for (int i = 0; i < 2; ++i) { const int f = 2 * w + i, mt8 = f >> 1, ks = f & 1; const int dim = 16 * mt8 + c16; unsigned short e[8];
#pragma unroll
            for (int j = 0; j < 8; ++j) e[j] = rm[RMPART + (32 * ks + pi_q(q4, j)) * RMP + dim];
            const v4u val = {(unsigned)e[0] | ((unsigned)e[1] << 16), (unsigned)e[2] | ((unsigned)e[3] << 16), (unsigned)e[4] | ((unsigned)e[5] << 16), (unsigned)e[6] | ((unsigned)e[7] << 16)};
            *(v4u*)(fr_u + (32 + f) * 1024 + lane * 16) = val; }
        { unsigned short e[16];
#pragma unroll
          for (int mt = 0; mt < 4; ++mt)
#pragma unroll
              for (int r = 0; r < 4; ++r) e[mt * 4 + r] = rm[2 * RMPART + (16 * mt + 4 * q4 + r) * RMP + 16 * w + c16];
          v4u a = {(unsigned)e[0] | ((unsigned)e[1] << 16), (unsigned)e[2] | ((unsigned)e[3] << 16), (unsigned)e[4] | ((unsigned)e[5] << 16), (unsigned)e[6] | ((unsigned)e[7] << 16)};
          v4u b = {(unsigned)e[8] | ((unsigned)e[9] << 16), (unsigned)e[10] | ((unsigned)e[11] << 16), (unsigned)e[12] | ((unsigned)e[13] << 16), (unsigned)e[14] | ((unsigned)e[15] << 16)};
          v4u* dst = (v4u*)(VACC + (((size_t)ui * 8 + w) * 64 + lane) * 16); dst[0] = a; dst[1] = b; }
#pragma unroll
        for (int i = 0; i < 4; ++i) { const int t4 = 4 * w + i, isQK = t4 >> 4, tt = t4 & 15, mt = tt >> 2, nt = tt & 3; pg8::f32x4 acc = {0.f, 0.f, 0.f, 0.f};
#pragma unroll
            for (int ks = 0; ks < 4; ++ks) { const LAS bf16* sa = rm + (isQK ? 0 : RMPART) + (16 * mt + c16) * RMP + 32 * ks + 4 * q4; const LAS bf16* sb = rm + RMPART + (16 * nt + c16) * RMP + 32 * ks + 4 * q4;
                const v2u alo = *(const LAS v2u*)sa, ahi = *(const LAS v2u*)(sa + 16), blo = *(const LAS v2u*)sb, bhi = *(const LAS v2u*)(sb + 16);
                const v4u av = {alo.x, alo.y, ahi.x, ahi.y}, bv = {blo.x, blo.y, bhi.x, bhi.y};
                acc = __builtin_amdgcn_mfma_f32_16x16x32_bf16(__builtin_bit_cast(bf16x8_t, av), __builtin_bit_cast(bf16x8_t, bv), acc, 0, 0, 0); }
#pragma unroll
            for (int r = 0; r < 4; ++r) mm[isQK * 4096 + (16 * mt + 4 * q4 + r) * 64 + 16 * nt + c16] = acc[r]; }
        if (w < 2) { const int dir = w; int lane_g = lane; asm volatile("" : "+v"(lane_g)); const float* sm = SMALL + (size_t)(tok0 + lane_g) * 32;
            const float beta = __builtin_amdgcn_rcpf(1.0f + __expf(-sm[dir * 8 + h])); const float al = dir ? P.a_log_b[h] : P.a_log_f[h], db = dir ? P.dt_b[h] : P.dt_f[h];
            const float xx = sm[16 + dir * 8 + h] + db; const float sp = (xx > 20.f) ? xx : __logf(1.0f + __expf(xx)); const float gg = -__expf(al) * sp;
            float gc = gg;
#pragma unroll
            for (int o = 1; o < 64; o <<= 1) { const int src = dir ? lane_g + o : lane_g - o; const float tt = __int_as_float(__builtin_amdgcn_ds_bpermute(src << 2, __float_as_int(gc))); const bool okk = dir ? (lane_g + o < 64) : (lane_g >= o); if (okk) gc += tt; }
            const float glast = __int_as_float(__builtin_amdgcn_ds_bpermute((dir ? 0 : 63) << 2, __float_as_int(gc)));
            gv[dir * 128 + lane_g] = gc; gv[dir * 128 + 64 + lane_g] = beta;
            float* vec = VEC + ((size_t)ui * 2 + dir) * DN_VEC_UD; const float eg = __expf(gc);
            vec[lane_g] = beta; vec[64 + lane_g] = beta * eg; vec[128 + lane_g] = eg; vec[192 + lane_g] = __expf(glast - gc); }
        __syncthreads();
        unsigned char* ti_u = TI + (size_t)ui * 2 * DN_TI_UD;
#pragma unroll
        for (int k2 = 0; k2 < 2; ++k2) { const int task = tid + 512 * k2, dir = task >> 9, f = (task >> 6) & 7, mt = f >> 1, ks = f & 1; const int i = 16 * mt + c16; const float gci = gv[dir * 128 + i]; float e[8];
#pragma unroll
            for (int j8 = 0; j8 < 8; ++j8) { const int j = 32 * ks + pi_q(q4, j8); const bool incl = dir ? (i <= j) : (i >= j); e[j8] = incl ? mm[4096 + i * 64 + j] * __expf(gci - gv[dir * 128 + j]) : 0.f; }
            const v4u val = {cvt_pk_bf16(e[0], e[1]), cvt_pk_bf16(e[2], e[3]), cvt_pk_bf16(e[4], e[5]), cvt_pk_bf16(e[6], e[7])};
            *(v4u*)(ti_u + dir * DN_TI_UD + (8 + f) * 1024 + lane * 16) = val; }
        f32x4 lpv[4];
#pragma unroll
        for (int k4 = 0; k4 < 4; ++k4) { const int vi = tid + 512 * k4, dir = vi >> 10, ip = (vi >> 4) & 63, p = (vi >> 2) & 3, jj4 = vi & 3; const int i = dir ? 63 - ip : ip; const float gci = gv[dir * 128 + i], bi = gv[dir * 128 + 64 + i];
#pragma unroll
            for (int e = 0; e < 4; ++e) { const int jp = 16 * jj4 + 4 * e + p; const int j = dir ? 63 - jp : jp; lpv[k4][e] = (jp < ip) ? bi * mm[i * 64 + j] * __expf(gci - gv[dir * 128 + j]) : 0.f; } }
        __syncthreads();
#pragma unroll
        for (int k4 = 0; k4 < 4; ++k4) { const int vi = tid + 512 * k4; *(LAS f32x4*)(lp + vi * 4) = lpv[k4]; }
        __syncthreads();
        { const int dir = w >> 2, cc = (w & 3) * 16 + (lane >> 2), p = lane & 3; float t[16];
#pragma unroll
          for (int jj = 0; jj < 16; ++jj) t[jj] = 0.f;
#pragma unroll
          for (int ip = 0; ip < 64; ++ip) { float part = 0.f;
#pragma unroll
              for (int jj4 = 0; jj4 < (ip + 15) / 16; ++jj4) { const f32x4 l4 = *(const LAS f32x4*)(lp + ((dir * 64 + ip) * 4 + p) * 16 + jj4 * 4);
#pragma unroll
                  for (int e = 0; e < 4; ++e) if (16 * jj4 + 4 * e < ip) part += l4[e] * t[4 * jj4 + e]; }
              part += dpp_xor1(part); part += dpp_xor2(part);
              const float val = ((cc == ip) ? 1.0f : 0.0f) - part; if (p == (ip & 3)) t[ip >> 2] = val; }
#pragma unroll
          for (int jj = 0; jj < 16; ++jj) tm[(dir * 64 + 4 * jj + p) * 64 + cc] = t[jj]; }
        __syncthreads();
#pragma unroll
        for (int k2 = 0; k2 < 2; ++k2) { const int task = tid + 512 * k2, dir = task >> 9, f = (task >> 6) & 7, mt = f >> 1, ks = f & 1; const int i = 16 * mt + c16; float e[8];
#pragma unroll
            for (int j8 = 0; j8 < 8; ++j8) { const int j = 32 * ks + pi_q(q4, j8); e[j8] = dir ? tm[(64 + 63 - i) * 64 + 63 - j] : tm[i * 64 + j]; }
            const v4u val = {cvt_pk_bf16(e[0], e[1]), cvt_pk_bf16(e[2], e[3]), cvt_pk_bf16(e[4], e[5]), cvt_pk_bf16(e[6], e[7])};
            *(v4u*)(ti_u + dir * DN_TI_UD + f * 1024 + lane * 16) = val; }
    }
#undef DNA_STAGE
}

__device__ __forceinline__ bf16x8_t pack_acc2(const pg8::f32x4& a, const pg8::f32x4& b) { const v4u v = {cvt_pk_bf16(a[0], a[1]), cvt_pk_bf16(a[2], a[3]), cvt_pk_bf16(b[0], b[1]), cvt_pk_bf16(b[2], b[3])}; return __builtin_bit_cast(bf16x8_t, v); }
__device__ __forceinline__ void phase_scan(const unsigned char* FRAG, const unsigned char* TI, const bf16* VACC, const float* VEC, bf16* OF, bf16* OB, int S, unsigned char* lds_, int bid, int G, int tid) {
    LAS unsigned char* lds = (LAS unsigned char*)lds_;
    const int lane = tid & 63, w = __builtin_amdgcn_readfirstlane(tid >> 6), c16 = lane & 15, q4 = lane >> 4;
    const int NCH = S >> 6, nchain = (TG / S) * 16;
    constexpr int BUFB = 65536;
    for (int chain = bid; chain < nchain; chain += G) {
        const int dir = chain & 1, h = (chain >> 1) & 7, b = chain >> 4;
        bf16* O = dir ? OB : OF;
        pg8::f32x4 Sacc[8];
#pragma unroll
        for (int T8 = 0; T8 < 8; ++T8) Sacc[T8] = (pg8::f32x4){0.f, 0.f, 0.f, 0.f};
#define DN_STAGE(bufoff, nn) do { const size_t ui_ = ((size_t)(b * NCH + (nn)) * 8 + h); \
            for (int pc = w; pc < 64; pc += NWAVES) { const unsigned char* src = (pc < 48) ? FRAG + ui_ * DN_FRAG_U + pc * 1024 : TI + (ui_ * 2 + dir) * DN_TI_UD + (pc - 48) * 1024; \
                __builtin_amdgcn_global_load_lds((const unsigned*)(src + lane * 16), (LAS unsigned*)(lds + (bufoff) + pc * 1024), 16, 0, 0); } } while (0)
        int n = dir ? NCH - 1 : 0;
        DN_STAGE(0, n);
        v4u vcur0, vcur1; { const v4u* vp = (const v4u*)(VACC + ((((size_t)(b * NCH + n) * 8 + h) * 8 + w) * 64 + lane) * 16); vcur0 = vp[0]; vcur1 = vp[1]; }
        if (w == 0) { const v4u vv = *(const v4u*)(VEC + (((size_t)(b * NCH + n) * 8 + h) * 2 + dir) * DN_VEC_UD + lane * 4); *(LAS v4u*)(lds + 131072 + lane * 16) = vv; }
        __syncthreads();
        int buf = 0;
        for (int step = 0; step < NCH; ++step) {
            const int nn = dir ? n - 1 : n + 1; v4u vn0 = vcur0, vn1 = vcur1;
            v4u vecn = {0u, 0u, 0u, 0u};
            if (step + 1 < NCH) { DN_STAGE((buf ^ 1) * BUFB, nn); const v4u* vp = (const v4u*)(VACC + ((((size_t)(b * NCH + nn) * 8 + h) * 8 + w) * 64 + lane) * 16); vn0 = vp[0]; vn1 = vp[1];  if (w == 0) vecn = *(const v4u*)(VEC + (((size_t)(b * NCH + nn) * 8 + h) * 2 + dir) * DN_VEC_UD + lane * 4); }
            const LAS unsigned char* B0 = lds + buf * BUFB; const LAS float* vec = (const LAS float*)(lds + 131072 + buf * 1024);
#define DN_A(off, fi) (*(const LAS bf16x8_t*)(B0 + (off) + (fi) * 1024 + lane * 16))
            bf16x8_t Sb[4];
#pragma unroll
            for (int ks = 0; ks < 4; ++ks) Sb[ks] = pack_acc2(Sacc[2 * ks], Sacc[2 * ks + 1]);
            pg8::f32x4 X1[4], X2[4];
#pragma unroll
            for (int mt = 0; mt < 4; ++mt) { X1[mt] = (pg8::f32x4){0.f, 0.f, 0.f, 0.f}; X2[mt] = X1[mt];
#pragma unroll
                for (int ks = 0; ks < 4; ++ks) { X1[mt] = __builtin_amdgcn_mfma_f32_16x16x32_bf16(DN_A(0, mt * 4 + ks), Sb[ks], X1[mt], 0, 0, 0); X2[mt] = __builtin_amdgcn_mfma_f32_16x16x32_bf16(DN_A(16384, mt * 4 + ks), Sb[ks], X2[mt], 0, 0, 0); } }
            const unsigned vw[8] = {vcur0.x, vcur0.y, vcur0.z, vcur0.w, vcur1.x, vcur1.y, vcur1.z, vcur1.w};
            pg8::f32x4 Y[4];
#pragma unroll
            for (int mt = 0; mt < 4; ++mt) { const pg8::f32x4 be = *(const LAS pg8::f32x4*)(vec + 16 * mt + 4 * q4), aa = *(const LAS pg8::f32x4*)(vec + 64 + 16 * mt + 4 * q4);
                const pg8::f32x4 vv = {bflo(vw[2 * mt]), bfhi(vw[2 * mt]), bflo(vw[2 * mt + 1]), bfhi(vw[2 * mt + 1])}; Y[mt] = be * vv - aa * X1[mt]; }
            const bf16x8_t Yb0 = pack_acc2(Y[0], Y[1]), Yb1 = pack_acc2(Y[2], Y[3]);
            pg8::f32x4 vn[4];
#pragma unroll
            for (int mt = 0; mt < 4; ++mt) { vn[mt] = __builtin_amdgcn_mfma_f32_16x16x32_bf16(DN_A(49152, mt * 2), Yb0, (pg8::f32x4){0.f, 0.f, 0.f, 0.f}, 0, 0, 0); vn[mt] = __builtin_amdgcn_mfma_f32_16x16x32_bf16(DN_A(49152, mt * 2 + 1), Yb1, vn[mt], 0, 0, 0); }
            const bf16x8_t vb0 = pack_acc2(vn[0], vn[1]), vb1 = pack_acc2(vn[2], vn[3]);
            pg8::f32x4 dd[4];
#pragma unroll
            for (int mt = 0; mt < 4; ++mt) { const pg8::f32x4 eg = *(const LAS pg8::f32x4*)(vec + 128 + 16 * mt + 4 * q4); dd[mt] = *(const LAS pg8::f32x4*)(vec + 192 + 16 * mt + 4 * q4);
                pg8::f32x4 o = eg * X2[mt]; o = __builtin_amdgcn_mfma_f32_16x16x32_bf16(DN_A(57344, mt * 2), vb0, o, 0, 0, 0); o = __builtin_amdgcn_mfma_f32_16x16x32_bf16(DN_A(57344, mt * 2 + 1), vb1, o, 0, 0, 0);
                bf16* op = O + ((size_t)(b * S + n * 64 + 16 * mt + 4 * q4)) * 1024 + h * 128 + 16 * w + c16;
#pragma unroll
                for (int r = 0; r < 4; ++r) op[(size_t)r * 1024] = (bf16)(cvt_pk_bf16(o[r], 0.f) & 0xffffu); }
            const bf16x8_t db0 = pack_acc2(dd[0] * vn[0], dd[1] * vn[1]), db1 = pack_acc2(dd[2] * vn[2], dd[3] * vn[3]);
            const float dec = vec[128 + (dir ? 0 : 63)];
#pragma unroll
            for (int T8 = 0; T8 < 8; ++T8) { pg8::f32x4 a = Sacc[T8] * dec; a = __builtin_amdgcn_mfma_f32_16x16x32_bf16(DN_A(32768, T8 * 2), db0, a, 0, 0, 0); a = __builtin_amdgcn_mfma_f32_16x16x32_bf16(DN_A(32768, T8 * 2 + 1), db1, a, 0, 0, 0); Sacc[T8] = a; }
            if (w == 0 && step + 1 < NCH) *(LAS v4u*)(lds + 131072 + (buf ^ 1) * 1024 + lane * 16) = vecn;
            __syncthreads();
            buf ^= 1; n = nn; vcur0 = vn0; vcur1 = vn1;
        }
#undef DN_A
#undef DN_STAGE
    }
}

__device__ __forceinline__ void phase_combine(const Ptrs& P, const bf16* OF, const bf16* OB, const bf16* Z, bf16* DNOUT, int gw, int NGW, int lane) {
    for (int item = gw; item < TG * 8; item += NGW) { const size_t off = (size_t)item * 128 + lane * 2;
        const unsigned a = *(const unsigned*)(OF + off), b = *(const unsigned*)(OB + off), z = *(const unsigned*)(Z + off);
        const float o0 = bflo(a) + bflo(b), o1 = bfhi(a) + bfhi(b);
        const float ss = wave_sum(o0 * o0 + o1 * o1); const float rs = rsqrtf(ss * (1.0f / 128.0f) + EPS);
        const float y0 = o0 * rs * P.out_norm_g[lane * 2] * siluf_(bflo(z)), y1 = o1 * rs * P.out_norm_g[lane * 2 + 1] * siluf_(bfhi(z));
        *(unsigned*)(DNOUT + (size_t)(item >> 3) * 1536 + 512 + (item & 7) * 128 + lane * 2) = cvt_pk_bf16(y0, y1); }
}

__device__ __forceinline__ void unpack8(const v4u w, float* o) { o[0] = bflo(w.x); o[1] = bfhi(w.x); o[2] = bflo(w.y); o[3] = bfhi(w.y); o[4] = bflo(w.z); o[5] = bfhi(w.z); o[6] = bflo(w.w); o[7] = bfhi(w.w); }
__device__ __forceinline__ void phase_act(const Ptrs& P, const bf16* UP, bf16* ACT, int S, int gt, int NGT) {
    constexpr int TB = 16, NCG = DFF / 8;
    for (int item = gt; item < (TG / TB) * NCG; item += NGT) { const int tb = item / NCG, cg = item - tb * NCG, c = cg * 8, t0 = tb * TB, pos0 = t0 & (S - 1);
        float w0[8], w1[8], w2[8], bb[8];
#pragma unroll
        for (int e = 0; e < 8; e += 4) { const f32x4 a = *(const f32x4*)(P.ffn_conv_w + c + e), b = *(const f32x4*)(P.ffn_conv_w + DFF + c + e), d = *(const f32x4*)(P.ffn_conv_w + 2 * DFF + c + e), f = *(const f32x4*)(P.ffn_conv_b + c + e);
#pragma unroll
            for (int k = 0; k < 4; ++k) { w0[e + k] = a[k]; w1[e + k] = b[k]; w2[e + k] = d[k]; bb[e + k] = f[k]; } }
        const bf16* gp = UP + (size_t)t0 * NUP + c; const bf16* vp = gp + DFF; bf16* op = ACT + (size_t)t0 * DFF + c;
        float gprev[8], gcur[8], gnext[8];
        if (pos0 > 0) unpack8(*(const v4u*)(gp - NUP), gprev); else {
#pragma unroll
            for (int e = 0; e < 8; ++e) gprev[e] = 0.f; }
        unpack8(*(const v4u*)gp, gcur);
#pragma unroll 4
        for (int t = 0; t < TB; ++t) {
            if (t + 1 < TB || pos0 + TB < S) unpack8(*(const v4u*)(gp + (size_t)(t + 1) * NUP), gnext); else {
#pragma unroll
                for (int e = 0; e < 8; ++e) gnext[e] = 0.f; }
            float vv[8]; unpack8(*(const v4u*)(vp + (size_t)t * NUP), vv); float r[8];
#pragma unroll
            for (int e = 0; e < 8; e += 2) { const pg8::f32x2 gg = {bb[e] + w0[e] * gprev[e] + w1[e] * gcur[e] + w2[e] * gnext[e], bb[e + 1] + w0[e + 1] * gprev[e + 1] + w1[e + 1] * gcur[e + 1] + w2[e + 1] * gnext[e + 1]}; const pg8::f32x2 ge = pg8::gelu_pk(gg); r[e] = ge.x * vv[e]; r[e + 1] = ge.y * vv[e + 1]; }
            const v4u o = {cvt_pk_bf16(r[0], r[1]), cvt_pk_bf16(r[2], r[3]), cvt_pk_bf16(r[4], r[5]), cvt_pk_bf16(r[6], r[7])}; *(v4u*)(op + (size_t)t * DFF) = o;
#pragma unroll
            for (int e = 0; e < 8; ++e) { gprev[e] = gcur[e]; gcur[e] = gnext[e]; } }
    }
}

__device__ __forceinline__ void act_fix(const Ptrs& P, const float* EDGE, bf16* ACT, int pm, int S, int tid) {
    for (int i = tid; i < 2 * DFF; i += NTHREADS) { const int which = i / DFF, c = i - which * DFF, pt = c >> 7, ci = c & 127; const int tr = pm * 256 + (which ? 255 : 0);
        const bool need = which ? (((tr + 1) & (S - 1)) != 0) : ((tr & (S - 1)) != 0);
        if (need) { const float* e0 = EDGE + ((size_t)pm * 22 + pt) * 768; const float* en = EDGE + ((size_t)(pm + (which ? 1 : -1)) * 22 + pt) * 768;
            const float up = which ? e0[2 * 128 + ci] : en[3 * 128 + ci], gm = which ? e0[3 * 128 + ci] : e0[ci], dn = which ? en[ci] : e0[128 + ci], vv = which ? e0[5 * 128 + ci] : e0[4 * 128 + ci];
            const float gc = P.ffn_conv_b[c] + P.ffn_conv_w[c] * up + P.ffn_conv_w[DFF + c] * gm + P.ffn_conv_w[2 * DFF + c] * dn;
            const pg8::f32x2 ge = pg8::gelu_pk((pg8::f32x2){gc, gc}); ACT[(size_t)tr * DFF + c] = (bf16)(cvt_pk_bf16(ge.x * vv, 0.f) & 0xffffu); } }
}

__device__ __forceinline__ void phase_final(const Ptrs& P, const float* ssq3, int g, int gw, int NGW, int lane) {
    for (int m = g * TG + gw; m < (g + 1) * TG; m += NGW) { const float rs = rsqrtf(ssq3[m] * (1.0f / 1024.0f) + EPS); f32x4* xr = (f32x4*)(P.out + (size_t)m * D) + lane; const f32x4* gr = (const f32x4*)P.norm_final_g + lane;
#pragma unroll
        for (int j = 0; j < 4; ++j) xr[64 * j] = xr[64 * j] * rs * gr[64 * j]; }
}

typedef __attribute__((address_space(1))) unsigned gu32;
#define RLX_AGENT __ATOMIC_RELAXED, __HIP_MEMORY_SCOPE_AGENT
#define XB_TMO      128
#define XB_XCNT(j)  (256  + 64 * (j))
#define XB_XSUB(j)  (1280 + 64 * (j))
#define XB_XGEN(j)  (2304 + 64 * (j))
#define XB_TOP      3328
#define XB_TOPGEN   3392
#define XCD_BAR_WORDS 3456
#define XB_SPIN_CAP (1u << 18)

__device__ __forceinline__ unsigned xb_ld(unsigned* p)              { return __hip_atomic_load(p, __ATOMIC_RELAXED, __HIP_MEMORY_SCOPE_AGENT); }
__device__ __forceinline__ unsigned xb_add(unsigned* p, unsigned v) { return __hip_atomic_fetch_add(p, v, __ATOMIC_RELAXED, __HIP_MEMORY_SCOPE_AGENT); }
__device__ __forceinline__ unsigned xb_xcc_id() { return (unsigned)__builtin_amdgcn_s_getreg((3 << 11) | 20) & 0xFu; }
#define XB_SPIN(cond, bar) do { unsigned _sp = 0; while (cond) { __builtin_amdgcn_s_sleep(1); \
    if ((++_sp & 255u) == 0u) { if (xb_ld(&(bar)[XB_TMO])) break; if (_sp > XB_SPIN_CAP) { atomicAdd(&(bar)[XB_TMO], 1u); break; } } } } while (0)

struct XcdBarrier {
    unsigned* bar; unsigned x;
    volatile LAS unsigned* st;
};

__device__ __forceinline__ XcdBarrier xcd_barrier_post(unsigned* bar, volatile LAS unsigned* st, int tid) {
    XcdBarrier b; b.bar = bar; b.x = xb_xcc_id(); b.st = st;
    if (tid == 0) (void)xb_add(&bar[XB_XCNT(b.x)], 1u);
    return b;
}
__device__ __forceinline__ void xcd_barrier_complete(unsigned* bar, unsigned x, unsigned& nloc, unsigned& nx) {
    const unsigned G = gridDim.x * gridDim.y * gridDim.z;
    unsigned sum, cnt, mine, sp = 0u;
    for (;;) {
        sum = 0u; cnt = 0u; mine = 0u;
#pragma unroll
        for (unsigned j = 0; j < 16; ++j) { const unsigned c = xb_ld(&bar[XB_XCNT(j)]); sum += c; cnt += (c > 0u) ? 1u : 0u; mine = (j == x) ? c : mine; }
        if (sum == G) break;
        __builtin_amdgcn_s_sleep(1);
        if ((++sp & 255u) == 0u) { if (xb_ld(&bar[XB_TMO])) break; if (sp > XB_SPIN_CAP) { atomicAdd(&bar[XB_TMO], 1u); break; } }
    }
    nloc = mine > 0u ? mine : 1u; nx = cnt > 0u ? cnt : 1u;
}

__device__ __forceinline__ void xcd_barrier(const XcdBarrier& b, int tid) {
    asm volatile("s_waitcnt vmcnt(0)" ::: "memory");
    __syncthreads();
    if (tid == 0) {
        unsigned* bar = b.bar;
        __builtin_amdgcn_s_waitcnt(0);
        unsigned nloc = b.st[0], nx = b.st[1];
        if (nloc == 0u) { xcd_barrier_complete(bar, b.x, nloc, nx); b.st[0] = nloc; b.st[1] = nx; }
        const unsigned old = xb_add(&bar[XB_XSUB(b.x)], 1u);
        const unsigned gen = old / nloc;
        if (old + 1u == (gen + 1u) * nloc) {
            __builtin_amdgcn_fence(__ATOMIC_RELEASE, "agent");
            asm volatile("s_waitcnt vmcnt(0)" ::: "memory");
            const unsigned og = xb_add(&bar[XB_TOP], 1u);
            const unsigned tg = og / nx;
            if (og + 1u == (tg + 1u) * nx) xb_add(&bar[XB_TOPGEN], 1u);
            else XB_SPIN(xb_ld(&bar[XB_TOPGEN]) == tg, bar);
            __builtin_amdgcn_fence(__ATOMIC_ACQUIRE, "agent");
            xb_add(&bar[XB_XGEN(b.x)], 1u);
            asm volatile("s_waitcnt vmcnt(0)" ::: "memory");
        } else {
            XB_SPIN(xb_ld(&bar[XB_XGEN(b.x)]) == gen, bar);
            __builtin_amdgcn_fence(__ATOMIC_ACQUIRE, "agent");
            asm volatile("s_waitcnt vmcnt(0)" ::: "memory");
        }
    }
    __syncthreads();
}

constexpr int LDS_BYTES = 147456;
constexpr int CW_BAR = 4096;
constexpr int STEPS_PER_GROUP = 9, NSTEPS = 1 + NGROUPS * STEPS_PER_GROUP + 1;

#define LDP(i) ((const float*)ap->in[i])
#define MKP() Ptrs P; P.x_p = LDP(0); P.x_s = LDP(1); P.norm_mix_g = LDP(2); P.w_in = LDP(3); P.conv_w = LDP(4); P.a_log_f = LDP(5); P.a_log_b = LDP(6); P.dt_f = LDP(7); P.dt_b = LDP(8); \
        P.out_norm_g = LDP(9); P.w_a = LDP(10); P.w_b = LDP(11); P.w_out = LDP(12); P.norm_ffn_g = LDP(13); P.w_up = LDP(14); P.ffn_conv_w = LDP(15); P.ffn_conv_b = LDP(16); P.w_down = LDP(17); P.norm_final_g = LDP(18); \
        P.out = ap->out; P.ws = ap->ws;
#define WSP ((unsigned char*)ap->ws)
#define ARP (WSP + WS_ARENA)
#define Win ((bf16*)(WSP + WS_WIN))
#define Wup ((bf16*)(WSP + WS_WUP))
#define Wdn ((bf16*)(WSP + WS_WDOWN))
#define Wout ((bf16*)(WSP + WS_WOUT))
#define Wa ((bf16*)(WSP + WS_WA))
#define Wb ((bf16*)(WSP + WS_WB))
#define ropeC ((const float*)(WSP + WS_ROPE))
#define ropeS (ropeC + 4096 * 8)
#define ssq2 ((float*)(WSP + WS_CTL + CTL_SSQ2))
#define ssq3 ((float*)(WSP + WS_CTL + CTL_SSQ3))
#define XBg ((bf16*)(WSP + WS_XB))
#define rstd1 ((const float*)(WSP + WS_RSTD1) + t0)
#define ATT ((bf16*)(ARP + AR_ATT))
#define DNQ ((bf16*)(ARP + AR_DNQ))
#define Z ((bf16*)(ARP + AR_Z))
#define SMALL ((float*)(ARP + AR_SMALL))
#define AB ((bf16*)(ARP + AR_ATT))
#define MIX ((bf16*)(ARP + AR_MIX))
#define PO ((bf16*)(ARP + AR_PO))
#define LSE2 ((float*)(ARP + AR_LSE))
#define FRAGP ((unsigned char*)(ARP + AR_FRAG))
#define VACCP ((bf16*)(ARP + AR_VACC))
#define TIP ((unsigned char*)(ARP + AR_TI))
#define VECP ((float*)(ARP + AR_VEC))
#define OF ((bf16*)(ARP + AR_OF))
#define OB ((bf16*)(ARP + AR_OB))
#define Gt ((bf16*)OUTg)
#define EDGEP ((float*)(ARP + AR_AO))
#define X1B ((bf16*)(ARP + 322 * MiB))
#define ACT ((bf16*)(ARP + AR_ACT))
#define OUTg ((float*)ap->out + (size_t)t0 * D)
#define STEP_PRE() int tid = wave_u * 64 + (int)__builtin_amdgcn_mbcnt_hi(~0u, __builtin_amdgcn_mbcnt_lo(~0u, 0u)), bid = blockIdx.x; typedef const __attribute__((address_space(4))) Args* kargp_t; kargp_t ap = (kargp_t)__builtin_amdgcn_kernarg_segment_ptr(); asm volatile("" : "+v"(tid), "+s"(bid), "+s"(ap)); \
        const int lane = tid & 63, wave = tid >> 6, gw = bid * NWAVES + wave, gt = bid * NTHREADS + tid; (void)lane; (void)wave; (void)gw; (void)gt;
template <int ONLYK, int STEP> __device__ __forceinline__ void run_step(unsigned char* lds, int G, int NGW, int NGT, int wave_u) {
    STEP_PRE();
    constexpr int g = (STEP - 1) / STEPS_PER_GROUP, k = (STEP - 1) % STEPS_PER_GROUP; constexpr int t0 = g * TG; constexpr int S = (g < 2) ? 2048 : 4096;
    if constexpr (STEP == 0) {
        { MKP(); phase_prologue<0>(P, lds, bid, G, tid); }
    } else if constexpr (STEP == NSTEPS - 1) {
        { MKP(); phase_final(P, ssq3, NGROUPS - 1, gw, NGW, lane); }
    } else {
            if constexpr (k == 0) {
                pg8::Gemm gm{XBg, Win, TG, NPA, D}; pg8::StaticOrder So; So.init(TG, NPA, G, bid); pg8::EpiProjA E{ATT, DNQ, Z, SMALL, rstd1, ropeC, ropeS, S - 1};
                pg8::gemm_phase<pg8::EpiProjA, pg8::StaticOrder, true, true>((LAS unsigned char*)lds, gm, So, E, tid);
            } else if constexpr (k == 1) {
                phase_attn(ATT, PO, LSE2, S, lds, bid, G, tid);
            } else if constexpr (k == 2) {
                MKP(); if constexpr (g > 0) phase_final(P, ssq3, g - 1, gw, NGW, lane);
                if constexpr (g == 0) { phase_prologue<1>(P, lds, bid, G, tid); __syncthreads(); }
                phase_dna(P, DNQ, SMALL, FRAGP, VACCP, TIP, VECP, S, lds, bid, G, tid);
            } else if constexpr (k == 3) {
                constexpr int nchain = (TG / S) * 16;
                if (bid < nchain) phase_scan(FRAGP, TIP, VACCP, VECP, OF, OB, S, lds, bid, G, tid);
                else { pg8::Gemm gm{XBg, Win + (size_t)NPA * D, TG, 2048, D}; pg8::StaticOrder So; So.init(TG, 2048, G - nchain, bid - nchain); pg8::EpiGates E{Gt, rstd1};
                  pg8::gemm_phase<pg8::EpiGates, pg8::StaticOrder, true, true>((LAS unsigned char*)lds, gm, So, E, tid); }
            } else if constexpr (k == 4) {
                phase_attn_combine(PO, LSE2, AB, gt, NGT); MKP(); phase_combine(P, OF, OB, Z, AB, gw, NGW, lane);
            } else if constexpr (k == 5) {
                pg8::Gemm gm{AB, Wa, TG, D, 1536}; pg8::StaticOrder So; So.init(TG, D, G, bid); pg8::EpiMix E{Gt, MIX};
                pg8::gemm_phase<pg8::EpiMix, pg8::StaticOrder, true, true>((LAS unsigned char*)lds, gm, So, E, tid);
            } else if constexpr (k == 6) {
                pg8::Gemm gm{MIX, Wout, TG, D, D}; pg8::StaticOrder So; So.init(TG, D, G, bid);
                pg8::EpiResB E{XBg, nullptr, X1B, ssq2 + t0};
                pg8::gemm_phase<pg8::EpiResB, pg8::StaticOrder, true, true>((LAS unsigned char*)lds, gm, So, E, tid);
            } else if constexpr (k == 7) {
                pg8::Gemm gm{X1B, Wup, TG, NUP, D}; pg8::StaticOrder So; So.init(TG, NUP, G, bid); pg8::EpiUpAct E{ACT, EDGEP, ssq2 + t0, LDP(15), LDP(16), (LAS unsigned char*)lds};
                pg8::gemm_phase<pg8::EpiUpAct, pg8::StaticOrder, true, true>((LAS unsigned char*)lds, gm, So, E, tid);
            } else {
                { MKP(); if constexpr (g + 1 < NGROUPS) phase_xb(P, g + 1, gw, NGW, lane);
                  pg8::StaticOrder So; So.init(TG, D, G, bid); pg8::Unit u0; if (So.next(0, u0)) act_fix(P, EDGEP, ACT, u0.pm, S, tid);
                  asm volatile("s_waitcnt vmcnt(0)" ::: "memory"); __syncthreads(); }
                pg8::Gemm gm{ACT, Wdn, TG, D, DFF}; pg8::StaticOrder So; So.init(TG, D, G, bid); pg8::EpiResB E{X1B, OUTg, nullptr, ssq3 + t0};
                pg8::gemm_phase<pg8::EpiResB, pg8::StaticOrder, true, true>((LAS unsigned char*)lds, gm, So, E, tid);
            }
    }
}
template <int ONLYK, int STEP> __device__ __forceinline__ void run_steps(unsigned char* lds, cg::grid_group& grid, const XcdBarrier& xb, int lo, int hi, int G, int NGW, int NGT, int wave_u) {
    if constexpr (STEP < NSTEPS) {
        if (lo <= STEP && STEP < hi) { run_step<ONLYK, STEP>(lds, G, NGW, NGT, wave_u);
            if (STEP + 1 < hi) {
                if constexpr (STEP == 0) grid.sync();
                else { const int tid = wave_u * 64 + (int)__builtin_amdgcn_mbcnt_hi(~0u, __builtin_amdgcn_mbcnt_lo(~0u, 0u)); xcd_barrier(xb, tid); } } }
        run_steps<ONLYK, STEP + 1>(lds, grid, xb, lo, hi, G, NGW, NGT, wave_u);
    }
}
template <int ONLYK> __global__ void __launch_bounds__(NTHREADS, 2) fwd(Args args) {
    extern __shared__ __attribute__((aligned(16))) unsigned char lds[];
    const int G = gridDim.x, NGW = G * NWAVES, NGT = G * NTHREADS;
    cg::grid_group grid = cg::this_grid();
    const int wave_u = __builtin_amdgcn_readfirstlane((int)threadIdx.x >> 6);
    volatile LAS unsigned* st = (volatile LAS unsigned*)((LAS unsigned char*)lds + LDS_BYTES - 16);
    if (threadIdx.x < 4) st[threadIdx.x] = 0u;
    __syncthreads();
    const XcdBarrier xb = xcd_barrier_post((unsigned*)(args.ws + WS_CTL) + CW_BAR, st, (int)threadIdx.x);
    run_steps<ONLYK, 0>(lds, grid, xb, args.lo, args.hi, G, NGW, NGT, wave_u);
}

extern "C" void kernel_launch(void* const* d_in, const int* in_sizes, int n_in, void* d_out, int out_size, void* d_ws, size_t ws_size, hipStream_t stream) {
    static int grid = 0;
    if (grid == 0) {
        if (n_in != 19 || ws_size < WS_END) { fprintf(stderr, "kernel_launch: unexpected n_in %d / ws_size %zu (need %zu)\n", n_in, ws_size, (size_t)WS_END); grid = -1; return; }
        int dev = 0, cus = 0; (void)hipGetDevice(&dev); (void)hipDeviceGetAttribute(&cus, hipDeviceAttributeMultiprocessorCount, dev);
        if (hipFuncSetAttribute((const void*)fwd<-1>, hipFuncAttributeMaxDynamicSharedMemorySize, LDS_BYTES) != hipSuccess) { fprintf(stderr, "kernel_launch: hipFuncSetAttribute failed\n"); grid = -1; return; }
        int per_cu = 0;
        if (hipOccupancyMaxActiveBlocksPerMultiprocessor(&per_cu, (const void*)fwd<-1>, NTHREADS, LDS_BYTES) != hipSuccess || per_cu < 1) { fprintf(stderr, "kernel_launch: occupancy query failed / %d blocks per CU\n", per_cu); grid = -1; return; }
        grid = cus;
    }
    if (grid < 0) return;
    (void)hipMemsetAsync((char*)d_ws + WS_CTL, 0, CTL_BYTES, stream);
    Args a{};
    for (int i = 0; i < 19; ++i) a.in[i] = (const float*)d_in[i];
    a.out = (float*)d_out; a.ws = (unsigned char*)d_ws;
    a.lo = 0; a.hi = NSTEPS; void* kargs[] = {&a};
    hipError_t e = hipLaunchCooperativeKernel((const void*)fwd<-1>, dim3(grid), dim3(NTHREADS), kargs, LDS_BYTES, stream);
    if (e != hipSuccess) fprintf(stderr, "cooperative launch failed: %s (grid %d)\n", hipGetErrorString(e), grid);
}
```
